# Optimizing an MI355X kernel written in HIP

```python
import math
import jax, jax.numpy as jnp
from jax import lax
import numpy as np

D_MODEL = 1024
BATCH = 8
SEQ = 2048
DEPTH = 2
DEC_BATCH = 128
DEC_SEQ = 8
PAST_LEN = 16384
PAGE_SIZE = 128

BRANCH_W = D_MODEL // 2
N_BRANCH = 3
N_POOL_GROUPS = 4
POOL_WINDOWS = (2, 4, 8, 16)
POOL_GROUP_W = BRANCH_W // N_POOL_GROUPS
POOL_BUF = max(POOL_WINDOWS) - 1
CONV_WIDTH = 31
CONV_BUF = CONV_WIDTH - 1
N_MEM = 256
N_XHEADS = 4
XHEAD_DIM = BRANCH_W // N_XHEADS
N_IN_SLICES = 7
IN_COLS = N_IN_SLICES * BRANCH_W + N_BRANCH * D_MODEL
EPS = 1e-6

kernel_name = "hybrid_pool_conv_memattn_decoder_step"


def rmsnorm(x, g):
    xf = x.astype(jnp.float32)
    r = xf * lax.rsqrt(jnp.mean(xf * xf, axis=-1, keepdims=True) + EPS)
    return (r * g.astype(jnp.float32)).astype(x.dtype)


def layernorm(x, g, b):
    xf = x.astype(jnp.float32)
    mu = jnp.mean(xf, axis=-1, keepdims=True)
    var = jnp.mean(jnp.square(xf - mu), axis=-1, keepdims=True)
    r = (xf - mu) * lax.rsqrt(var + EPS)
    return (r * g.astype(jnp.float32) + b.astype(jnp.float32)).astype(x.dtype)


def pool_mix(ext, pos0, pool_w, pool_scale):
    B, L, W = ext.shape
    S = L - POOL_BUF
    ef = ext.astype(jnp.float32)
    csum = jnp.concatenate([jnp.zeros((B, 1, W), jnp.float32), jnp.cumsum(ef, axis=1)], axis=1)
    pos = (pos0 + jnp.arange(S)).astype(jnp.float32)
    parts = []
    for g, win in enumerate(POOL_WINDOWS):
        cg = csum[..., g * POOL_GROUP_W:(g + 1) * POOL_GROUP_W]
        hi = cg[:, POOL_BUF + 1:POOL_BUF + 1 + S]
        lo = cg[:, POOL_BUF + 1 - win:POOL_BUF + 1 - win + S]
        cnt = jnp.minimum(pos + 1.0, float(win))[None, :, None]
        parts.append((hi - lo) / cnt)
    pooled = jnp.concatenate(parts, axis=-1)
    mixed = (pooled - ef[:, POOL_BUF:]).reshape(B, S, N_POOL_GROUPS, POOL_GROUP_W)
    y = jnp.einsum('bsgc,gcd->bsgd', mixed, pool_w.astype(jnp.float32)).reshape(B, S, W)
    return (y * pool_scale.astype(jnp.float32)).astype(ext.dtype)


def causal_dwconv(ext, conv_w, conv_b):
    W = ext.shape[-1]
    out = lax.conv_general_dilated(ext, conv_w[:, None, :].astype(ext.dtype), window_strides=(1,),
                                   padding='VALID', dimension_numbers=('NWC', 'WIO', 'NWC'),
                                   feature_group_count=W)
    return out + conv_b


def mem_kv(mem, g, w):
    B = mem.shape[0]
    kv = rmsnorm(mem, g) @ w
    k = kv[..., :BRANCH_W].reshape(B, N_MEM, N_XHEADS, XHEAD_DIM)
    v = kv[..., BRANCH_W:].reshape(B, N_MEM, N_XHEADS, XHEAD_DIM)
    return k, v


def layer(x, pool_buf, conv_buf, mk, mv, pos0, g_pre, g_post, w_in, pool_w, pool_scale,
          conv_w, conv_b, conv_ln_g, conv_ln_b, w_branch, w_out):
    B, S, _ = x.shape
    W = BRANCH_W
    h = rmsnorm(x, g_pre)
    proj = h @ w_in
    p_in, p_gate, c_val, c_glu, c_gate, q, x_gate = [proj[..., i * W:(i + 1) * W] for i in range(N_IN_SLICES)]
    merge_logits = proj[..., N_IN_SLICES * W:].reshape(B, S, N_BRANCH, D_MODEL)
    pool_ext = jnp.concatenate([pool_buf, p_in], axis=1)
    a = pool_mix(pool_ext, pos0, pool_w, pool_scale) * jax.nn.silu(p_gate)
    u = c_val * jax.nn.sigmoid(c_glu)
    conv_ext = jnp.concatenate([conv_buf, u], axis=1)
    cv = jax.nn.silu(layernorm(causal_dwconv(conv_ext, conv_w, conv_b), conv_ln_g, conv_ln_b))
    bconv = cv * jax.nn.silu(c_gate)
    qh = q.reshape(B, S, N_XHEADS, XHEAD_DIM)
    s = jnp.einsum('bshd,bmhd->bhsm', qh, mk).astype(jnp.float32) / math.sqrt(XHEAD_DIM)
    p = jax.nn.softmax(s, axis=-1).astype(x.dtype)
    o = jnp.einsum('bhsm,bmhd->bshd', p, mv).reshape(B, S, W)
    cattn = o * jax.nn.silu(x_gate)
    br = jnp.einsum('bsnw,nwd->bsnd', jnp.stack([a, bconv, cattn], axis=2), w_branch)
    merged = jnp.sum(jax.nn.sigmoid(merge_logits) * br, axis=2)
    y = merged @ w_out
    x_new = x + rmsnorm(y, g_post)
    return x_new, pool_ext[:, -POOL_BUF:], conv_ext[:, -CONV_BUF:]


def setup_inputs(seed: int = 0) -> dict:
    key = jax.random.key(seed)
    ks = jax.random.split(key, 24)
    f = jnp.float32
    W = BRANCH_W
    nrm = lambda k, shape, s: jax.random.normal(k, shape, f) * s
    return {
        "x_prompt": nrm(ks[0], (BATCH, SEQ, D_MODEL), 1.0),
        "x_sample": nrm(ks[1], (DEC_BATCH, DEC_SEQ, D_MODEL), 1.0),
        "state_pool": nrm(ks[2], (DEPTH, DEC_BATCH, POOL_BUF, W), 1.0),
        "state_conv": nrm(ks[3], (DEPTH, DEC_BATCH, CONV_BUF, W), 0.5),
        "cache_mem_k": nrm(ks[4], (DEPTH, DEC_BATCH, N_MEM, N_XHEADS, XHEAD_DIM), 1.0),
        "cache_mem_v": nrm(ks[5], (DEPTH, DEC_BATCH, N_MEM, N_XHEADS, XHEAD_DIM), 1.0),
        "mem_prompt": nrm(ks[6], (BATCH, N_MEM, D_MODEL), 1.0),
        "norm_pre": 1.0 + nrm(ks[7], (DEPTH, D_MODEL), 0.05),
        "norm_post": 1.0 + nrm(ks[8], (DEPTH, D_MODEL), 0.05),
        "mem_norm": 1.0 + nrm(ks[9], (DEPTH, D_MODEL), 0.05),
        "w_mem_kv": nrm(ks[10], (DEPTH, D_MODEL, 2 * W), D_MODEL ** -0.5),
        "w_in": nrm(ks[11], (DEPTH, D_MODEL, IN_COLS), D_MODEL ** -0.5),
        "pool_w": nrm(ks[12], (DEPTH, N_POOL_GROUPS, POOL_GROUP_W, POOL_GROUP_W), POOL_GROUP_W ** -0.5),
        "pool_scale": 1.0 + nrm(ks[13], (DEPTH, W), 0.1),
        "conv_w": nrm(ks[14], (DEPTH, CONV_WIDTH, W), CONV_WIDTH ** -0.5),
        "conv_b": nrm(ks[15], (DEPTH, W), 0.02),
        "conv_ln_g": 1.0 + nrm(ks[16], (DEPTH, W), 0.05),
        "conv_ln_b": nrm(ks[17], (DEPTH, W), 0.02),
        "w_branch": nrm(ks[18], (DEPTH, N_BRANCH, W, D_MODEL), W ** -0.5),
        "w_out": nrm(ks[19], (DEPTH, D_MODEL, D_MODEL), D_MODEL ** -0.5),
    }


def reference(x_prompt, x_sample, state_pool, state_conv, cache_mem_k, cache_mem_v, mem_prompt,
              norm_pre, norm_post, mem_norm, w_mem_kv, w_in, pool_w, pool_scale, conv_w, conv_b,
              conv_ln_g, conv_ln_b, w_branch, w_out):
    xp = x_prompt
    xs = x_sample
    pool_p, conv_p, mk_p, mv_p, pool_s, conv_s = [], [], [], [], [], []
    for i in range(DEPTH):
        lw = (norm_pre[i], norm_post[i], w_in[i], pool_w[i], pool_scale[i], conv_w[i], conv_b[i],
              conv_ln_g[i], conv_ln_b[i], w_branch[i], w_out[i])
        mk, mv = mem_kv(mem_prompt, mem_norm[i], w_mem_kv[i])
        zp = jnp.zeros((xp.shape[0], POOL_BUF, BRANCH_W), xp.dtype)
        zc = jnp.zeros((xp.shape[0], CONV_BUF, BRANCH_W), xp.dtype)
        xp, nb_pool, nb_conv = layer(xp, zp, zc, mk, mv, 0, *lw)
        pool_p.append(nb_pool)
        conv_p.append(nb_conv)
        mk_p.append(mk)
        mv_p.append(mv)
        xs, ns_pool, ns_conv = layer(xs, state_pool[i], state_conv[i], cache_mem_k[i], cache_mem_v[i],
                                     PAST_LEN, *lw)
        pool_s.append(ns_pool)
        conv_s.append(ns_conv)
    return (xp, xs, jnp.stack(pool_p), jnp.stack(conv_p), jnp.stack(mk_p), jnp.stack(mv_p),
            jnp.stack(pool_s), jnp.stack(conv_s))
```

```cpp
#include <hip/hip_runtime.h>
#include <hip/hip_cooperative_groups.h>
#include <cstdio>
#include <cstdint>
namespace cg = cooperative_groups;

#define LAS __attribute__((address_space(3)))
typedef unsigned short bf16_t;
typedef short bf16x8 __attribute__((ext_vector_type(8)));
typedef float f32x4 __attribute__((ext_vector_type(4)));
typedef float f32x2 __attribute__((ext_vector_type(2)));
typedef unsigned u32x4 __attribute__((ext_vector_type(4)));
typedef unsigned u32x2 __attribute__((ext_vector_type(2)));

constexpr int D = 1024, NCOL = 6656, MP = 16384, MS = 1024, MT = MP + MS, SEQ = 2048, NSEQ = 128;
constexpr int C_PGATE = 512, C_CVAL = 1024, C_CGLU = 1536, C_CGATE = 2048, C_Q = 2560, C_XGATE = 3072, C_LOGIT = 3584;
constexpr int BR_LD = 1536;
constexpr float EPS = 1e-6f;
constexpr size_t O_POOLP = 17825792, O_CONVP = 17948672, O_MK = 18194432, O_MV = 20291584, O_POOLS = 22388736, O_CONVS = 24354816;
constexpr size_t WS_WIN = 0;
constexpr size_t WS_WKV = WS_WIN + (size_t)2 * NCOL * D * 2;
constexpr size_t WS_WBR = WS_WKV + (size_t)2 * D * D * 2;
constexpr size_t WS_WOUT = WS_WBR + (size_t)6 * D * 512 * 2;
constexpr size_t WS_WPOOL = WS_WOUT + (size_t)2 * D * D * 2;
constexpr size_t WS_H = WS_WPOOL + (size_t)8 * 128 * 128 * 2;
constexpr size_t WS_MEMN = WS_H + (size_t)MT * D * 2;
constexpr size_t WS_PROJ = WS_MEMN + (size_t)2 * 2048 * D * 2;
constexpr size_t WS_KVB = WS_PROJ + (size_t)MT * NCOL * 2;
constexpr size_t WS_BR = WS_KVB + (size_t)2 * 2048 * D * 2;
constexpr size_t WS_MRG = WS_BR + (size_t)MT * BR_LD * 2;
constexpr size_t WS_Y = WS_MRG + (size_t)MT * D * 2;
constexpr size_t WS_SSQ = WS_Y + (size_t)MT * D * 2;
constexpr size_t WS_END = WS_SSQ + (size_t)MT * 16 * 4;
constexpr int LDS_BYTES = 140 * 1024;
constexpr int NTHREADS = 512;

#ifndef MK_LAUNCHES
#define MK_LAUNCHES 1
#endif
constexpr int NPHASES = 11;

__device__ __forceinline__ unsigned pk2(float lo, float hi) { unsigned r; asm("v_cvt_pk_bf16_f32 %0, %1, %2" : "=v"(r) : "v"(lo), "v"(hi)); return r; }
__device__ __forceinline__ float bflo(unsigned w) { return __uint_as_float(w << 16); }
__device__ __forceinline__ float bfhi(unsigned w) { return __uint_as_float(w & 0xffff0000u); }
__device__ __forceinline__ float bf1(bf16_t b) { return __uint_as_float(((unsigned)b) << 16); }
__device__ __forceinline__ float sigmoidf_(float x) { return __builtin_amdgcn_rcpf(1.0f + __builtin_amdgcn_exp2f(-1.4426950408889634f * x)); }
__device__ __forceinline__ float siluf_(float x) { return x * sigmoidf_(x); }
__device__ __forceinline__ float wave_sum(float v) {
#pragma unroll
    for (int o = 1; o < 64; o <<= 1) v += __shfl_xor(v, o);
    return v;
}
#define LDS_WAIT() asm volatile("s_waitcnt lgkmcnt(0)" ::: "memory")

namespace pg8 {
constexpr int BM = 256, BK = 64, HALF = 128, HTB = HALF * BK * 2, STAGE_BYTES = 8 * HTB, NXCD = 8, WGM = 8;
__host__ __device__ __forceinline__ int lds_byte(int r, int c) { const int st = (r >> 4) * 2 + (c >> 5), rr = r & 15, cc = c & 31, ob = rr * 64 + cc * 2; return st * 1024 + (ob ^ (((ob >> 9) & 1) << 5)); }
__host__ __device__ __forceinline__ void stage_rc(int b, int& R, int& C) { const int st = b / 1024, sb = b % 1024, swz = sb ^ (((sb >> 9) & 1) << 5); R = (st >> 1) * 16 + swz / 64; C = (st & 1) * 32 + (swz % 64) / 2; }
__host__ __device__ __forceinline__ int perm32(int rho) { const int n = rho >> 4, i = rho & 15; return 8 * (i >> 2) + 4 * n + (i & 3); }

struct Unit { int pm, pn, z; };
struct Gemm { const bf16_t* A; const bf16_t* Bt; int K, lda, ldb; unsigned zA, zB; };

struct Order {
    int nM, nN, ntile, nz, zinner, G, c;
    __device__ void init(int M, int N, int nz_, int zinner_, int G_, int c_) { nM = M / BM; nN = N / BM; ntile = nM * nN; nz = nz_; zinner = zinner_; G = G_; c = c_; }
    __device__ bool next(int i, Unit& u) const {
        int tix, z;
        if (zinner) { tix = (i / nz) * G + c; z = i % nz; if (tix >= ntile) return false; }
        else { const long L = (long)i * G + c; if (L >= (long)ntile * nz) return false; z = (int)(L / ntile); tix = (int)(L % ntile); }
        int wgid = tix; { const int q = ntile / NXCD, r = ntile % NXCD, xcd = wgid % NXCD, off = wgid / NXCD; wgid = (xcd < r ? xcd * (q + 1) : r * (q + 1) + (xcd - r) * q) + off; }
        const int nig = WGM * nN, gid = wgid / nig, fm = gid * WGM, gsz = (nM - fm) < WGM ? (nM - fm) : WGM;
        u.pm = fm + ((wgid % nig) % gsz); u.pn = (wgid % nig) / gsz; u.z = z; return true;
    }
};

struct EpiStoreBf16 {
    static constexpr bool PERM = true;
    bf16_t* O; int ldc;
    __device__ __forceinline__ void operator()(const f32x4 (&acc)[2][2][4][2], const Unit& u, int wr, int wc, int fr, int fq) const {
        const int row0 = u.pm * BM + wr * 64 + fr, col0 = u.pn * BM + wc * 32 + 8 * fq;
#pragma unroll
        for (int ai = 0; ai < 2; ++ai)
#pragma unroll
            for (int m = 0; m < 4; ++m) { bf16_t* rowp = O + (size_t)(row0 + ai * HALF + m * 16) * ldc + col0;
#pragma unroll
                for (int bj = 0; bj < 2; ++bj) { const f32x4 v0 = acc[ai][bj][m][0], v1 = acc[ai][bj][m][1];
                    u32x4 w; w.x = pk2(v0[0], v0[1]); w.y = pk2(v0[2], v0[3]); w.z = pk2(v1[0], v1[1]); w.w = pk2(v1[2], v1[3]);
                    *(u32x4*)(rowp + bj * HALF) = w; } }
    }
};
struct EpiKV {
    static constexpr bool PERM = false;
    float* outK; float* outV; bf16_t* kvb;
    __device__ __forceinline__ void operator()(const f32x4 (&acc)[2][2][4][2], const Unit& u, int wr, int wc, int fr, int fq) const {
        const int row0 = u.pm * BM + wr * 64 + fr, col0 = u.pn * BM + wc * 32 + 4 * fq;
        float* of = (u.pn < 2 ? outK : outV) + (size_t)u.z * 2048 * 512; const int cf0 = col0 & 511;
        bf16_t* ob = kvb + (size_t)u.z * 2048 * 1024;
#pragma unroll
        for (int ai = 0; ai < 2; ++ai)
#pragma unroll
            for (int m = 0; m < 4; ++m) { const int r = row0 + ai * HALF + m * 16;
#pragma unroll
                for (int bj = 0; bj < 2; ++bj)
#pragma unroll
                    for (int n = 0; n < 2; ++n) { const f32x4 v = acc[ai][bj][m][n];
                        *(f32x4*)(of + (size_t)r * 512 + cf0 + bj * HALF + n * 16) = v;
                        u32x2 w; w.x = pk2(v[0], v[1]); w.y = pk2(v[2], v[3]);
                        *(u32x2*)(ob + (size_t)r * 1024 + col0 + bj * HALF + n * 16) = w; } }
    }
};
struct EpiMerge {
    static constexpr bool PERM = true;
    const bf16_t* proj; bf16_t* mrg;
    __device__ __forceinline__ void operator()(const f32x4 (&acc)[2][2][4][2], const Unit& u, int wr, int wc, int fr, int fq) const {
        const int row0 = u.pm * BM + wr * 64 + fr, col0 = u.pn * BM + wc * 32 + 8 * fq;
#pragma unroll
        for (int ai = 0; ai < 2; ++ai)
#pragma unroll
            for (int m = 0; m < 4; ++m) { const int r = row0 + ai * HALF + m * 16;
                const bf16_t* lg = proj + (size_t)r * NCOL + C_LOGIT + u.z * D + col0; bf16_t* mp = mrg + (size_t)r * D + col0;
#pragma unroll
                for (int bj = 0; bj < 2; ++bj) { const f32x4 v0 = acc[ai][bj][m][0], v1 = acc[ai][bj][m][1];
                    const u32x4 g = *(const u32x4*)(lg + bj * HALF);
                    float o[8];
                    o[0] = v0[0] * sigmoidf_(bflo(g.x)); o[1] = v0[1] * sigmoidf_(bfhi(g.x)); o[2] = v0[2] * sigmoidf_(bflo(g.y)); o[3] = v0[3] * sigmoidf_(bfhi(g.y));
                    o[4] = v1[0] * sigmoidf_(bflo(g.z)); o[5] = v1[1] * sigmoidf_(bfhi(g.z)); o[6] = v1[2] * sigmoidf_(bflo(g.w)); o[7] = v1[3] * sigmoidf_(bfhi(g.w));
                    if (u.z != 0) { const u32x4 p = *(const u32x4*)(mp + bj * HALF);
                        o[0] += bflo(p.x); o[1] += bfhi(p.x); o[2] += bflo(p.y); o[3] += bfhi(p.y); o[4] += bflo(p.z); o[5] += bfhi(p.z); o[6] += bflo(p.w); o[7] += bfhi(p.w); }
                    u32x4 w; w.x = pk2(o[0], o[1]); w.y = pk2(o[2], o[3]); w.z = pk2(o[4], o[5]); w.w = pk2(o[6], o[7]);
                    *(u32x4*)(mp + bj * HALF) = w; }
                asm volatile("" ::: "memory"); }
    }
};
struct EpiY {
    static constexpr bool PERM = true;
    bf16_t* Y; float* ssq;
    __device__ __forceinline__ void operator()(const f32x4 (&acc)[2][2][4][2], const Unit& u, int wr, int wc, int fr, int fq) const {
        const int row0 = u.pm * BM + wr * 64 + fr, col0 = u.pn * BM + wc * 32 + 8 * fq;
#pragma unroll
        for (int ai = 0; ai < 2; ++ai)
#pragma unroll
            for (int m = 0; m < 4; ++m) { const int r = row0 + ai * HALF + m * 16; bf16_t* rowp = Y + (size_t)r * D + col0; float s = 0.f;
#pragma unroll
                for (int bj = 0; bj < 2; ++bj) { const f32x4 v0 = acc[ai][bj][m][0], v1 = acc[ai][bj][m][1];
                    s += (v0[0] * v0[0] + v0[1] * v0[1]) + (v0[2] * v0[2] + v0[3] * v0[3]) + (v1[0] * v1[0] + v1[1] * v1[1]) + (v1[2] * v1[2] + v1[3] * v1[3]);
                    u32x4 w; w.x = pk2(v0[0], v0[1]); w.y = pk2(v0[2], v0[3]); w.z = pk2(v1[0], v1[1]); w.w = pk2(v1[2], v1[3]);
                    *(u32x4*)(rowp + bj * HALF) = w; }
                s += __shfl_xor(s, 16); s += __shfl_xor(s, 32);
                if (fq == 0) ssq[(size_t)r * 16 + u.pn * 4 + wc] = s; }
    }
};

template <class Epi>
__device__ __forceinline__ void gemm_phase(LAS unsigned char* lds, const Gemm g, const Order& S, const Epi& E) {
    int tid = threadIdx.x; asm volatile("" : "+v"(tid));
    const int wid = __builtin_amdgcn_readfirstlane(tid >> 6), lane = tid & 63, wr = wid >> 2, wc = wid & 3, fr = lane & 15, fq = lane >> 4;
    const int K = g.K, nt = K / BK;
    unsigned voffA[2], voffB[2];
#pragma unroll
    for (int i = 0; i < 2; ++i) { int R, C; stage_rc(tid * 16 + i * 8192, R, C); const int Rb = Epi::PERM ? ((R & ~31) + perm32(R & 31)) : R;
        voffA[i] = (unsigned)(R * g.lda + C) * 2u; voffB[i] = (unsigned)(Rb * g.ldb + C) * 2u; }
    constexpr unsigned kstep = BK * 2;
    const unsigned hstepA = (unsigned)HALF * g.lda * 2, hstepB = (unsigned)HALF * g.ldb * 2;
    const unsigned tstepA = 2 * hstepA, tstepB = 2 * hstepB;
    const unsigned ldsw = (unsigned)wid * 1024u;
    const int aoff = lds_byte(wr * 64 + fr, fq * 8), boff = lds_byte(wc * 32 + fr, fq * 8);
#define PG8_SA(b, h) (((b) * 2 + (h)) * HTB)
#define PG8_SB(b, h) ((4 + (b) * 2 + (h)) * HTB)
#define PG8_STAGE(bufoff, gbase, voff) do { _Pragma("unroll") for (int _i = 0; _i < 2; ++_i) \
        __builtin_amdgcn_global_load_lds((const unsigned*)((const char*)(gbase) + (voff)[_i]), (LAS unsigned*)(lds + (bufoff) + ldsw + _i * 8192), 16, 0, 0); } while (0)
#define PG8_LDA(dst, b, h) do { _Pragma("unroll") for (int m = 0; m < 4; ++m) _Pragma("unroll") for (int k = 0; k < 2; ++k) dst[m][k] = *(const LAS bf16x8*)(lds + PG8_SA(b, h) + aoff + m * 2048 + k * 1024); } while (0)
#define PG8_LDB(dst, b, h) do { _Pragma("unroll") for (int n = 0; n < 2; ++n) _Pragma("unroll") for (int k = 0; k < 2; ++k) dst[n][k] = *(const LAS bf16x8*)(lds + PG8_SB(b, h) + boff + n * 2048 + k * 1024); } while (0)
#define PG8_MMA(ai, bj, At, Bt) do { __builtin_amdgcn_s_setprio(1); _Pragma("unroll") for (int m = 0; m < 4; ++m) _Pragma("unroll") for (int n = 0; n < 2; ++n) _Pragma("unroll") for (int k = 0; k < 2; ++k) \
        acc[ai][bj][m][n] = __builtin_amdgcn_mfma_f32_16x16x32_bf16(Bt[n][k], At[m][k], acc[ai][bj][m][n], 0, 0, 0); __builtin_amdgcn_s_setprio(0); } while (0)
#define PG8_WAIT_V(n) asm volatile("s_waitcnt vmcnt(" #n ")" ::: "memory")
#define PG8_WAIT_L(n) asm volatile("s_waitcnt lgkmcnt(" #n ")" ::: "memory")
#define PG8_BAR __builtin_amdgcn_s_barrier()
#define PG8_SCHED __builtin_amdgcn_sched_barrier(0)
    Unit cur, nxt; int ui = 0;
    if (!S.next(0, cur)) return;
    f32x4 acc[2][2][4][2];
#pragma unroll
    for (int a = 0; a < 2; ++a)
#pragma unroll
        for (int b = 0; b < 2; ++b)
#pragma unroll
            for (int m = 0; m < 4; ++m)
#pragma unroll
                for (int n = 0; n < 2; ++n) acc[a][b][m][n] = (f32x4){0.f, 0.f, 0.f, 0.f};
    bf16x8 At[4][2], B0[2][2], B1[2][2];
    const char* cA = (const char*)g.A + (size_t)((unsigned)cur.pm * tstepA + (unsigned)cur.z * g.zA); const char* cB = (const char*)g.Bt + (size_t)((unsigned)cur.pn * tstepB + (unsigned)cur.z * g.zB);
    PG8_STAGE(PG8_SB(0, 0), cB, voffB); PG8_STAGE(PG8_SB(0, 1), cB + hstepB, voffB); PG8_STAGE(PG8_SA(0, 0), cA, voffA); PG8_STAGE(PG8_SA(0, 1), cA + hstepA, voffA);
    if (wr == 1) PG8_BAR;
    PG8_WAIT_V(2); PG8_BAR;
    PG8_STAGE(PG8_SB(1, 0), cB + kstep, voffB); PG8_STAGE(PG8_SA(1, 0), cA + kstep, voffA); PG8_STAGE(PG8_SB(1, 1), cB + hstepB + kstep, voffB);
    PG8_WAIT_V(6); PG8_BAR;
    for (;;) {
        const bool has_next = S.next(ui + 1, nxt);
        const char* nA = has_next ? (const char*)g.A + (size_t)((unsigned)nxt.pm * tstepA + (unsigned)nxt.z * g.zA) : cA;
        const char* nB = has_next ? (const char*)g.Bt + (size_t)((unsigned)nxt.pn * tstepB + (unsigned)nxt.z * g.zB) : cB;
        for (int t = 0; t < nt; t += 2) {
            const bool last = (t == nt - 2);
            const char* a1 = cA + (unsigned)(t + 1) * kstep;
            const char* a2 = last ? nA : cA + (unsigned)(t + 2) * kstep; const char* b2 = last ? nB : cB + (unsigned)(t + 2) * kstep;
            const char* a3 = a2 + kstep; const char* b3 = b2 + kstep;
            PG8_LDB(B0, 0, 0); PG8_LDB(B1, 0, 1); PG8_SCHED; PG8_LDA(At, 0, 0); PG8_STAGE(PG8_SA(1, 1), a1 + hstepA, voffA);
            PG8_WAIT_V(8); PG8_WAIT_L(0); PG8_BAR; PG8_MMA(0, 0, At, B0); PG8_MMA(0, 1, At, B1); PG8_BAR; PG8_SCHED;
            PG8_LDA(At, 0, 1); PG8_STAGE(PG8_SB(0, 0), b2, voffB); PG8_STAGE(PG8_SB(0, 1), b2 + hstepB, voffB); PG8_STAGE(PG8_SA(0, 0), a2, voffA);
            PG8_WAIT_V(8); PG8_WAIT_L(0); PG8_BAR; PG8_MMA(1, 0, At, B0); PG8_MMA(1, 1, At, B1); PG8_BAR; PG8_SCHED;
            PG8_LDB(B0, 1, 0); PG8_LDB(B1, 1, 1); PG8_SCHED; PG8_LDA(At, 1, 0); PG8_STAGE(PG8_SA(0, 1), a2 + hstepA, voffA);
            PG8_WAIT_V(8); PG8_WAIT_L(0); PG8_BAR; PG8_MMA(0, 0, At, B0); PG8_MMA(0, 1, At, B1); PG8_BAR; PG8_SCHED;
            PG8_LDA(At, 1, 1); PG8_STAGE(PG8_SB(1, 0), b3, voffB); PG8_STAGE(PG8_SB(1, 1), b3 + hstepB, voffB); PG8_STAGE(PG8_SA(1, 0), a3, voffA);
            PG8_WAIT_V(8); PG8_WAIT_L(0); PG8_BAR; PG8_MMA(1, 0, At, B0); PG8_MMA(1, 1, At, B1); PG8_BAR; PG8_SCHED;
        }
        if (wr == 0) PG8_BAR;
        E(acc, cur, wr, wc, fr, fq);
        if (!has_next) break;
#pragma unroll
        for (int a = 0; a < 2; ++a)
#pragma unroll
            for (int b = 0; b < 2; ++b)
#pragma unroll
                for (int m = 0; m < 4; ++m)
#pragma unroll
                    for (int n = 0; n < 2; ++n) acc[a][b][m][n] = (f32x4){0.f, 0.f, 0.f, 0.f};
        cur = nxt; cA = nA; cB = nB; ++ui;
        if (wr == 1) PG8_BAR;
    }
    PG8_WAIT_V(0);
    PG8_BAR;
#undef PG8_SA
#undef PG8_SB
#undef PG8_STAGE
#undef PG8_LDA
#undef PG8_LDB
#undef PG8_MMA
#undef PG8_WAIT_V
#undef PG8_WAIT_L
#undef PG8_BAR
#undef PG8_SCHED
}
}

struct Params { const float* in[20]; float* out; unsigned char* ws; int ph_lo, ph_hi; };
enum { I_XP = 0, I_XS, I_SPOOL, I_SCONV, I_CK, I_CV, I_MEM, I_NPRE, I_NPOST, I_MNORM, I_WKV, I_WIN, I_POOLW, I_PSCALE, I_CONVW, I_CONVB, I_LNG, I_LNB, I_WBR, I_WOUT };

__device__ __forceinline__ void transpose_item(const float* W, int K, int N, bf16_t* WT, LAS float* scr, int item, int lane) {
    const int nblk = N / 32, kb = item / nblk, nb = item % nblk, k0 = 64 * kb, n0 = 32 * nb;
#pragma unroll 8
    for (int i = 0; i < 32; ++i) { const int kk = 2 * i + (lane >> 5); scr[kk * 33 + (lane & 31)] = W[(size_t)(k0 + kk) * N + n0 + (lane & 31)]; }
    LDS_WAIT();
    const int c = lane & 7;
#pragma unroll
    for (int j = 0; j < 4; ++j) { const int n = (lane >> 3) + 8 * j; const LAS float* s = scr + (8 * c) * 33 + n;
        u32x4 o; o.x = pk2(s[0 * 33], s[1 * 33]); o.y = pk2(s[2 * 33], s[3 * 33]); o.z = pk2(s[4 * 33], s[5 * 33]); o.w = pk2(s[6 * 33], s[7 * 33]);
        *(u32x4*)(WT + (size_t)(n0 + n) * K + k0 + 8 * c) = o; }
    LDS_WAIT();
}

__device__ __forceinline__ void p0_prologue(const Params& p, LAS unsigned char* lds, int gw, int NGW, int wave, int lane) {
    LAS float* scr = (LAS float*)(lds + wave * 8704);
    unsigned char* ws = p.ws;
    constexpr int I_IN = (D / 64) * (NCOL / 32), I_SQ = (D / 64) * (D / 32), I_BR = (512 / 64) * (D / 32), I_PL = 2 * 4;
    constexpr int NITEMS = 2 * I_IN + 2 * I_SQ + 6 * I_BR + 2 * I_SQ + 8 * I_PL;
    for (int it = gw; it < NITEMS; it += NGW) {
        int r = it;
        if (r < 2 * I_IN) { const int l = r / I_IN; transpose_item(p.in[I_WIN] + (size_t)l * D * NCOL, D, NCOL, (bf16_t*)(ws + WS_WIN) + (size_t)l * NCOL * D, scr, r % I_IN, lane); continue; } r -= 2 * I_IN;
        if (r < 2 * I_SQ) { const int l = r / I_SQ; transpose_item(p.in[I_WKV] + (size_t)l * D * D, D, D, (bf16_t*)(ws + WS_WKV) + (size_t)l * D * D, scr, r % I_SQ, lane); continue; } r -= 2 * I_SQ;
        if (r < 6 * I_BR) { const int l = r / I_BR; transpose_item(p.in[I_WBR] + (size_t)l * 512 * D, 512, D, (bf16_t*)(ws + WS_WBR) + (size_t)l * D * 512, scr, r % I_BR, lane); continue; } r -= 6 * I_BR;
        if (r < 2 * I_SQ) { const int l = r / I_SQ; transpose_item(p.in[I_WOUT] + (size_t)l * D * D, D, D, (bf16_t*)(ws + WS_WOUT) + (size_t)l * D * D, scr, r % I_SQ, lane); continue; } r -= 2 * I_SQ;
        { const int l = r / I_PL; transpose_item(p.in[I_POOLW] + (size_t)l * 128 * 128, 128, 128, (bf16_t*)(ws + WS_WPOOL) + (size_t)l * 128 * 128, scr, r % I_PL, lane); }
    }
    const float* g0 = p.in[I_NPRE];
    for (int m = gw; m < MT; m += NGW) {
        const float* xrow = (m < MP) ? p.in[I_XP] + (size_t)m * D : p.in[I_XS] + (size_t)(m - MP) * D;
        const f32x4* xr = (const f32x4*)xrow + lane; f32x4 v[4]; float s = 0.f;
#pragma unroll
        for (int j = 0; j < 4; ++j) { v[j] = xr[64 * j]; s += (v[j].x * v[j].x + v[j].y * v[j].y) + (v[j].z * v[j].z + v[j].w * v[j].w); }
        const float rs = 1.0f / sqrtf(wave_sum(s) * (1.f / D) + EPS);
        u32x2* o = (u32x2*)((bf16_t*)(ws + WS_H) + (size_t)m * D) + lane;
#pragma unroll
        for (int j = 0; j < 4; ++j) { const f32x4 g = ((const f32x4*)g0)[lane + 64 * j]; u32x2 w; w.x = pk2(v[j].x * rs * g.x, v[j].y * rs * g.y); w.y = pk2(v[j].z * rs * g.z, v[j].w * rs * g.w); o[64 * j] = w; }
    }
    for (int m = gw; m < 2048; m += NGW) {
        const f32x4* xr = (const f32x4*)(p.in[I_MEM] + (size_t)m * D) + lane; f32x4 v[4]; float s = 0.f;
#pragma unroll
        for (int j = 0; j < 4; ++j) { v[j] = xr[64 * j]; s += (v[j].x * v[j].x + v[j].y * v[j].y) + (v[j].z * v[j].z + v[j].w * v[j].w); }
        const float rs = 1.0f / sqrtf(wave_sum(s) * (1.f / D) + EPS);
#pragma unroll
        for (int l = 0; l < 2; ++l) { u32x2* o = (u32x2*)((bf16_t*)(ws + WS_MEMN) + ((size_t)l * 2048 + m) * D) + lane;
#pragma unroll
            for (int j = 0; j < 4; ++j) { const f32x4 g = ((const f32x4*)(p.in[I_MNORM] + l * D))[lane + 64 * j]; u32x2 w; w.x = pk2(v[j].x * rs * g.x, v[j].y * rs * g.y); w.y = pk2(v[j].z * rs * g.z, v[j].w * rs * g.w); o[64 * j] = w; } }
    }
}

__device__ __forceinline__ void p5_residual(const Params& p, int layer, int gw, int NGW, int lane) {
    unsigned char* ws = p.ws;
    const bf16_t* Y = (const bf16_t*)(ws + WS_Y); const float* ssq = (const float*)(ws + WS_SSQ);
    const f32x4* gp = (const f32x4*)(p.in[I_NPOST] + layer * D); const f32x4* gn = (const f32x4*)(p.in[I_NPRE] + D);
    for (int m = gw; m < MT; m += NGW) {
        const float* xrow = (layer == 0) ? ((m < MP) ? p.in[I_XP] + (size_t)m * D : p.in[I_XS] + (size_t)(m - MP) * D) : p.out + (size_t)m * D;
        float sp = (lane < 16) ? ssq[(size_t)m * 16 + lane] : 0.f;
        const float rs = 1.0f / sqrtf(wave_sum(sp) * (1.f / D) + EPS);
        const f32x4* xr = (const f32x4*)xrow + lane; const u32x2* yr = (const u32x2*)(Y + (size_t)m * D) + lane;
        f32x4 v[4]; float s = 0.f;
#pragma unroll
        for (int j = 0; j < 4; ++j) { const f32x4 x = xr[64 * j]; const u32x2 y = yr[64 * j]; const f32x4 g = gp[lane + 64 * j];
            v[j].x = x.x + bflo(y.x) * rs * g.x; v[j].y = x.y + bfhi(y.x) * rs * g.y; v[j].z = x.z + bflo(y.y) * rs * g.z; v[j].w = x.w + bfhi(y.y) * rs * g.w;
            s += (v[j].x * v[j].x + v[j].y * v[j].y) + (v[j].z * v[j].z + v[j].w * v[j].w); }
        f32x4* orow = (f32x4*)(p.out + (size_t)m * D) + lane;
#pragma unroll
        for (int j = 0; j < 4; ++j) orow[64 * j] = v[j];
        if (layer == 0) {
            const float r2 = 1.0f / sqrtf(wave_sum(s) * (1.f / D) + EPS);
            u32x2* o = (u32x2*)((bf16_t*)(ws + WS_H) + (size_t)m * D) + lane;
#pragma unroll
            for (int j = 0; j < 4; ++j) { const f32x4 g = gn[lane + 64 * j]; u32x2 w; w.x = pk2(v[j].x * r2 * g.x, v[j].y * r2 * g.y); w.y = pk2(v[j].z * r2 * g.z, v[j].w * r2 * g.w); o[64 * j] = w; }
        }
    }
}

template <int T, bool SAMPLE>
__device__ __forceinline__ void pool_task(const Params& p, int layer, LAS unsigned char* lds, int task, int tid, int wave, int lane) {
    constexpr int R = T + 15, NRB = (T + 15) / 16;
    unsigned char* ws = p.ws;
    const bf16_t* proj = (const bf16_t*)(ws + WS_PROJ); bf16_t* br = (bf16_t*)(ws + WS_BR);
    LAS unsigned* PE = (LAS unsigned*)lds;
    LAS unsigned* MX = (LAS unsigned*)(lds + R * 1024);
    int b = 0, t0 = 0, seq = 0, rowbase;
    if (SAMPLE) { seq = task; rowbase = MP + seq * 8; } else { b = task >> 6; t0 = (task & 63) * T; rowbase = b * SEQ + t0; }
    __syncthreads();
    for (int idx = tid; idx < R * 64; idx += NTHREADS) {
        const int row = idx >> 6, c8 = idx & 63; u32x4 w;
        if (SAMPLE) {
            if (row < 15) { const float* src = p.in[I_SPOOL] + (((size_t)layer * NSEQ + seq) * 15 + row) * 512 + 8 * c8; const f32x4 a = *(const f32x4*)src, c = *(const f32x4*)(src + 4);
                w.x = pk2(a.x, a.y); w.y = pk2(a.z, a.w); w.z = pk2(c.x, c.y); w.w = pk2(c.z, c.w);
                if (row >= 8) { float* o = p.out + O_POOLS + (((size_t)layer * NSEQ + seq) * 15 + (row - 8)) * 512 + 8 * c8; *(f32x4*)o = a; *(f32x4*)(o + 4) = c; } }
            else { w = *(const u32x4*)(proj + (size_t)(rowbase + row - 15) * NCOL + 8 * c8);
                float* o = p.out + O_POOLS + (((size_t)layer * NSEQ + seq) * 15 + (row - 8)) * 512 + 8 * c8;
                *(f32x4*)o = (f32x4){bflo(w.x), bfhi(w.x), bflo(w.y), bfhi(w.y)}; *(f32x4*)(o + 4) = (f32x4){bflo(w.z), bfhi(w.z), bflo(w.w), bfhi(w.w)}; }
        } else {
            const int grow = t0 - 15 + row;
            if (grow < 0) w = (u32x4){0u, 0u, 0u, 0u};
            else { w = *(const u32x4*)(proj + (size_t)(b * SEQ + grow) * NCOL + 8 * c8);
                if (grow >= SEQ - 15) { float* o = p.out + O_POOLP + (((size_t)layer * 8 + b) * 15 + (grow - (SEQ - 15))) * 512 + 8 * c8;
                    *(f32x4*)o = (f32x4){bflo(w.x), bfhi(w.x), bflo(w.y), bfhi(w.y)}; *(f32x4*)(o + 4) = (f32x4){bflo(w.z), bfhi(w.z), bflo(w.w), bfhi(w.w)}; } }
        }
        *(LAS u32x4*)(PE + row * 256 + 4 * c8) = w;
    }
    __syncthreads();
    for (int idx = tid; idx < T * 256; idx += NTHREADS) {
        const int t = idx >> 8, cp = idx & 255, g = cp >> 6, win = 2 << g;
        float s0 = 0.f, s1 = 0.f;
        for (int j = 0; j < win; ++j) { const unsigned w = PE[(15 + t - j) * 256 + cp]; s0 += bflo(w); s1 += bfhi(w); }
        const unsigned cur = PE[(15 + t) * 256 + cp];
        float cnt = (float)win; if (!SAMPLE) { const int pp = t0 + t + 1; cnt = (float)(pp < win ? pp : win); }
        const float inv = 1.0f / cnt;
        MX[t * 260 + cp] = pk2(s0 * inv - bflo(cur), s1 * inv - bfhi(cur));
    }
    __syncthreads();
    {
        const int g = wave >> 1, ch = wave & 1, h4 = lane >> 4, c = lane & 15;
        const bf16_t* wt = (const bf16_t*)(ws + WS_WPOOL) + ((size_t)(layer * 4 + g) * 128 + 64 * ch) * 128;
        f32x4 acc[NRB][4];
#pragma unroll
        for (int rb = 0; rb < NRB; ++rb)
#pragma unroll
            for (int cb = 0; cb < 4; ++cb) acc[rb][cb] = (f32x4){0.f, 0.f, 0.f, 0.f};
#pragma unroll
        for (int ks = 0; ks < 4; ++ks) {
            bf16x8 bf[NRB];
#pragma unroll
            for (int rb = 0; rb < NRB; ++rb) bf[rb] = *(const LAS bf16x8*)((LAS unsigned char*)MX + (16 * rb + c) * 1040 + (128 * g + 32 * ks + 8 * h4) * 2);
#pragma unroll
            for (int cb = 0; cb < 4; ++cb) { const bf16x8 wf = *(const bf16x8*)(wt + (size_t)(16 * cb + c) * 128 + 32 * ks + 8 * h4);
#pragma unroll
                for (int rb = 0; rb < NRB; ++rb) acc[rb][cb] = __builtin_amdgcn_mfma_f32_16x16x32_bf16(wf, bf[rb], acc[rb][cb], 0, 0, 0); }
        }
        const float* psc = p.in[I_PSCALE] + layer * 512;
#pragma unroll
        for (int rb = 0; rb < NRB; ++rb) { const int tr = 16 * rb + c; if (tr < T) { const size_t row = (size_t)rowbase + tr;
#pragma unroll
                for (int cb = 0; cb < 4; ++cb) { const int col = 128 * g + 64 * ch + 16 * cb + 4 * h4;
                    const f32x4 sc = *(const f32x4*)(psc + col); const u32x2 gt = *(const u32x2*)(proj + row * NCOL + C_PGATE + col); const f32x4 a = acc[rb][cb];
                    u32x2 w; w.x = pk2(a[0] * sc.x * siluf_(bflo(gt.x)), a[1] * sc.y * siluf_(bfhi(gt.x))); w.y = pk2(a[2] * sc.z * siluf_(bflo(gt.y)), a[3] * sc.w * siluf_(bfhi(gt.y)));
                    *(u32x2*)(br + row * BR_LD + col) = w; } } }
    }
}

template <int T, bool SAMPLE>
__device__ __forceinline__ void conv_task(const Params& p, int layer, LAS unsigned char* lds, int task, int tid, int wave, int lane) {
    constexpr int R = T + 30, TT = T / 2;
    unsigned char* ws = p.ws;
    const bf16_t* proj = (const bf16_t*)(ws + WS_PROJ); bf16_t* br = (bf16_t*)(ws + WS_BR);
    LAS unsigned* U = (LAS unsigned*)lds;
    LAS float* CO = (LAS float*)(lds + R * 1024);
    int b = 0, t0 = 0, seq = 0, rowbase;
    if (SAMPLE) { seq = task; rowbase = MP + seq * 8; } else { b = task >> 6; t0 = (task & 63) * T; rowbase = b * SEQ + t0; }
    __syncthreads();
    for (int idx = tid; idx < R * 64; idx += NTHREADS) {
        const int row = idx >> 6, c8 = idx & 63; u32x4 w; float* o = nullptr; bool have = true; f32x4 ua, ub;
        if (SAMPLE && row < 30) {
            const float* src = p.in[I_SCONV] + (((size_t)layer * NSEQ + seq) * 30 + row) * 512 + 8 * c8; ua = *(const f32x4*)src; ub = *(const f32x4*)(src + 4);
            if (row >= 8) o = p.out + O_CONVS + (((size_t)layer * NSEQ + seq) * 30 + (row - 8)) * 512 + 8 * c8;
        } else {
            int grow; if (SAMPLE) grow = rowbase + row - 30; else { const int gs = t0 - 30 + row; have = gs >= 0; grow = b * SEQ + gs; }
            if (have) {
                const u32x4 cv = *(const u32x4*)(proj + (size_t)grow * NCOL + C_CVAL + 8 * c8), cg_ = *(const u32x4*)(proj + (size_t)grow * NCOL + C_CGLU + 8 * c8);
                ua = (f32x4){bflo(cv.x) * sigmoidf_(bflo(cg_.x)), bfhi(cv.x) * sigmoidf_(bfhi(cg_.x)), bflo(cv.y) * sigmoidf_(bflo(cg_.y)), bfhi(cv.y) * sigmoidf_(bfhi(cg_.y))};
                ub = (f32x4){bflo(cv.z) * sigmoidf_(bflo(cg_.z)), bfhi(cv.z) * sigmoidf_(bfhi(cg_.z)), bflo(cv.w) * sigmoidf_(bflo(cg_.w)), bfhi(cv.w) * sigmoidf_(bfhi(cg_.w))};
                if (SAMPLE) o = p.out + O_CONVS + (((size_t)layer * NSEQ + seq) * 30 + (row - 8)) * 512 + 8 * c8;
                else { const int gs = t0 - 30 + row; if (gs >= SEQ - 30) o = p.out + O_CONVP + (((size_t)layer * 8 + b) * 30 + (gs - (SEQ - 30))) * 512 + 8 * c8; }
            } else { ua = (f32x4){0.f, 0.f, 0.f, 0.f}; ub = ua; }
        }
        if (o) { *(f32x4*)o = ua; *(f32x4*)(o + 4) = ub; }
        w.x = pk2(ua.x, ua.y); w.y = pk2(ua.z, ua.w); w.z = pk2(ub.x, ub.y); w.w = pk2(ub.z, ub.w);
        *(LAS u32x4*)(U + row * 256 + 4 * c8) = w;
    }
    __syncthreads();
    {
        const int cp = tid & 255, half = tid >> 8;
        const f32x2* cw = (const f32x2*)(p.in[I_CONVW] + (size_t)layer * 31 * 512) + cp;
        f32x2 wk[31];
#pragma unroll
        for (int k = 0; k < 31; ++k) wk[k] = cw[k * 256];
        const f32x2 bias = *((const f32x2*)(p.in[I_CONVB] + layer * 512) + cp);
        f32x2 acc[TT];
#pragma unroll
        for (int t = 0; t < TT; ++t) acc[t] = bias;
#pragma unroll
        for (int j = 0; j < TT + 30; ++j) {
            const unsigned uu = U[(half * TT + j) * 256 + cp]; const f32x2 uv = (f32x2){bflo(uu), bfhi(uu)};
#pragma unroll
            for (int t = 0; t < TT; ++t) { const int k = j - t; if (k >= 0 && k < 31) acc[t] += wk[k] * uv; }
        }
#pragma unroll
        for (int t = 0; t < TT; ++t) *(LAS f32x2*)(CO + (half * TT + t) * 512 + 2 * cp) = acc[t];
    }
    __syncthreads();
    {
        const float* lg = p.in[I_LNG] + layer * 512 + 8 * lane; const float* lb = p.in[I_LNB] + layer * 512 + 8 * lane;
        const f32x4 g0 = *(const f32x4*)lg, g1 = *(const f32x4*)(lg + 4), b0 = *(const f32x4*)lb, b1 = *(const f32x4*)(lb + 4);
        for (int t = wave; t < T; t += 8) {
            const f32x4 x0 = *(const LAS f32x4*)(CO + t * 512 + 8 * lane), x1 = *(const LAS f32x4*)(CO + t * 512 + 8 * lane + 4);
            const float mean = wave_sum((x0.x + x0.y) + (x0.z + x0.w) + (x1.x + x1.y) + (x1.z + x1.w)) * (1.f / 512.f);
            const f32x4 d0 = x0 - mean, d1 = x1 - mean;
            const float var = wave_sum((d0.x * d0.x + d0.y * d0.y) + (d0.z * d0.z + d0.w * d0.w) + (d1.x * d1.x + d1.y * d1.y) + (d1.z * d1.z + d1.w * d1.w)) * (1.f / 512.f);
            const float rstd = 1.0f / sqrtf(var + EPS);
            const f32x4 y0 = d0 * rstd * g0 + b0, y1 = d1 * rstd * g1 + b1;
            const size_t row = (size_t)rowbase + t;
            const u32x4 gt = *(const u32x4*)(proj + row * NCOL + C_CGATE + 8 * lane);
            u32x4 w;
            w.x = pk2(siluf_(y0.x) * siluf_(bflo(gt.x)), siluf_(y0.y) * siluf_(bfhi(gt.x))); w.y = pk2(siluf_(y0.z) * siluf_(bflo(gt.y)), siluf_(y0.w) * siluf_(bfhi(gt.y)));
            w.z = pk2(siluf_(y1.x) * siluf_(bflo(gt.z)), siluf_(y1.y) * siluf_(bfhi(gt.z))); w.w = pk2(siluf_(y1.z) * siluf_(bflo(gt.w)), siluf_(y1.w) * siluf_(bfhi(gt.w)));
            *(u32x4*)(br + row * BR_LD + 512 + 8 * lane) = w;
        }
    }
}

constexpr int KS_STRIDE = 272, VT_STRIDE = 528, VT_OFF = 256 * KS_STRIDE;
template <bool SAMPLE>
__device__ __forceinline__ void attn_task(const Params& p, int layer, LAS unsigned char* lds, int task, int tid, int wave, int lane) {
    unsigned char* ws = p.ws;
    const bf16_t* proj = (const bf16_t*)(ws + WS_PROJ); bf16_t* br = (bf16_t*)(ws + WS_BR);
    int b = 0, head, qc = 0, seq = 0;
    if (SAMPLE) { seq = task >> 2; head = task & 3; } else { b = task >> 5; head = (task >> 3) & 3; qc = task & 7; }
    __syncthreads();
    if (SAMPLE) {
        const float* kb = p.in[I_CK] + (((size_t)layer * NSEQ + seq) * 256) * 512 + head * 128; const float* vb = p.in[I_CV] + (((size_t)layer * NSEQ + seq) * 256) * 512 + head * 128;
#pragma unroll
        for (int i = 0; i < 8; ++i) { const int c = tid + NTHREADS * i, key = c >> 4, dc = c & 15; const float* src = kb + (size_t)key * 512 + dc * 8;
            const f32x4 a = *(const f32x4*)src, c2 = *(const f32x4*)(src + 4); u32x4 w; w.x = pk2(a.x, a.y); w.y = pk2(a.z, a.w); w.z = pk2(c2.x, c2.y); w.w = pk2(c2.z, c2.w);
            *(LAS u32x4*)(lds + key * KS_STRIDE + dc * 16) = w; if ((i & 3) == 3) asm volatile("" ::: "memory"); }
#pragma unroll
        for (int i = 0; i < 8; ++i) { const int it = tid + NTHREADS * i, d = it & 127, ch = it >> 7; const float* src = vb + (size_t)(8 * ch) * 512 + d;
            float v[8];
#pragma unroll
            for (int j = 0; j < 8; ++j) v[j] = src[(size_t)j * 512];
            u32x4 w; w.x = pk2(v[0], v[1]); w.y = pk2(v[2], v[3]); w.z = pk2(v[4], v[5]); w.w = pk2(v[6], v[7]);
            *(LAS u32x4*)(lds + VT_OFF + d * VT_STRIDE + ch * 16) = w; if (i & 1) asm volatile("" ::: "memory"); }
    } else {
        const bf16_t* kb = (const bf16_t*)(ws + WS_KVB) + ((size_t)layer * 2048 + b * 256) * 1024 + head * 128; const bf16_t* vb = kb + 512;
#pragma unroll
        for (int i = 0; i < 8; ++i) { const int c = tid + NTHREADS * i, key = c >> 4, dc = c & 15;
            *(LAS u32x4*)(lds + key * KS_STRIDE + dc * 16) = *(const u32x4*)(kb + (size_t)key * 1024 + dc * 8); }
#pragma unroll
        for (int i = 0; i < 8; ++i) { const int it = tid + NTHREADS * i, d = it & 127, ch = it >> 7; const bf16_t* src = vb + (size_t)(8 * ch) * 1024 + d;
            unsigned v[8];
#pragma unroll
            for (int j = 0; j < 8; ++j) v[j] = src[(size_t)j * 1024];
            u32x4 w; w.x = v[0] | (v[1] << 16); w.y = v[2] | (v[3] << 16); w.z = v[4] | (v[5] << 16); w.w = v[6] | (v[7] << 16);
            *(LAS u32x4*)(lds + VT_OFF + d * VT_STRIDE + ch * 16) = w; if (i & 1) asm volatile("" ::: "memory"); }
    }
    __syncthreads();
    const int h4 = lane >> 4, c = lane & 15;
    const int ntiles = SAMPLE ? 1 : 16, nvalid = SAMPLE ? 8 : 16;
    for (int wt = wave; wt < ntiles; wt += 8) {
        const int qrow0 = SAMPLE ? (MP + seq * 8) : (b * SEQ + qc * 256 + wt * 16);
        const int cr = c < nvalid ? c : nvalid - 1;
        const bf16_t* qrow = proj + (size_t)(qrow0 + cr) * NCOL + C_Q + head * 128 + 8 * h4;
        bf16x8 qf[4];
#pragma unroll
        for (int ks = 0; ks < 4; ++ks) qf[ks] = *(const bf16x8*)(qrow + 32 * ks);
        f32x4 s[16];
#pragma unroll
        for (int nb = 0; nb < 16; ++nb) {
            s[nb] = (f32x4){0.f, 0.f, 0.f, 0.f};
            const int keyrow = 32 * (nb >> 1) + 8 * (c >> 2) + 4 * (nb & 1) + (c & 3);
#pragma unroll
            for (int ks = 0; ks < 4; ++ks) { const bf16x8 kf = *(const LAS bf16x8*)(lds + keyrow * KS_STRIDE + (32 * ks + 8 * h4) * 2);
                s[nb] = __builtin_amdgcn_mfma_f32_16x16x32_bf16(kf, qf[ks], s[nb], 0, 0, 0); }
            if (nb & 1) asm volatile("" ::: "memory");
        }
        float mx = -3.0e38f;
#pragma unroll
        for (int nb = 0; nb < 16; ++nb) mx = fmaxf(fmaxf(fmaxf(s[nb][0], s[nb][1]), fmaxf(s[nb][2], s[nb][3])), mx);
        mx = fmaxf(mx, __shfl_xor(mx, 16)); mx = fmaxf(mx, __shfl_xor(mx, 32));
        const float sc = 0.08838834764831845f * 1.4426950408889634f;
        float sum = 0.f;
#pragma unroll
        for (int nb = 0; nb < 16; ++nb)
#pragma unroll
            for (int i = 0; i < 4; ++i) { const float e = __builtin_amdgcn_exp2f((s[nb][i] - mx) * sc); s[nb][i] = e; sum += e; }
        sum += __shfl_xor(sum, 16); sum += __shfl_xor(sum, 32);
        const float inv = 1.0f / sum;
        bf16x8 pf[8];
#pragma unroll
        for (int si = 0; si < 8; ++si) { u32x4 w; w.x = pk2(s[2 * si][0], s[2 * si][1]); w.y = pk2(s[2 * si][2], s[2 * si][3]); w.z = pk2(s[2 * si + 1][0], s[2 * si + 1][1]); w.w = pk2(s[2 * si + 1][2], s[2 * si + 1][3]);
            pf[si] = __builtin_bit_cast(bf16x8, w); }
#pragma unroll
        for (int nd = 0; nd < 8; ++nd) {
            f32x4 o = (f32x4){0.f, 0.f, 0.f, 0.f};
#pragma unroll
            for (int si = 0; si < 8; ++si) { const bf16x8 vf = *(const LAS bf16x8*)(lds + VT_OFF + (16 * nd + c) * VT_STRIDE + (32 * si + 8 * h4) * 2);
                o = __builtin_amdgcn_mfma_f32_16x16x32_bf16(vf, pf[si], o, 0, 0, 0); }
            if (c < nvalid) { const size_t row = (size_t)qrow0 + c; const int col = head * 128 + 16 * nd + 4 * h4;
                const u32x2 gt = *(const u32x2*)(proj + row * NCOL + C_XGATE + col);
                u32x2 w; w.x = pk2(o[0] * inv * siluf_(bflo(gt.x)), o[1] * inv * siluf_(bfhi(gt.x))); w.y = pk2(o[2] * inv * siluf_(bflo(gt.y)), o[3] * inv * siluf_(bfhi(gt.y)));
                *(u32x2*)(br + row * BR_LD + 1024 + col) = w; }
            asm volatile("" ::: "memory");
        }
    }
}

__global__ void __launch_bounds__(NTHREADS, 2) mk_fwd(Params p) {
    extern __shared__ __attribute__((aligned(16))) unsigned char lds_raw[];
    LAS unsigned char* lds = (LAS unsigned char*)lds_raw;
    cg::grid_group grid = cg::this_grid();
    const int G = gridDim.x, bx = blockIdx.x;
    const int vcu = (G % 8 == 0) ? (bx % 8) * (G / 8) + bx / 8 : bx;
    const int NGW = G * 8;
#define IDS() int tid = threadIdx.x; asm volatile("" : "+v"(tid)); const int lane = tid & 63, wave = __builtin_amdgcn_readfirstlane(tid >> 6), gw = vcu * 8 + wave; (void)gw; (void)lane
    unsigned char* ws = p.ws;
    const int lo = p.ph_lo, hi = p.ph_hi;
#define IN(k) (lo <= (k) && (k) < hi)
#define SEAM(k) do { if (IN(k) && IN((k) + 1)) grid.sync(); } while (0)

    if (IN(0)) { IDS(); p0_prologue(p, lds, gw, NGW, wave, lane); }
    SEAM(0);
#pragma unroll 1
    for (int layer = 0; layer < 2; ++layer) {
        const int pb = 1 + 5 * layer;
        if (IN(pb)) {
            { pg8::Gemm g{(const bf16_t*)(ws + WS_H), (const bf16_t*)(ws + WS_WIN) + (size_t)layer * NCOL * D, D, D, D, 0, 0};
              pg8::Order S; S.init(MT, NCOL, 1, 0, G, bx);
              pg8::EpiStoreBf16 E{(bf16_t*)(ws + WS_PROJ), NCOL};
              pg8::gemm_phase<pg8::EpiStoreBf16>(lds, g, S, E); }
            if (layer == 0) {
              pg8::Gemm g{(const bf16_t*)(ws + WS_MEMN), (const bf16_t*)(ws + WS_WKV), D, D, D, 2048u * D * 2u, (unsigned)D * D * 2u};
              pg8::Order S; S.init(2048, D, 2, 0, G, G - 1 - bx);
              pg8::EpiKV E{p.out + O_MK, p.out + O_MV, (bf16_t*)(ws + WS_KVB)};
              pg8::gemm_phase<pg8::EpiKV>(lds, g, S, E); }
        }
        SEAM(pb);
        if (IN(pb + 1)) {
            IDS();
            for (int t = bx; t < 512; t += G) pool_task<32, false>(p, layer, lds, t, tid, wave, lane);
            for (int t = bx; t < 512; t += G) conv_task<32, false>(p, layer, lds, t, tid, wave, lane);
            for (int t = bx; t < 256; t += G) { if (t < 128) pool_task<8, true>(p, layer, lds, t, tid, wave, lane); else conv_task<8, true>(p, layer, lds, t - 128, tid, wave, lane); }
            for (int t = bx; t < 256; t += G) attn_task<false>(p, layer, lds, t, tid, wave, lane);
            for (int t = bx; t < 512; t += G) attn_task<true>(p, layer, lds, t, tid, wave, lane);
        }
        SEAM(pb + 1);
        if (IN(pb + 2)) {
            pg8::Gemm g{(const bf16_t*)(ws + WS_BR), (const bf16_t*)(ws + WS_WBR) + (size_t)layer * 3 * D * 512, 512, BR_LD, 512, 512u * 2u, (unsigned)D * 512u * 2u};
            pg8::Order S; S.init(MT, D, 3, 1, G, bx);
            pg8::EpiMerge E{(const bf16_t*)(ws + WS_PROJ), (bf16_t*)(ws + WS_MRG)};
            pg8::gemm_phase<pg8::EpiMerge>(lds, g, S, E);
        }
        SEAM(pb + 2);
        if (IN(pb + 3)) {
            pg8::Gemm g{(const bf16_t*)(ws + WS_MRG), (const bf16_t*)(ws + WS_WOUT) + (size_t)layer * D * D, D, D, D, 0, 0};
            pg8::Order S; S.init(MT, D, 1, 0, G, bx);
            pg8::EpiY E{(bf16_t*)(ws + WS_Y), (float*)(ws + WS_SSQ)};
            pg8::gemm_phase<pg8::EpiY>(lds, g, S, E);
        }
        SEAM(pb + 3);
        if (IN(pb + 4)) { IDS(); p5_residual(p, layer, gw, NGW, lane); }
        if (layer == 0) SEAM(pb + 4);
    }
#undef IN
#undef SEAM
#undef IDS
}

extern "C" void kernel_launch(void* const* d_in, const int* in_sizes, int n_in, void* d_out, int out_size, void* d_ws, size_t ws_size, hipStream_t stream) {
    static int grid = 0;
    if (grid == 0) {
        if (n_in != 20 || ws_size < WS_END) { fprintf(stderr, "kernel_launch: expected 20 inputs and >= %zu bytes of workspace (got %d, %zu)\n", (size_t)WS_END, n_in, ws_size); grid = -1; return; }
        int dev = 0, cus = 0, per_cu = 0;
        if (hipGetDevice(&dev) != hipSuccess || hipDeviceGetAttribute(&cus, hipDeviceAttributeMultiprocessorCount, dev) != hipSuccess) { grid = -1; return; }
        if (hipFuncSetAttribute((const void*)mk_fwd, hipFuncAttributeMaxDynamicSharedMemorySize, LDS_BYTES) != hipSuccess) { fprintf(stderr, "kernel_launch: hipFuncSetAttribute failed\n"); grid = -1; return; }
        if (hipOccupancyMaxActiveBlocksPerMultiprocessor(&per_cu, (const void*)mk_fwd, NTHREADS, LDS_BYTES) != hipSuccess || per_cu < 1) { fprintf(stderr, "kernel_launch: occupancy query says %d blocks per CU\n", per_cu); (void)hipGetLastError(); per_cu = 1; }
        grid = cus;
    }
    if (grid < 0) return;
    Params p{};
    for (int i = 0; i < 20; ++i) p.in[i] = (const float*)d_in[i];
    p.out = (float*)d_out; p.ws = (unsigned char*)d_ws;
#if MK_LAUNCHES == 1
    p.ph_lo = 0; p.ph_hi = NPHASES;
    void* args[] = {&p};
    hipError_t e = hipLaunchCooperativeKernel((const void*)mk_fwd, dim3(grid), dim3(NTHREADS), args, LDS_BYTES, stream);
    if (e != hipSuccess) fprintf(stderr, "cooperative launch failed: %s (grid %d)\n", hipGetErrorString(e), grid);
#else
    for (int k = 0; k < NPHASES; ++k) { p.ph_lo = k; p.ph_hi = k + 1; hipLaunchKernelGGL(mk_fwd, dim3(grid), dim3(NTHREADS), LDS_BYTES, stream, p); }
#endif
}
```

```cpp
#include <hip/hip_runtime.h>
#include <hip/hip_cooperative_groups.h>
#include <cstdio>
#include <cstdint>
namespace cg = cooperative_groups;

#define LAS __attribute__((address_space(3)))
typedef unsigned short bf16_t;
typedef short bf16x8 __attribute__((ext_vector_type(8)));
typedef float f32x4 __attribute__((ext_vector_type(4)));
typedef float f32x2 __attribute__((ext_vector_type(2)));
typedef unsigned u32x4 __attribute__((ext_vector_type(4)));
typedef unsigned u32x2 __attribute__((ext_vector_type(2)));

constexpr int D = 1024, NCOL = 6656, MP = 16384, MS = 1024, MT = MP + MS, SEQ = 2048, NSEQ = 128;
constexpr int C_PGATE = 512, C_CVAL = 1024, C_CGLU = 1536, C_CGATE = 2048, C_Q = 2560, C_XGATE = 3072, C_LOGIT = 3584;
constexpr int BR_LD = 1536;
constexpr float EPS = 1e-6f;
constexpr size_t O_POOLP = 17825792, O_CONVP = 17948672, O_MK = 18194432, O_MV = 20291584, O_POOLS = 22388736, O_CONVS = 24354816;
constexpr size_t WS_WIN = 0;
constexpr size_t WS_WKV = WS_WIN + (size_t)2 * NCOL * D * 2;
constexpr size_t WS_WBR = WS_WKV + (size_t)2 * D * D * 2;
constexpr size_t WS_WOUT = WS_WBR + (size_t)6 * D * 512 * 2;
constexpr size_t WS_WPOOL = WS_WOUT + (size_t)2 * D * D * 2;
constexpr size_t WS_H = WS_WPOOL + (size_t)8 * 128 * 128 * 2;
constexpr size_t WS_MEMN = WS_H + (size_t)MT * D * 2;
constexpr size_t WS_PROJ = WS_MEMN + (size_t)2 * 2048 * D * 2;
constexpr size_t WS_KVB = WS_PROJ + (size_t)MT * NCOL * 2;
constexpr size_t WS_BR = WS_KVB + (size_t)2 * 2048 * D * 2;
constexpr size_t WS_MRG = WS_BR + (size_t)MT * BR_LD * 2;
constexpr size_t WS_Y = WS_MRG + (size_t)MT * D * 2;
constexpr size_t WS_SSQ = WS_Y + (size_t)MT * D * 2;
constexpr size_t WS_BAR = WS_SSQ + (size_t)MT * 16 * 4;
constexpr size_t WS_END = WS_BAR + 3456 * 4;
constexpr int LDS_BAR_OFF = 140 * 1024 - 16;
constexpr int LDS_BYTES = 140 * 1024;
constexpr int NTHREADS = 512;

#ifndef MK_LAUNCHES
#define MK_LAUNCHES 1
#endif
constexpr int NPHASES = 11;
constexpr int REP1 = 1, REP2 = 1, REP3 = 1, REP4 = 1;

__device__ __forceinline__ unsigned pk2(float lo, float hi) { unsigned r; asm("v_cvt_pk_bf16_f32 %0, %1, %2" : "=v"(r) : "v"(lo), "v"(hi)); return r; }
__device__ __forceinline__ float bflo(unsigned w) { return __uint_as_float(w << 16); }
__device__ __forceinline__ float bfhi(unsigned w) { return __uint_as_float(w & 0xffff0000u); }
__device__ __forceinline__ float bf1(bf16_t b) { return __uint_as_float(((unsigned)b) << 16); }
__device__ __forceinline__ float sigmoidf_(float x) { return __builtin_amdgcn_rcpf(1.0f + __builtin_amdgcn_exp2f(-1.4426950408889634f * x)); }
__device__ __forceinline__ float siluf_(float x) { return x * sigmoidf_(x); }
__device__ __forceinline__ float wave_sum(float v) {
#pragma unroll
    for (int o = 1; o < 64; o <<= 1) v += __shfl_xor(v, o);
    return v;
}
#define LDS_WAIT() asm volatile("s_waitcnt lgkmcnt(0)" ::: "memory")

namespace pg8 {
constexpr int BM = 256, BK = 64, HALF = 128, HTB = HALF * BK * 2, STAGE_BYTES = 8 * HTB, NXCD = 8, WGM = 8;
__host__ __device__ __forceinline__ int lds_byte(int r, int c) { const int st = (r >> 4) * 2 + (c >> 5), rr = r & 15, cc = c & 31, ob = rr * 64 + cc * 2; return st * 1024 + (ob ^ (((ob >> 9) & 1) << 5)); }
__host__ __device__ __forceinline__ void stage_rc(int b, int& R, int& C) { const int st = b / 1024, sb = b % 1024, swz = sb ^ (((sb >> 9) & 1) << 5); R = (st >> 1) * 16 + swz / 64; C = (st & 1) * 32 + (swz % 64) / 2; }
__host__ __device__ __forceinline__ int perm32(int rho) { const int n = rho >> 4, i = rho & 15; return 8 * (i >> 2) + 4 * n + (i & 3); }

struct Unit { int pm, pn, z; };
struct Gemm { const bf16_t* A; const bf16_t* Bt; int K, lda, ldb; unsigned zA, zB; };

struct Order {
    int nM, nN, ntile, nz, zinner, G, c;
    __device__ void init(int M, int N, int nz_, int zinner_, int G_, int c_) { nM = M / BM; nN = N / BM; ntile = nM * nN; nz = nz_; zinner = zinner_; G = G_; c = c_; }
    __device__ bool next(int i, Unit& u) const {
        int tix, z;
        if (zinner) { tix = (i / nz) * G + c; z = i % nz; if (tix >= ntile) return false; }
        else { const long L = (long)i * G + c; if (L >= (long)ntile * nz) return false; z = (int)(L / ntile); tix = (int)(L % ntile); }
        int wgid = tix; { const int q = ntile / NXCD, r = ntile % NXCD, xcd = wgid % NXCD, off = wgid / NXCD; wgid = (xcd < r ? xcd * (q + 1) : r * (q + 1) + (xcd - r) * q) + off; }
        const int nig = WGM * nN, gid = wgid / nig, fm = gid * WGM, gsz = (nM - fm) < WGM ? (nM - fm) : WGM;
        u.pm = fm + ((wgid % nig) % gsz); u.pn = (wgid % nig) / gsz; u.z = z; return true;
    }
};

struct EpiStoreBf16 {
    static constexpr bool PERM = true;
    bf16_t* O; int ldc;
    __device__ __forceinline__ void operator()(const f32x4 (&acc)[2][2][4][2], const Unit& u, int wr, int wc, int fr, int fq) const {
        const int row0 = u.pm * BM + wr * 64 + fr, col0 = u.pn * BM + wc * 32 + 8 * fq;
#pragma unroll
        for (int ai = 0; ai < 2; ++ai)
#pragma unroll
            for (int m = 0; m < 4; ++m) { bf16_t* rowp = O + (size_t)(row0 + ai * HALF + m * 16) * ldc + col0;
#pragma unroll
                for (int bj = 0; bj < 2; ++bj) { const f32x4 v0 = acc[ai][bj][m][0], v1 = acc[ai][bj][m][1];
                    u32x4 w; w.x = pk2(v0[0], v0[1]); w.y = pk2(v0[2], v0[3]); w.z = pk2(v1[0], v1[1]); w.w = pk2(v1[2], v1[3]);
                    *(u32x4*)(rowp + bj * HALF) = w; } }
    }
};
struct EpiKV {
    static constexpr bool PERM = false;
    float* outK; float* outV; bf16_t* kvb;
    __device__ __forceinline__ void operator()(const f32x4 (&acc)[2][2][4][2], const Unit& u, int wr, int wc, int fr, int fq) const {
        const int row0 = u.pm * BM + wr * 64 + fr, col0 = u.pn * BM + wc * 32 + 4 * fq;
        float* of = (u.pn < 2 ? outK : outV) + (size_t)u.z * 2048 * 512; const int cf0 = col0 & 511;
        bf16_t* ob = kvb + (size_t)u.z * 2048 * 1024;
#pragma unroll
        for (int ai = 0; ai < 2; ++ai)
#pragma unroll
            for (int m = 0; m < 4; ++m) { const int r = row0 + ai * HALF + m * 16;
#pragma unroll
                for (int bj = 0; bj < 2; ++bj)
#pragma unroll
                    for (int n = 0; n < 2; ++n) { const f32x4 v = acc[ai][bj][m][n];
                        *(f32x4*)(of + (size_t)r * 512 + cf0 + bj * HALF + n * 16) = v;
                        u32x2 w; w.x = pk2(v[0], v[1]); w.y = pk2(v[2], v[3]);
                        *(u32x2*)(ob + (size_t)r * 1024 + col0 + bj * HALF + n * 16) = w; } }
    }
};
struct EpiMerge {
    static constexpr bool PERM = true;
    const bf16_t* proj; bf16_t* mrg;
    __device__ __forceinline__ void operator()(const f32x4 (&acc)[2][2][4][2], const Unit& u, int wr, int wc, int fr, int fq) const {
        const int row0 = u.pm * BM + wr * 64 + fr, col0 = u.pn * BM + wc * 32 + 8 * fq;
#pragma unroll
        for (int ai = 0; ai < 2; ++ai)
#pragma unroll
            for (int m = 0; m < 4; ++m) { const int r = row0 + ai * HALF + m * 16;
                const bf16_t* lg = proj + (size_t)r * NCOL + C_LOGIT + u.z * D + col0; bf16_t* mp = mrg + (size_t)r * D + col0;
#pragma unroll
                for (int bj = 0; bj < 2; ++bj) { const f32x4 v0 = acc[ai][bj][m][0], v1 = acc[ai][bj][m][1];
                    const u32x4 g = *(const u32x4*)(lg + bj * HALF);
                    float o[8];
                    o[0] = v0[0] * sigmoidf_(bflo(g.x)); o[1] = v0[1] * sigmoidf_(bfhi(g.x)); o[2] = v0[2] * sigmoidf_(bflo(g.y)); o[3] = v0[3] * sigmoidf_(bfhi(g.y));
                    o[4] = v1[0] * sigmoidf_(bflo(g.z)); o[5] = v1[1] * sigmoidf_(bfhi(g.z)); o[6] = v1[2] * sigmoidf_(bflo(g.w)); o[7] = v1[3] * sigmoidf_(bfhi(g.w));
                    if (u.z != 0) { const u32x4 p = *(const u32x4*)(mp + bj * HALF);
                        o[0] += bflo(p.x); o[1] += bfhi(p.x); o[2] += bflo(p.y); o[3] += bfhi(p.y); o[4] += bflo(p.z); o[5] += bfhi(p.z); o[6] += bflo(p.w); o[7] += bfhi(p.w); }
                    u32x4 w; w.x = pk2(o[0], o[1]); w.y = pk2(o[2], o[3]); w.z = pk2(o[4], o[5]); w.w = pk2(o[6], o[7]);
                    *(u32x4*)(mp + bj * HALF) = w; }
                if (m == 3) asm volatile("" ::: "memory"); }
    }
};
struct EpiY {
    static constexpr bool PERM = true;
    bf16_t* Y; float* ssq;
    __device__ __forceinline__ void operator()(const f32x4 (&acc)[2][2][4][2], const Unit& u, int wr, int wc, int fr, int fq) const {
        const int row0 = u.pm * BM + wr * 64 + fr, col0 = u.pn * BM + wc * 32 + 8 * fq;
#pragma unroll
        for (int ai = 0; ai < 2; ++ai)
#pragma unroll
            for (int m = 0; m < 4; ++m) { const int r = row0 + ai * HALF + m * 16; bf16_t* rowp = Y + (size_t)r * D + col0; float s = 0.f;
#pragma unroll
                for (int bj = 0; bj < 2; ++bj) { const f32x4 v0 = acc[ai][bj][m][0], v1 = acc[ai][bj][m][1];
                    s += (v0[0] * v0[0] + v0[1] * v0[1]) + (v0[2] * v0[2] + v0[3] * v0[3]) + (v1[0] * v1[0] + v1[1] * v1[1]) + (v1[2] * v1[2] + v1[3] * v1[3]);
                    u32x4 w; w.x = pk2(v0[0], v0[1]); w.y = pk2(v0[2], v0[3]); w.z = pk2(v1[0], v1[1]); w.w = pk2(v1[2], v1[3]);
                    *(u32x4*)(rowp + bj * HALF) = w; }
                s += __shfl_xor(s, 16); s += __shfl_xor(s, 32);
                if (fq == 0) ssq[(size_t)r * 16 + u.pn * 4 + wc] = s; }
    }
};

template <class Epi>
__device__ __forceinline__ void gemm_phase(LAS unsigned char* lds, const Gemm g, const Order& S, const Epi& E) {
    int tid = threadIdx.x; asm volatile("" : "+v"(tid));
    const int wid = __builtin_amdgcn_readfirstlane(tid >> 6), lane = tid & 63, wr = wid >> 2, wc = wid & 3, fr = lane & 15, fq = lane >> 4;
    const int K = g.K, nt = K / BK;
    unsigned voffA[2], voffB[2];
#pragma unroll
    for (int i = 0; i < 2; ++i) { int R, C; stage_rc(tid * 16 + i * 8192, R, C); const int Rb = Epi::PERM ? ((R & ~31) + perm32(R & 31)) : R;
        voffA[i] = (unsigned)(R * g.lda + C) * 2u; voffB[i] = (unsigned)(Rb * g.ldb + C) * 2u; }
    constexpr unsigned kstep = BK * 2;
    const unsigned hstepA = (unsigned)HALF * g.lda * 2, hstepB = (unsigned)HALF * g.ldb * 2;
    const unsigned tstepA = 2 * hstepA, tstepB = 2 * hstepB;
    const unsigned ldsw = (unsigned)wid * 1024u;
    const int aoff = lds_byte(wr * 64 + fr, fq * 8), boff = lds_byte(wc * 32 + fr, fq * 8);
#define PG8_SA(b, h) (((b) * 2 + (h)) * HTB)
#define PG8_SB(b, h) ((4 + (b) * 2 + (h)) * HTB)
#define PG8_STAGE(bufoff, gbase, voff) do { _Pragma("unroll") for (int _i = 0; _i < 2; ++_i) \
        __builtin_amdgcn_global_load_lds((const unsigned*)((const char*)(gbase) + (voff)[_i]), (LAS unsigned*)(lds + (bufoff) + ldsw + _i * 8192), 16, 0, 0); } while (0)
#define PG8_LDA(dst, b, h) do { _Pragma("unroll") for (int m = 0; m < 4; ++m) _Pragma("unroll") for (int k = 0; k < 2; ++k) dst[m][k] = *(const LAS bf16x8*)(lds + PG8_SA(b, h) + aoff + m * 2048 + k * 1024); } while (0)
#define PG8_LDB(dst, b, h) do { _Pragma("unroll") for (int n = 0; n < 2; ++n) _Pragma("unroll") for (int k = 0; k < 2; ++k) dst[n][k] = *(const LAS bf16x8*)(lds + PG8_SB(b, h) + boff + n * 2048 + k * 1024); } while (0)
#define PG8_MMA(ai, bj, At, Bt) do { __builtin_amdgcn_s_setprio(1); _Pragma("unroll") for (int m = 0; m < 4; ++m) _Pragma("unroll") for (int n = 0; n < 2; ++n) _Pragma("unroll") for (int k = 0; k < 2; ++k) \
        acc[ai][bj][m][n] = __builtin_amdgcn_mfma_f32_16x16x32_bf16(Bt[n][k], At[m][k], acc[ai][bj][m][n], 0, 0, 0); __builtin_amdgcn_s_setprio(0); } while (0)
#define PG8_WAIT_V(n) asm volatile("s_waitcnt vmcnt(" #n ")" ::: "memory")
#define PG8_WAIT_L(n) asm volatile("s_waitcnt lgkmcnt(" #n ")" ::: "memory")
#define PG8_BAR __builtin_amdgcn_s_barrier()
#define PG8_SCHED __builtin_amdgcn_sched_barrier(0)
    Unit cur, nxt; int ui = 0;
    if (!S.next(0, cur)) return;
    f32x4 acc[2][2][4][2];
#pragma unroll
    for (int a = 0; a < 2; ++a)
#pragma unroll
        for (int b = 0; b < 2; ++b)
#pragma unroll
            for (int m = 0; m < 4; ++m)
#pragma unroll
                for (int n = 0; n < 2; ++n) acc[a][b][m][n] = (f32x4){0.f, 0.f, 0.f, 0.f};
    bf16x8 At[4][2], B0[2][2], B1[2][2];
    const char* cA = (const char*)g.A + (size_t)((unsigned)cur.pm * tstepA + (unsigned)cur.z * g.zA); const char* cB = (const char*)g.Bt + (size_t)((unsigned)cur.pn * tstepB + (unsigned)cur.z * g.zB);
    PG8_STAGE(PG8_SB(0, 0), cB, voffB); PG8_STAGE(PG8_SB(0, 1), cB + hstepB, voffB); PG8_STAGE(PG8_SA(0, 0), cA, voffA); PG8_STAGE(PG8_SA(0, 1), cA + hstepA, voffA);
    if (wr == 1) PG8_BAR;
    PG8_WAIT_V(2); PG8_BAR;
    PG8_STAGE(PG8_SB(1, 0), cB + kstep, voffB); PG8_STAGE(PG8_SA(1, 0), cA + kstep, voffA); PG8_STAGE(PG8_SB(1, 1), cB + hstepB + kstep, voffB);
    PG8_WAIT_V(6); PG8_BAR;
    for (;;) {
        const bool has_next = S.next(ui + 1, nxt);
        const char* nA = has_next ? (const char*)g.A + (size_t)((unsigned)nxt.pm * tstepA + (unsigned)nxt.z * g.zA) : cA;
        const char* nB = has_next ? (const char*)g.Bt + (size_t)((unsigned)nxt.pn * tstepB + (unsigned)nxt.z * g.zB) : cB;
        for (int t = 0; t < nt; t += 2) {
            const bool last = (t == nt - 2);
            const char* a1 = cA + (unsigned)(t + 1) * kstep;
            const char* a2 = last ? nA : cA + (unsigned)(t + 2) * kstep; const char* b2 = last ? nB : cB + (unsigned)(t + 2) * kstep;
            const char* a3 = a2 + kstep; const char* b3 = b2 + kstep;
            PG8_LDB(B0, 0, 0); PG8_LDB(B1, 0, 1); PG8_SCHED; PG8_LDA(At, 0, 0); PG8_STAGE(PG8_SA(1, 1), a1 + hstepA, voffA);
            PG8_WAIT_V(8); PG8_WAIT_L(0); PG8_BAR; PG8_MMA(0, 0, At, B0); PG8_MMA(0, 1, At, B1); PG8_BAR; PG8_SCHED;
            PG8_LDA(At, 0, 1); PG8_STAGE(PG8_SB(0, 0), b2, voffB); PG8_STAGE(PG8_SB(0, 1), b2 + hstepB, voffB); PG8_STAGE(PG8_SA(0, 0), a2, voffA);
            PG8_WAIT_V(8); PG8_WAIT_L(0); PG8_BAR; PG8_MMA(1, 0, At, B0); PG8_MMA(1, 1, At, B1); PG8_BAR; PG8_SCHED;
            PG8_LDB(B0, 1, 0); PG8_LDB(B1, 1, 1); PG8_SCHED; PG8_LDA(At, 1, 0); PG8_STAGE(PG8_SA(0, 1), a2 + hstepA, voffA);
            PG8_WAIT_V(8); PG8_WAIT_L(0); PG8_BAR; PG8_MMA(0, 0, At, B0); PG8_MMA(0, 1, At, B1); PG8_BAR; PG8_SCHED;
            PG8_LDA(At, 1, 1); PG8_STAGE(PG8_SB(1, 0), b3, voffB); PG8_STAGE(PG8_SB(1, 1), b3 + hstepB, voffB); PG8_STAGE(PG8_SA(1, 0), a3, voffA);
            PG8_WAIT_V(8); PG8_WAIT_L(0); PG8_BAR; PG8_MMA(1, 0, At, B0); PG8_MMA(1, 1, At, B1); PG8_BAR; PG8_SCHED;
        }
        if (wr == 0) PG8_BAR;
        E(acc, cur, wr, wc, fr, fq);
        if (!has_next) break;
#pragma unroll
        for (int a = 0; a < 2; ++a)
#pragma unroll
            for (int b = 0; b < 2; ++b)
#pragma unroll
                for (int m = 0; m < 4; ++m)
#pragma unroll
                    for (int n = 0; n < 2; ++n) acc[a][b][m][n] = (f32x4){0.f, 0.f, 0.f, 0.f};
        cur = nxt; cA = nA; cB = nB; ++ui;
        if (wr == 1) PG8_BAR;
    }
    PG8_WAIT_V(0);
    PG8_BAR;
#undef PG8_SA
#undef PG8_SB
#undef PG8_STAGE
#undef PG8_LDA
#undef PG8_LDB
#undef PG8_MMA
#undef PG8_WAIT_V
#undef PG8_WAIT_L
#undef PG8_BAR
#undef PG8_SCHED
}
}


#define XB_TMO      128
#define XB_XCNT(j)  (256  + 64 * (j))
#define XB_XSUB(j)  (1280 + 64 * (j))
#define XB_XGEN(j)  (2304 + 64 * (j))
#define XB_TOP      3328
#define XB_TOPGEN   3392
#define XCD_BAR_WORDS 3456
#define XB_SPIN_CAP (1u << 22)
__device__ __forceinline__ unsigned xb_ld(unsigned* p)              { return __hip_atomic_load(p, __ATOMIC_RELAXED, __HIP_MEMORY_SCOPE_AGENT); }
__device__ __forceinline__ unsigned xb_add(unsigned* p, unsigned v) { return __hip_atomic_fetch_add(p, v, __ATOMIC_RELAXED, __HIP_MEMORY_SCOPE_AGENT); }
__device__ __forceinline__ unsigned xb_xcc_id() { return (unsigned)__builtin_amdgcn_s_getreg((3 << 11) | 20) & 0xFu; }
#define XB_SPIN(cond, bar) do { unsigned _sp = 0; while (cond) { __builtin_amdgcn_s_sleep(1); \
    if ((++_sp & 255u) == 0u) { if (xb_ld(&(bar)[XB_TMO])) break; if (_sp > XB_SPIN_CAP) { atomicAdd(&(bar)[XB_TMO], 1u); break; } } } } while (0)
struct XcdBarrier { unsigned* bar; unsigned x; volatile LAS unsigned* st; };
__device__ __forceinline__ XcdBarrier xcd_barrier_post(unsigned* bar, volatile LAS unsigned* st) {
    XcdBarrier b; b.bar = bar; b.x = xb_xcc_id(); b.st = st;
    if (threadIdx.x == 0) (void)xb_add(&bar[XB_XCNT(b.x)], 1u);
    return b;
}
__device__ __forceinline__ void xcd_barrier_complete(unsigned* bar, unsigned x, unsigned& nloc, unsigned& nx) {
    const unsigned G = gridDim.x * gridDim.y * gridDim.z;
    unsigned sum, cnt, mine, sp = 0u;
    for (;;) {
        sum = 0u; cnt = 0u; mine = 0u;
#pragma unroll
        for (unsigned j = 0; j < 16; ++j) { const unsigned c = xb_ld(&bar[XB_XCNT(j)]); sum += c; cnt += (c > 0u) ? 1u : 0u; mine = (j == x) ? c : mine; }
        if (sum == G) break;
        __builtin_amdgcn_s_sleep(1);
        if ((++sp & 255u) == 0u) { if (xb_ld(&bar[XB_TMO])) break; if (sp > XB_SPIN_CAP) { atomicAdd(&bar[XB_TMO], 1u); break; } }
    }
    nloc = mine > 0u ? mine : 1u; nx = cnt > 0u ? cnt : 1u;
}
__device__ __forceinline__ void xcd_barrier(const XcdBarrier& b) {
    asm volatile("s_waitcnt vmcnt(0)" ::: "memory");
    __syncthreads();
    if (threadIdx.x == 0) {
        unsigned* bar = b.bar;
        __builtin_amdgcn_s_waitcnt(0);
        unsigned nloc = b.st[0], nx = b.st[1];
        if (nloc == 0u) { xcd_barrier_complete(bar, b.x, nloc, nx); b.st[0] = nloc; b.st[1] = nx; }
        const unsigned old = xb_add(&bar[XB_XSUB(b.x)], 1u);
        const unsigned gen = old / nloc;
        if (old + 1u == (gen + 1u) * nloc) {
            __builtin_amdgcn_fence(__ATOMIC_RELEASE, "agent");
            asm volatile("s_waitcnt vmcnt(0)" ::: "memory");
            const unsigned og = xb_add(&bar[XB_TOP], 1u);
            const unsigned tg = og / nx;
            if (og + 1u == (tg + 1u) * nx) xb_add(&bar[XB_TOPGEN], 1u);
            else XB_SPIN(xb_ld(&bar[XB_TOPGEN]) == tg, bar);
            __builtin_amdgcn_fence(__ATOMIC_ACQUIRE, "agent");
            xb_add(&bar[XB_XGEN(b.x)], 1u);
            asm volatile("s_waitcnt vmcnt(0)" ::: "memory");
        } else {
            XB_SPIN(xb_ld(&bar[XB_XGEN(b.x)]) == gen, bar);
            __builtin_amdgcn_fence(__ATOMIC_ACQUIRE, "agent");
            asm volatile("s_waitcnt vmcnt(0)" ::: "memory");
        }
    }
    __syncthreads();
}

struct Params { const float* in[20]; float* out; unsigned char* ws; int ph_lo, ph_hi, use_cg, pad; };
enum { I_XP = 0, I_XS, I_SPOOL, I_SCONV, I_CK, I_CV, I_MEM, I_NPRE, I_NPOST, I_MNORM, I_WKV, I_WIN, I_POOLW, I_PSCALE, I_CONVW, I_CONVB, I_LNG, I_LNB, I_WBR, I_WOUT };

__device__ __forceinline__ void transpose_item(const float* W, int K, int N, bf16_t* WT, LAS float* scr, int item, int lane) {
    const int nblk = N / 32, kb = item / nblk, nb = item % nblk, k0 = 64 * kb, n0 = 32 * nb;
    const int kk = lane >> 3, n4 = (lane & 7) * 4;
    f32x4 v[8];
#pragma unroll
    for (int i = 0; i < 8; ++i) v[i] = *(const f32x4*)(W + (size_t)(k0 + kk + 8 * i) * N + n0 + n4);
#pragma unroll
    for (int i = 0; i < 8; ++i) { LAS float* d = scr + (kk + 8 * i) * 33 + n4; d[0] = v[i].x; d[1] = v[i].y; d[2] = v[i].z; d[3] = v[i].w; }
    LDS_WAIT();
    const int c = lane & 7;
#pragma unroll
    for (int j = 0; j < 4; ++j) { const int n = (lane >> 3) + 8 * j; const LAS float* s = scr + (8 * c) * 33 + n;
        u32x4 o; o.x = pk2(s[0 * 33], s[1 * 33]); o.y = pk2(s[2 * 33], s[3 * 33]); o.z = pk2(s[4 * 33], s[5 * 33]); o.w = pk2(s[6 * 33], s[7 * 33]);
        *(u32x4*)(WT + (size_t)(n0 + n) * K + k0 + 8 * c) = o; }
    LDS_WAIT();
}

__device__ __forceinline__ void p0_prologue(const Params& p, LAS unsigned char* lds, int gw, int NGW, int wave, int lane) {
    LAS float* scr = (LAS float*)(lds + wave * 8704);
    unsigned char* ws = p.ws;
    constexpr int I_IN = (D / 64) * (NCOL / 32), I_SQ = (D / 64) * (D / 32), I_BR = (512 / 64) * (D / 32), I_PL = 2 * 4;
    constexpr int NITEMS = 2 * I_IN + 2 * I_SQ + 6 * I_BR + 2 * I_SQ + 8 * I_PL;
    for (int it = gw; it < NITEMS; it += NGW) {
        int r = it;
        if (r < 2 * I_IN) { const int l = r / I_IN; transpose_item(p.in[I_WIN] + (size_t)l * D * NCOL, D, NCOL, (bf16_t*)(ws + WS_WIN) + (size_t)l * NCOL * D, scr, r % I_IN, lane); continue; } r -= 2 * I_IN;
        if (r < 2 * I_SQ) { const int l = r / I_SQ; transpose_item(p.in[I_WKV] + (size_t)l * D * D, D, D, (bf16_t*)(ws + WS_WKV) + (size_t)l * D * D, scr, r % I_SQ, lane); continue; } r -= 2 * I_SQ;
        if (r < 6 * I_BR) { const int l = r / I_BR; transpose_item(p.in[I_WBR] + (size_t)l * 512 * D, 512, D, (bf16_t*)(ws + WS_WBR) + (size_t)l * D * 512, scr, r % I_BR, lane); continue; } r -= 6 * I_BR;
        if (r < 2 * I_SQ) { const int l = r / I_SQ; transpose_item(p.in[I_WOUT] + (size_t)l * D * D, D, D, (bf16_t*)(ws + WS_WOUT) + (size_t)l * D * D, scr, r % I_SQ, lane); continue; } r -= 2 * I_SQ;
        { const int l = r / I_PL; transpose_item(p.in[I_POOLW] + (size_t)l * 128 * 128, 128, 128, (bf16_t*)(ws + WS_WPOOL) + (size_t)l * 128 * 128, scr, r % I_PL, lane); }
    }
    const float* g0 = p.in[I_NPRE];
    for (int m0 = gw; m0 < MT; m0 += 2 * NGW) {
        f32x4 v[2][4]; float s[2];
#pragma unroll
        for (int r = 0; r < 2; ++r) { const int mm = m0 + r * NGW, m = mm < MT ? mm : MT - 1;
            const float* xrow = (m < MP) ? p.in[I_XP] + (size_t)m * D : p.in[I_XS] + (size_t)(m - MP) * D; const f32x4* xr = (const f32x4*)xrow + lane;
#pragma unroll
            for (int j = 0; j < 4; ++j) v[r][j] = xr[64 * j]; }
#pragma unroll
        for (int r = 0; r < 2; ++r) { float t = 0.f;
#pragma unroll
            for (int j = 0; j < 4; ++j) t += (v[r][j].x * v[r][j].x + v[r][j].y * v[r][j].y) + (v[r][j].z * v[r][j].z + v[r][j].w * v[r][j].w);
            s[r] = 1.0f / sqrtf(wave_sum(t) * (1.f / D) + EPS); }
#pragma unroll
        for (int r = 0; r < 2; ++r) { const int mm = m0 + r * NGW; if (mm < MT) { u32x2* o = (u32x2*)((bf16_t*)(ws + WS_H) + (size_t)mm * D) + lane; const float rs = s[r];
#pragma unroll
            for (int j = 0; j < 4; ++j) { const f32x4 g = ((const f32x4*)g0)[lane + 64 * j]; u32x2 w; w.x = pk2(v[r][j].x * rs * g.x, v[r][j].y * rs * g.y); w.y = pk2(v[r][j].z * rs * g.z, v[r][j].w * rs * g.w); o[64 * j] = w; } } }
    }
    for (int m = gw; m < 2048; m += NGW) {
        const f32x4* xr = (const f32x4*)(p.in[I_MEM] + (size_t)m * D) + lane; f32x4 v[4]; float s = 0.f;
#pragma unroll
        for (int j = 0; j < 4; ++j) { v[j] = xr[64 * j]; s += (v[j].x * v[j].x + v[j].y * v[j].y) + (v[j].z * v[j].z + v[j].w * v[j].w); }
        const float rs = 1.0f / sqrtf(wave_sum(s) * (1.f / D) + EPS);
#pragma unroll
        for (int l = 0; l < 2; ++l) { u32x2* o = (u32x2*)((bf16_t*)(ws + WS_MEMN) + ((size_t)l * 2048 + m) * D) + lane;
#pragma unroll
            for (int j = 0; j < 4; ++j) { const f32x4 g = ((const f32x4*)(p.in[I_MNORM] + l * D))[lane + 64 * j]; u32x2 w; w.x = pk2(v[j].x * rs * g.x, v[j].y * rs * g.y); w.y = pk2(v[j].z * rs * g.z, v[j].w * rs * g.w); o[64 * j] = w; } }
    }
}

__device__ __forceinline__ void p5_residual(const Params& p, int layer, int gw, int NGW, int lane) {
    unsigned char* ws = p.ws;
    const bf16_t* Y = (const bf16_t*)(ws + WS_Y); const float* ssq = (const float*)(ws + WS_SSQ);
    const f32x4* gp = (const f32x4*)(p.in[I_NPOST] + layer * D); const f32x4* gn = (const f32x4*)(p.in[I_NPRE] + D);
    for (int m0 = gw; m0 < MT; m0 += 2 * NGW) {
        f32x4 x[2][4]; u32x2 y[2][4]; float sp[2];
#pragma unroll
        for (int r = 0; r < 2; ++r) { const int mm = m0 + r * NGW, m = mm < MT ? mm : MT - 1;
            const float* xrow = (layer == 0) ? ((m < MP) ? p.in[I_XP] + (size_t)m * D : p.in[I_XS] + (size_t)(m - MP) * D) : p.out + (size_t)m * D;
            sp[r] = (lane < 16) ? ssq[(size_t)m * 16 + lane] : 0.f;
            const f32x4* xr = (const f32x4*)xrow + lane; const u32x2* yr = (const u32x2*)(Y + (size_t)m * D) + lane;
#pragma unroll
            for (int j = 0; j < 4; ++j) { x[r][j] = xr[64 * j]; y[r][j] = yr[64 * j]; } }
#pragma unroll
        for (int r = 0; r < 2; ++r) { const int mm = m0 + r * NGW;
            const float rs = 1.0f / sqrtf(wave_sum(sp[r]) * (1.f / D) + EPS); float s = 0.f;
#pragma unroll
            for (int j = 0; j < 4; ++j) { const f32x4 g = gp[lane + 64 * j]; f32x4& v = x[r][j]; const u32x2 yy = y[r][j];
                v.x += bflo(yy.x) * rs * g.x; v.y += bfhi(yy.x) * rs * g.y; v.z += bflo(yy.y) * rs * g.z; v.w += bfhi(yy.y) * rs * g.w;
                s += (v.x * v.x + v.y * v.y) + (v.z * v.z + v.w * v.w); }
            if (mm < MT) {
                f32x4* orow = (f32x4*)(p.out + (size_t)mm * D) + lane;
#pragma unroll
                for (int j = 0; j < 4; ++j) orow[64 * j] = x[r][j];
            }
            if (layer == 0) {
                const float r2 = 1.0f / sqrtf(wave_sum(s) * (1.f / D) + EPS);
                if (mm < MT) { u32x2* o = (u32x2*)((bf16_t*)(ws + WS_H) + (size_t)mm * D) + lane;
#pragma unroll
                    for (int j = 0; j < 4; ++j) { const f32x4 g = gn[lane + 64 * j]; const f32x4 v = x[r][j]; u32x2 w; w.x = pk2(v.x * r2 * g.x, v.y * r2 * g.y); w.y = pk2(v.z * r2 * g.z, v.w * r2 * g.w); o[64 * j] = w; } }
            }
        }
    }
}

template <int T, bool SAMPLE>
__device__ __forceinline__ void pool_task(const Params& p, int layer, LAS unsigned char* lds, int task, int tid, int wave, int lane) {
    constexpr int R = T + 15, NRB = (T + 15) / 16;
    unsigned char* ws = p.ws;
    const bf16_t* proj = (const bf16_t*)(ws + WS_PROJ); bf16_t* br = (bf16_t*)(ws + WS_BR);
    LAS unsigned* PE = (LAS unsigned*)lds;
    LAS unsigned* MX = (LAS unsigned*)(lds + R * 1024);
    int b = 0, t0 = 0, seq = 0, rowbase;
    if (SAMPLE) { seq = task; rowbase = MP + seq * 8; } else { b = task >> 6; t0 = (task & 63) * T; rowbase = b * SEQ + t0; }
    __syncthreads();
    for (int idx = tid; idx < R * 64; idx += NTHREADS) {
        const int row = idx >> 6, c8 = idx & 63; u32x4 w;
        if (SAMPLE) {
            if (row < 15) { const float* src = p.in[I_SPOOL] + (((size_t)layer * NSEQ + seq) * 15 + row) * 512 + 8 * c8; const f32x4 a = *(const f32x4*)src, c = *(const f32x4*)(src + 4);
                w.x = pk2(a.x, a.y); w.y = pk2(a.z, a.w); w.z = pk2(c.x, c.y); w.w = pk2(c.z, c.w);
                if (row >= 8) { float* o = p.out + O_POOLS + (((size_t)layer * NSEQ + seq) * 15 + (row - 8)) * 512 + 8 * c8; *(f32x4*)o = a; *(f32x4*)(o + 4) = c; } }
            else { w = *(const u32x4*)(proj + (size_t)(rowbase + row - 15) * NCOL + 8 * c8);
                float* o = p.out + O_POOLS + (((size_t)layer * NSEQ + seq) * 15 + (row - 8)) * 512 + 8 * c8;
                *(f32x4*)o = (f32x4){bflo(w.x), bfhi(w.x), bflo(w.y), bfhi(w.y)}; *(f32x4*)(o + 4) = (f32x4){bflo(w.z), bfhi(w.z), bflo(w.w), bfhi(w.w)}; }
        } else {
            const int grow = t0 - 15 + row;
            if (grow < 0) w = (u32x4){0u, 0u, 0u, 0u};
            else { w = *(const u32x4*)(proj + (size_t)(b * SEQ + grow) * NCOL + 8 * c8);
                if (grow >= SEQ - 15) { float* o = p.out + O_POOLP + (((size_t)layer * 8 + b) * 15 + (grow - (SEQ - 15))) * 512 + 8 * c8;
                    *(f32x4*)o = (f32x4){bflo(w.x), bfhi(w.x), bflo(w.y), bfhi(w.y)}; *(f32x4*)(o + 4) = (f32x4){bflo(w.z), bfhi(w.z), bflo(w.w), bfhi(w.w)}; } }
        }
        *(LAS u32x4*)(PE + row * 256 + 4 * c8) = w;
    }
    __syncthreads();
    for (int idx = tid; idx < T * 256; idx += NTHREADS) {
        const int t = idx >> 8, cp = idx & 255, g = cp >> 6, win = 2 << g;
        float s0 = 0.f, s1 = 0.f;
        for (int j = 0; j < win; ++j) { const unsigned w = PE[(15 + t - j) * 256 + cp]; s0 += bflo(w); s1 += bfhi(w); }
        const unsigned cur = PE[(15 + t) * 256 + cp];
        float cnt = (float)win; if (!SAMPLE) { const int pp = t0 + t + 1; cnt = (float)(pp < win ? pp : win); }
        const float inv = 1.0f / cnt;
        MX[t * 260 + cp] = pk2(s0 * inv - bflo(cur), s1 * inv - bfhi(cur));
    }
    __syncthreads();
    {
        const int g = wave >> 1, ch = wave & 1, h4 = lane >> 4, c = lane & 15;
        const bf16_t* wt = (const bf16_t*)(ws + WS_WPOOL) + ((size_t)(layer * 4 + g) * 128 + 64 * ch) * 128;
        f32x4 acc[NRB][4];
#pragma unroll
        for (int rb = 0; rb < NRB; ++rb)
#pragma unroll
            for (int cb = 0; cb < 4; ++cb) acc[rb][cb] = (f32x4){0.f, 0.f, 0.f, 0.f};
#pragma unroll
        for (int ks = 0; ks < 4; ++ks) {
            bf16x8 bf[NRB];
#pragma unroll
            for (int rb = 0; rb < NRB; ++rb) bf[rb] = *(const LAS bf16x8*)((LAS unsigned char*)MX + (16 * rb + c) * 1040 + (128 * g + 32 * ks + 8 * h4) * 2);
#pragma unroll
            for (int cb = 0; cb < 4; ++cb) { const bf16x8 wf = *(const bf16x8*)(wt + (size_t)(16 * cb + c) * 128 + 32 * ks + 8 * h4);
#pragma unroll
                for (int rb = 0; rb < NRB; ++rb) acc[rb][cb] = __builtin_amdgcn_mfma_f32_16x16x32_bf16(wf, bf[rb], acc[rb][cb], 0, 0, 0); }
        }
        const float* psc = p.in[I_PSCALE] + layer * 512;
#pragma unroll
        for (int rb = 0; rb < NRB; ++rb) { const int tr = 16 * rb + c; if (tr < T) { const size_t row = (size_t)rowbase + tr;
#pragma unroll
                for (int cb = 0; cb < 4; ++cb) { const int col = 128 * g + 64 * ch + 16 * cb + 4 * h4;
                    const f32x4 sc = *(const f32x4*)(psc + col); const u32x2 gt = *(const u32x2*)(proj + row * NCOL + C_PGATE + col); const f32x4 a = acc[rb][cb];
                    u32x2 w; w.x = pk2(a[0] * sc.x * siluf_(bflo(gt.x)), a[1] * sc.y * siluf_(bfhi(gt.x))); w.y = pk2(a[2] * sc.z * siluf_(bflo(gt.y)), a[3] * sc.w * siluf_(bfhi(gt.y)));
                    *(u32x2*)(br + row * BR_LD + col) = w; } } }
    }
}

template <int T, bool SAMPLE>
__device__ __forceinline__ void conv_task(const Params& p, int layer, LAS unsigned char* lds, int task, int tid, int wave, int lane) {
    constexpr int R = T + 30, TT = T / 2;
    unsigned char* ws = p.ws;
    const bf16_t* proj = (const bf16_t*)(ws + WS_PROJ); bf16_t* br = (bf16_t*)(ws + WS_BR);
    LAS unsigned* U = (LAS unsigned*)lds;
    LAS float* CO = (LAS float*)(lds + R * 1024);
    int b = 0, t0 = 0, seq = 0, rowbase;
    if (SAMPLE) { seq = task; rowbase = MP + seq * 8; } else { b = task >> 6; t0 = (task & 63) * T; rowbase = b * SEQ + t0; }
    __syncthreads();
    for (int idx = tid; idx < R * 64; idx += NTHREADS) {
        const int row = idx >> 6, c8 = idx & 63; u32x4 w; float* o = nullptr; bool have = true; f32x4 ua, ub;
        if (SAMPLE && row < 30) {
            const float* src = p.in[I_SCONV] + (((size_t)layer * NSEQ + seq) * 30 + row) * 512 + 8 * c8; ua = *(const f32x4*)src; ub = *(const f32x4*)(src + 4);
            if (row >= 8) o = p.out + O_CONVS + (((size_t)layer * NSEQ + seq) * 30 + (row - 8)) * 512 + 8 * c8;
        } else {
            int grow; if (SAMPLE) grow = rowbase + row - 30; else { const int gs = t0 - 30 + row; have = gs >= 0; grow = b * SEQ + gs; }
            if (have) {
                const u32x4 cv = *(const u32x4*)(proj + (size_t)grow * NCOL + C_CVAL + 8 * c8), cg_ = *(const u32x4*)(proj + (size_t)grow * NCOL + C_CGLU + 8 * c8);
                ua = (f32x4){bflo(cv.x) * sigmoidf_(bflo(cg_.x)), bfhi(cv.x) * sigmoidf_(bfhi(cg_.x)), bflo(cv.y) * sigmoidf_(bflo(cg_.y)), bfhi(cv.y) * sigmoidf_(bfhi(cg_.y))};
                ub = (f32x4){bflo(cv.z) * sigmoidf_(bflo(cg_.z)), bfhi(cv.z) * sigmoidf_(bfhi(cg_.z)), bflo(cv.w) * sigmoidf_(bflo(cg_.w)), bfhi(cv.w) * sigmoidf_(bfhi(cg_.w))};
                if (SAMPLE) o = p.out + O_CONVS + (((size_t)layer * NSEQ + seq) * 30 + (row - 8)) * 512 + 8 * c8;
                else { const int gs = t0 - 30 + row; if (gs >= SEQ - 30) o = p.out + O_CONVP + (((size_t)layer * 8 + b) * 30 + (gs - (SEQ - 30))) * 512 + 8 * c8; }
            } else { ua = (f32x4){0.f, 0.f, 0.f, 0.f}; ub = ua; }
        }
        if (o) { *(f32x4*)o = ua; *(f32x4*)(o + 4) = ub; }
        w.x = pk2(ua.x, ua.y); w.y = pk2(ua.z, ua.w); w.z = pk2(ub.x, ub.y); w.w = pk2(ub.z, ub.w);
        *(LAS u32x4*)(U + row * 256 + 4 * c8) = w;
    }
    __syncthreads();
    {
        const int cp = tid & 255, half = tid >> 8;
        const f32x2* cw = (const f32x2*)(p.in[I_CONVW] + (size_t)layer * 31 * 512) + cp;
        f32x2 wk[31];
#pragma unroll
        for (int k = 0; k < 31; ++k) wk[k] = cw[k * 256];
        const f32x2 bias = *((const f32x2*)(p.in[I_CONVB] + layer * 512) + cp);
        f32x2 acc[TT];
#pragma unroll
        for (int t = 0; t < TT; ++t) acc[t] = bias;
#pragma unroll
        for (int j = 0; j < TT + 30; ++j) {
            const unsigned uu = U[(half * TT + j) * 256 + cp]; const f32x2 uv = (f32x2){bflo(uu), bfhi(uu)};
#pragma unroll
            for (int t = 0; t < TT; ++t) { const int k = j - t; if (k >= 0 && k < 31) acc[t] += wk[k] * uv; }
        }
#pragma unroll
        for (int t = 0; t < TT; ++t) *(LAS f32x2*)(CO + (half * TT + t) * 512 + 2 * cp) = acc[t];
    }
    __syncthreads();
    {
        const float* lg = p.in[I_LNG] + layer * 512 + 8 * lane; const float* lb = p.in[I_LNB] + layer * 512 + 8 * lane;
        const f32x4 g0 = *(const f32x4*)lg, g1 = *(const f32x4*)(lg + 4), b0 = *(const f32x4*)lb, b1 = *(const f32x4*)(lb + 4);
        for (int t = wave; t < T; t += 8) {
            const f32x4 x0 = *(const LAS f32x4*)(CO + t * 512 + 8 * lane), x1 = *(const LAS f32x4*)(CO + t * 512 + 8 * lane + 4);
            const float mean = wave_sum((x0.x + x0.y) + (x0.z + x0.w) + (x1.x + x1.y) + (x1.z + x1.w)) * (1.f / 512.f);
            const f32x4 d0 = x0 - mean, d1 = x1 - mean;
            const float var = wave_sum((d0.x * d0.x + d0.y * d0.y) + (d0.z * d0.z + d0.w * d0.w) + (d1.x * d1.x + d1.y * d1.y) + (d1.z * d1.z + d1.w * d1.w)) * (1.f / 512.f);
            const float rstd = 1.0f / sqrtf(var + EPS);
            const f32x4 y0 = d0 * rstd * g0 + b0, y1 = d1 * rstd * g1 + b1;
            const size_t row = (size_t)rowbase + t;
            const u32x4 gt = *(const u32x4*)(proj + row * NCOL + C_CGATE + 8 * lane);
            u32x4 w;
            w.x = pk2(siluf_(y0.x) * siluf_(bflo(gt.x)), siluf_(y0.y) * siluf_(bfhi(gt.x))); w.y = pk2(siluf_(y0.z) * siluf_(bflo(gt.y)), siluf_(y0.w) * siluf_(bfhi(gt.y)));
            w.z = pk2(siluf_(y1.x) * siluf_(bflo(gt.z)), siluf_(y1.y) * siluf_(bfhi(gt.z))); w.w = pk2(siluf_(y1.z) * siluf_(bflo(gt.w)), siluf_(y1.w) * siluf_(bfhi(gt.w)));
            *(u32x4*)(br + row * BR_LD + 512 + 8 * lane) = w;
        }
    }
}

constexpr int KS_STRIDE = 272, VT_STRIDE = 528, VT_OFF = 256 * KS_STRIDE;
template <bool SAMPLE>
__device__ __forceinline__ void attn_task(const Params& p, int layer, LAS unsigned char* lds, int task, int tid, int wave, int lane) {
    unsigned char* ws = p.ws;
    const bf16_t* proj = (const bf16_t*)(ws + WS_PROJ); bf16_t* br = (bf16_t*)(ws + WS_BR);
    int b = 0, head, qc = 0, seq = 0;
    if (SAMPLE) { seq = task >> 2; head = task & 3; } else { b = task >> 5; head = (task >> 3) & 3; qc = task & 7; }
    __syncthreads();
    if (SAMPLE) {
        const float* kb = p.in[I_CK] + (((size_t)layer * NSEQ + seq) * 256) * 512 + head * 128; const float* vb = p.in[I_CV] + (((size_t)layer * NSEQ + seq) * 256) * 512 + head * 128;
#pragma unroll
        for (int i = 0; i < 8; ++i) { const int c = tid + NTHREADS * i, key = c >> 4, dc = c & 15; const float* src = kb + (size_t)key * 512 + dc * 8;
            const f32x4 a = *(const f32x4*)src, c2 = *(const f32x4*)(src + 4); u32x4 w; w.x = pk2(a.x, a.y); w.y = pk2(a.z, a.w); w.z = pk2(c2.x, c2.y); w.w = pk2(c2.z, c2.w);
            *(LAS u32x4*)(lds + key * KS_STRIDE + dc * 16) = w; if ((i & 3) == 3) asm volatile("" ::: "memory"); }
#pragma unroll
        for (int i = 0; i < 8; ++i) { const int it = tid + NTHREADS * i, d = it & 127, ch = it >> 7; const float* src = vb + (size_t)(8 * ch) * 512 + d;
            float v[8];
#pragma unroll
            for (int j = 0; j < 8; ++j) v[j] = src[(size_t)j * 512];
            u32x4 w; w.x = pk2(v[0], v[1]); w.y = pk2(v[2], v[3]); w.z = pk2(v[4], v[5]); w.w = pk2(v[6], v[7]);
            *(LAS u32x4*)(lds + VT_OFF + d * VT_STRIDE + ch * 16) = w; if (i & 1) asm volatile("" ::: "memory"); }
    } else {
        const bf16_t* kb = (const bf16_t*)(ws + WS_KVB) + ((size_t)layer * 2048 + b * 256) * 1024 + head * 128; const bf16_t* vb = kb + 512;
#pragma unroll
        for (int i = 0; i < 8; ++i) { const int c = tid + NTHREADS * i, key = c >> 4, dc = c & 15;
            *(LAS u32x4*)(lds + key * KS_STRIDE + dc * 16) = *(const u32x4*)(kb + (size_t)key * 1024 + dc * 8); }
#pragma unroll
        for (int i = 0; i < 8; ++i) { const int it = tid + NTHREADS * i, d = it & 127, ch = it >> 7; const bf16_t* src = vb + (size_t)(8 * ch) * 1024 + d;
            unsigned v[8];
#pragma unroll
            for (int j = 0; j < 8; ++j) v[j] = src[(size_t)j * 1024];
            u32x4 w; w.x = v[0] | (v[1] << 16); w.y = v[2] | (v[3] << 16); w.z = v[4] | (v[5] << 16); w.w = v[6] | (v[7] << 16);
            *(LAS u32x4*)(lds + VT_OFF + d * VT_STRIDE + ch * 16) = w; if (i & 1) asm volatile("" ::: "memory"); }
    }
    __syncthreads();
    const int h4 = lane >> 4, c = lane & 15;
    const int ntiles = SAMPLE ? 1 : 16, nvalid = SAMPLE ? 8 : 16;
    for (int wt = wave; wt < ntiles; wt += 8) {
        const int qrow0 = SAMPLE ? (MP + seq * 8) : (b * SEQ + qc * 256 + wt * 16);
        const int cr = c < nvalid ? c : nvalid - 1;
        const bf16_t* qrow = proj + (size_t)(qrow0 + cr) * NCOL + C_Q + head * 128 + 8 * h4;
        bf16x8 qf[4];
#pragma unroll
        for (int ks = 0; ks < 4; ++ks) qf[ks] = *(const bf16x8*)(qrow + 32 * ks);
        f32x4 s[16];
#pragma unroll
        for (int nb = 0; nb < 16; ++nb) {
            s[nb] = (f32x4){0.f, 0.f, 0.f, 0.f};
            const int keyrow = 32 * (nb >> 1) + 8 * (c >> 2) + 4 * (nb & 1) + (c & 3);
#pragma unroll
            for (int ks = 0; ks < 4; ++ks) { const bf16x8 kf = *(const LAS bf16x8*)(lds + keyrow * KS_STRIDE + (32 * ks + 8 * h4) * 2);
                s[nb] = __builtin_amdgcn_mfma_f32_16x16x32_bf16(kf, qf[ks], s[nb], 0, 0, 0); }
            if (nb & 1) asm volatile("" ::: "memory");
        }
        float mx = -3.0e38f;
#pragma unroll
        for (int nb = 0; nb < 16; ++nb) mx = fmaxf(fmaxf(fmaxf(s[nb][0], s[nb][1]), fmaxf(s[nb][2], s[nb][3])), mx);
        mx = fmaxf(mx, __shfl_xor(mx, 16)); mx = fmaxf(mx, __shfl_xor(mx, 32));
        const float sc = 0.08838834764831845f * 1.4426950408889634f;
        float sum = 0.f;
#pragma unroll
        for (int nb = 0; nb < 16; ++nb)
#pragma unroll
            for (int i = 0; i < 4; ++i) { const float e = __builtin_amdgcn_exp2f((s[nb][i] - mx) * sc); s[nb][i] = e; sum += e; }
        sum += __shfl_xor(sum, 16); sum += __shfl_xor(sum, 32);
        const float inv = 1.0f / sum;
        bf16x8 pf[8];
#pragma unroll
        for (int si = 0; si < 8; ++si) { u32x4 w; w.x = pk2(s[2 * si][0], s[2 * si][1]); w.y = pk2(s[2 * si][2], s[2 * si][3]); w.z = pk2(s[2 * si + 1][0], s[2 * si + 1][1]); w.w = pk2(s[2 * si + 1][2], s[2 * si + 1][3]);
            pf[si] = __builtin_bit_cast(bf16x8, w); }
#pragma unroll
        for (int nd = 0; nd < 8; ++nd) {
            f32x4 o = (f32x4){0.f, 0.f, 0.f, 0.f};
#pragma unroll
            for (int si = 0; si < 8; ++si) { const bf16x8 vf = *(const LAS bf16x8*)(lds + VT_OFF + (16 * nd + c) * VT_STRIDE + (32 * si + 8 * h4) * 2);
                o = __builtin_amdgcn_mfma_f32_16x16x32_bf16(vf, pf[si], o, 0, 0, 0); }
            if (c < nvalid) { const size_t row = (size_t)qrow0 + c; const int col = head * 128 + 16 * nd + 4 * h4;
                const u32x2 gt = *(const u32x2*)(proj + row * NCOL + C_XGATE + col);
                u32x2 w; w.x = pk2(o[0] * inv * siluf_(bflo(gt.x)), o[1] * inv * siluf_(bfhi(gt.x))); w.y = pk2(o[2] * inv * siluf_(bflo(gt.y)), o[3] * inv * siluf_(bfhi(gt.y)));
                *(u32x2*)(br + row * BR_LD + 1024 + col) = w; }
            asm volatile("" ::: "memory");
        }
    }
}

__global__ void __launch_bounds__(NTHREADS, 2) mk_fwd(Params p) {
    extern __shared__ __attribute__((aligned(16))) unsigned char lds_raw[];
    LAS unsigned char* lds = (LAS unsigned char*)lds_raw;
    cg::grid_group grid = cg::this_grid();
    const int G = gridDim.x, bx = blockIdx.x;
    const int vcu = (G % 8 == 0) ? (bx % 8) * (G / 8) + bx / 8 : bx;
    const int NGW = G * 8;
#define IDS() int tid = threadIdx.x; asm volatile("" : "+v"(tid)); const int lane = tid & 63, wave = __builtin_amdgcn_readfirstlane(tid >> 6), gw = vcu * 8 + wave; (void)gw; (void)lane
    unsigned char* ws = p.ws;
    const int lo = p.ph_lo, hi = p.ph_hi;
#define IN(k) (lo <= (k) && (k) < hi)
    if (threadIdx.x < 4) ((LAS unsigned*)(lds + LDS_BAR_OFF))[threadIdx.x] = 0u;
    __syncthreads();
    XcdBarrier xbar; xbar.bar = (unsigned*)(ws + WS_BAR); xbar.x = 0; xbar.st = (volatile LAS unsigned*)(lds + LDS_BAR_OFF);
    if (hi - lo > 1) xbar = xcd_barrier_post((unsigned*)(ws + WS_BAR), (volatile LAS unsigned*)(lds + LDS_BAR_OFF));
#define SEAM(k) do { if (IN(k) && IN((k) + 1)) { if (p.use_cg) grid.sync(); else xcd_barrier(xbar); } } while (0)

    if (IN(0)) { IDS(); p0_prologue(p, lds, gw, NGW, wave, lane); }
    SEAM(0);
#pragma unroll 1
    for (int layer = 0; layer < 2; ++layer) {
        const int pb = 1 + 5 * layer;
        if (IN(pb)) for (int rep = 0; rep < REP1; ++rep) {
            { pg8::Gemm g{(const bf16_t*)(ws + WS_H), (const bf16_t*)(ws + WS_WIN) + (size_t)layer * NCOL * D, D, D, D, 0, 0};
              pg8::Order S; S.init(MT, NCOL, 1, 0, G, bx);
              pg8::EpiStoreBf16 E{(bf16_t*)(ws + WS_PROJ), NCOL};
              pg8::gemm_phase<pg8::EpiStoreBf16>(lds, g, S, E); }
            if (layer == 0) {
              pg8::Gemm g{(const bf16_t*)(ws + WS_MEMN), (const bf16_t*)(ws + WS_WKV), D, D, D, 2048u * D * 2u, (unsigned)D * D * 2u};
              pg8::Order S; S.init(2048, D, 2, 0, G, G - 1 - bx);
              pg8::EpiKV E{p.out + O_MK, p.out + O_MV, (bf16_t*)(ws + WS_KVB)};
              pg8::gemm_phase<pg8::EpiKV>(lds, g, S, E); }
        }
        SEAM(pb);
        if (IN(pb + 1)) for (int rep = 0; rep < REP2; ++rep) {
            IDS();
            for (int t = bx; t < 512; t += G) pool_task<32, false>(p, layer, lds, t, tid, wave, lane);
            for (int t = bx; t < 512; t += G) conv_task<32, false>(p, layer, lds, t, tid, wave, lane);
            for (int t = bx; t < 256; t += G) { if (t < 128) pool_task<8, true>(p, layer, lds, t, tid, wave, lane); else conv_task<8, true>(p, layer, lds, t - 128, tid, wave, lane); }
            for (int t = bx; t < 256; t += G) attn_task<false>(p, layer, lds, t, tid, wave, lane);
            for (int t = bx; t < 512; t += G) attn_task<true>(p, layer, lds, t, tid, wave, lane);
        }
        SEAM(pb + 1);
        if (IN(pb + 2)) for (int rep = 0; rep < REP3; ++rep) {
            pg8::Gemm g{(const bf16_t*)(ws + WS_BR), (const bf16_t*)(ws + WS_WBR) + (size_t)layer * 3 * D * 512, 512, BR_LD, 512, 512u * 2u, (unsigned)D * 512u * 2u};
            pg8::Order S; S.init(MT, D, 3, 1, G, bx);
            pg8::EpiMerge E{(const bf16_t*)(ws + WS_PROJ), (bf16_t*)(ws + WS_MRG)};
            pg8::gemm_phase<pg8::EpiMerge>(lds, g, S, E);
        }
        SEAM(pb + 2);
        if (IN(pb + 3)) for (int rep = 0; rep < REP4; ++rep) {
            pg8::Gemm g{(const bf16_t*)(ws + WS_MRG), (const bf16_t*)(ws + WS_WOUT) + (size_t)layer * D * D, D, D, D, 0, 0};
            pg8::Order S; S.init(MT, D, 1, 0, G, bx);
            pg8::EpiY E{(bf16_t*)(ws + WS_Y), (float*)(ws + WS_SSQ)};
            pg8::gemm_phase<pg8::EpiY>(lds, g, S, E);
        }
        SEAM(pb + 3);
        if (IN(pb + 4)) { IDS(); p5_residual(p, layer, gw, NGW, lane); }
        if (layer == 0) SEAM(pb + 4);
    }
#undef IN
#undef SEAM
#undef IDS
}

extern "C" void kernel_launch(void* const* d_in, const int* in_sizes, int n_in, void* d_out, int out_size, void* d_ws, size_t ws_size, hipStream_t stream) {
    static int grid = 0;
    if (grid == 0) {
        if (n_in != 20 || ws_size < WS_END) { fprintf(stderr, "kernel_launch: expected 20 inputs and >= %zu bytes of workspace (got %d, %zu)\n", (size_t)WS_END, n_in, ws_size); grid = -1; return; }
        int dev = 0, cus = 0, per_cu = 0;
        if (hipGetDevice(&dev) != hipSuccess || hipDeviceGetAttribute(&cus, hipDeviceAttributeMultiprocessorCount, dev) != hipSuccess) { grid = -1; return; }
        if (hipFuncSetAttribute((const void*)mk_fwd, hipFuncAttributeMaxDynamicSharedMemorySize, LDS_BYTES) != hipSuccess) { fprintf(stderr, "kernel_launch: hipFuncSetAttribute failed\n"); grid = -1; return; }
        if (hipOccupancyMaxActiveBlocksPerMultiprocessor(&per_cu, (const void*)mk_fwd, NTHREADS, LDS_BYTES) != hipSuccess || per_cu < 1) { fprintf(stderr, "kernel_launch: occupancy query says %d blocks per CU\n", per_cu); (void)hipGetLastError(); per_cu = 1; }
        grid = cus;
    }
    if (grid < 0) return;
    Params p{};
    for (int i = 0; i < 20; ++i) p.in[i] = (const float*)d_in[i];
    p.out = (float*)d_out; p.ws = (unsigned char*)d_ws;
#if MK_LAUNCHES == 1
    p.ph_lo = 0; p.ph_hi = NPHASES;
    if (hipMemsetAsync((char*)d_ws + WS_BAR, 0, XCD_BAR_WORDS * 4, stream) != hipSuccess) { fprintf(stderr, "kernel_launch: memset of the barrier words failed\n"); return; }
    void* args[] = {&p};
    hipError_t e = hipLaunchCooperativeKernel((const void*)mk_fwd, dim3(grid), dim3(NTHREADS), args, LDS_BYTES, stream);
    if (e != hipSuccess) fprintf(stderr, "cooperative launch failed: %s (grid %d)\n", hipGetErrorString(e), grid);
#else
    for (int k = 0; k < NPHASES; ++k) { p.ph_lo = k; p.ph_hi = k + 1; hipLaunchKernelGGL(mk_fwd, dim3(grid), dim3(NTHREADS), LDS_BYTES, stream, p); }
#endif
}
```

```cpp
#include <hip/hip_runtime.h>
#include <hip/hip_cooperative_groups.h>
#include <cstdio>
#include <cstdint>
namespace cg = cooperative_groups;

#define LAS __attribute__((address_space(3)))
typedef unsigned short bf16_t;
typedef short bf16x8 __attribute__((ext_vector_type(8)));
typedef float f32x4 __attribute__((ext_vector_type(4)));
typedef float f32x2 __attribute__((ext_vector_type(2)));
typedef unsigned u32x4 __attribute__((ext_vector_type(4)));
typedef unsigned u32x2 __attribute__((ext_vector_type(2)));

constexpr int D = 1024, NCOL = 6656, MP = 16384, MS = 1024, MT = MP + MS, SEQ = 2048, NSEQ = 128;
constexpr int C_PGATE = 512, C_CVAL = 1024, C_CGLU = 1536, C_CGATE = 2048, C_Q = 2560, C_XGATE = 3072, C_LOGIT = 3584;
constexpr int BR_LD = 1536;
constexpr float EPS = 1e-6f;
constexpr size_t O_POOLP = 17825792, O_CONVP = 17948672, O_MK = 18194432, O_MV = 20291584, O_POOLS = 22388736, O_CONVS = 24354816;
constexpr size_t WS_WIN = 0;
constexpr size_t WS_WKV = WS_WIN + (size_t)2 * NCOL * D * 2;
constexpr size_t WS_WBR = WS_WKV + (size_t)2 * D * D * 2;
constexpr size_t WS_WOUT = WS_WBR + (size_t)6 * D * 512 * 2;
constexpr size_t WS_WPOOL = WS_WOUT + (size_t)2 * D * D * 2;
constexpr size_t WS_H = WS_WPOOL + (size_t)8 * 128 * 128 * 2;
constexpr size_t WS_MEMN = WS_H + (size_t)MT * D * 2;
constexpr size_t WS_PROJ = WS_MEMN + (size_t)2 * 2048 * D * 2;
constexpr size_t WS_KVB = WS_PROJ + (size_t)MT * NCOL * 2;
constexpr size_t WS_BR = WS_KVB + (size_t)2 * 2048 * D * 2;
constexpr size_t WS_MRG = WS_BR + (size_t)MT * BR_LD * 2;
constexpr size_t WS_Y = WS_MRG + (size_t)MT * D * 2;
constexpr size_t WS_SSQ = WS_Y + (size_t)MT * D * 2;
constexpr size_t WS_BAR = WS_SSQ + (size_t)MT * 16 * 4;
constexpr size_t WS_END = WS_BAR + 3456 * 4;
constexpr int LDS_BAR_OFF = 140 * 1024 - 16;
constexpr int LDS_BYTES = 140 * 1024;
constexpr int NTHREADS = 512;

#ifndef MK_LAUNCHES
#define MK_LAUNCHES 1
#endif
constexpr int NPHASES = 11;
constexpr int REP0 = 1, REP1 = 1, REP2 = 1, REP3 = 1, REP4 = 1, REP5 = 1;

__device__ __forceinline__ unsigned pk2(float lo, float hi) { unsigned r; asm("v_cvt_pk_bf16_f32 %0, %1, %2" : "=v"(r) : "v"(lo), "v"(hi)); return r; }
__device__ __forceinline__ float bflo(unsigned w) { return __uint_as_float(w << 16); }
__device__ __forceinline__ float bfhi(unsigned w) { return __uint_as_float(w & 0xffff0000u); }
__device__ __forceinline__ float bf1(bf16_t b) { return __uint_as_float(((unsigned)b) << 16); }
__device__ __forceinline__ float sigmoidf_(float x) { return __builtin_amdgcn_rcpf(1.0f + __builtin_amdgcn_exp2f(-1.4426950408889634f * x)); }
__device__ __forceinline__ float siluf_(float x) { return x * sigmoidf_(x); }
__device__ __forceinline__ float wave_sum(float v) {
#pragma unroll
    for (int o = 1; o < 64; o <<= 1) v += __shfl_xor(v, o);
    return v;
}
#define LDS_WAIT() asm volatile("s_waitcnt lgkmcnt(0)" ::: "memory")

namespace pg8 {
constexpr int BM = 256, BK = 64, HALF = 128, HTB = HALF * BK * 2, STAGE_BYTES = 8 * HTB, NXCD = 8, WGM = 8;
__host__ __device__ __forceinline__ int lds_byte(int r, int c) { const int st = (r >> 4) * 2 + (c >> 5), rr = r & 15, cc = c & 31, ob = rr * 64 + cc * 2; return st * 1024 + (ob ^ (((ob >> 9) & 1) << 5)); }
__host__ __device__ __forceinline__ void stage_rc(int b, int& R, int& C) { const int st = b / 1024, sb = b % 1024, swz = sb ^ (((sb >> 9) & 1) << 5); R = (st >> 1) * 16 + swz / 64; C = (st & 1) * 32 + (swz % 64) / 2; }
__host__ __device__ __forceinline__ int perm32(int rho) { const int n = rho >> 4, i = rho & 15; return 8 * (i >> 2) + 4 * n + (i & 3); }

struct Unit { int pm, pn, z; };
struct Gemm { const bf16_t* A; const bf16_t* Bt; int K, lda, ldb; unsigned zA, zB; };

struct Order {
    int nM, nN, ntile, nz, zinner, G, c;
    __device__ void init(int M, int N, int nz_, int zinner_, int G_, int c_) { nM = M / BM; nN = N / BM; ntile = nM * nN; nz = nz_; zinner = zinner_; G = G_; c = c_; }
    __device__ bool next(int i, Unit& u) const {
        int tix, z;
        if (zinner) { tix = (i / nz) * G + c; z = i % nz; if (tix >= ntile) return false; }
        else { const long L = (long)i * G + c; if (L >= (long)ntile * nz) return false; z = (int)(L / ntile); tix = (int)(L % ntile); }
        int wgid = tix; { const int q = ntile / NXCD, r = ntile % NXCD, xcd = wgid % NXCD, off = wgid / NXCD; wgid = (xcd < r ? xcd * (q + 1) : r * (q + 1) + (xcd - r) * q) + off; }
        const int nig = WGM * nN, gid = wgid / nig, fm = gid * WGM, gsz = (nM - fm) < WGM ? (nM - fm) : WGM;
        u.pm = fm + ((wgid % nig) % gsz); u.pn = (wgid % nig) / gsz; u.z = z; return true;
    }
};

struct EpiStoreBf16 {
    static constexpr bool PERM = true;
    bf16_t* O; int ldc;
    __device__ __forceinline__ void operator()(const f32x4 (&acc)[2][2][4][2], const Unit& u, int wr, int wc, int fr, int fq) const {
        const int row0 = u.pm * BM + wr * 64 + fr, col0 = u.pn * BM + wc * 32 + 8 * fq;
#pragma unroll
        for (int ai = 0; ai < 2; ++ai)
#pragma unroll
            for (int m = 0; m < 4; ++m) { bf16_t* rowp = O + (size_t)(row0 + ai * HALF + m * 16) * ldc + col0;
#pragma unroll
                for (int bj = 0; bj < 2; ++bj) { const f32x4 v0 = acc[ai][bj][m][0], v1 = acc[ai][bj][m][1];
                    u32x4 w; w.x = pk2(v0[0], v0[1]); w.y = pk2(v0[2], v0[3]); w.z = pk2(v1[0], v1[1]); w.w = pk2(v1[2], v1[3]);
                    *(u32x4*)(rowp + bj * HALF) = w; } }
    }
};
struct EpiK {
    static constexpr bool PERM = false;
    float* outK; bf16_t* kb;
    __device__ __forceinline__ void operator()(const f32x4 (&acc)[2][2][4][2], const Unit& u, int wr, int wc, int fr, int fq) const {
        const int row0 = u.pm * BM + wr * 64 + fr, col0 = u.pn * BM + wc * 32 + 4 * fq;
        float* of = outK + (size_t)u.z * 2048 * 512; bf16_t* ob = kb + (size_t)u.z * 2048 * 512;
#pragma unroll
        for (int ai = 0; ai < 2; ++ai)
#pragma unroll
            for (int m = 0; m < 4; ++m) { const int r = row0 + ai * HALF + m * 16;
#pragma unroll
                for (int bj = 0; bj < 2; ++bj)
#pragma unroll
                    for (int n = 0; n < 2; ++n) { const f32x4 v = acc[ai][bj][m][n]; const int c = col0 + bj * HALF + n * 16;
                        *(f32x4*)(of + (size_t)r * 512 + c) = v;
                        u32x2 w; w.x = pk2(v[0], v[1]); w.y = pk2(v[2], v[3]);
                        *(u32x2*)(ob + (size_t)r * 512 + c) = w; } }
    }
};
struct EpiVt {
    static constexpr bool PERM = true;
    float* outV; bf16_t* vt;
    __device__ __forceinline__ void operator()(const f32x4 (&acc)[2][2][4][2], const Unit& u, int wr, int wc, int fr, int fq) const {
        const int row0 = u.pm * BM + wr * 64 + fr, col0 = u.pn * BM + wc * 32 + 8 * fq;
        float* of = outV + (size_t)u.z * 2048 * 512; bf16_t* ob = vt + (size_t)u.z * 512 * 2048;
#pragma unroll
        for (int ai = 0; ai < 2; ++ai)
#pragma unroll
            for (int m = 0; m < 4; ++m) { const int r = row0 + ai * HALF + m * 16;
#pragma unroll
                for (int bj = 0; bj < 2; ++bj) { const f32x4 v0 = acc[ai][bj][m][0], v1 = acc[ai][bj][m][1]; const int c = col0 + bj * HALF;
                    u32x4 w; w.x = pk2(v0[0], v0[1]); w.y = pk2(v0[2], v0[3]); w.z = pk2(v1[0], v1[1]); w.w = pk2(v1[2], v1[3]);
                    *(u32x4*)(ob + (size_t)r * 2048 + c) = w;
#pragma unroll
                    for (int j = 0; j < 4; ++j) { of[(size_t)(c + j) * 512 + r] = v0[j]; of[(size_t)(c + 4 + j) * 512 + r] = v1[j]; } } }
    }
};
struct EpiMerge {
    static constexpr bool PERM = true;
    const bf16_t* proj; bf16_t* mrg;
    __device__ __forceinline__ void operator()(const f32x4 (&acc)[2][2][4][2], const Unit& u, int wr, int wc, int fr, int fq) const {
        const int row0 = u.pm * BM + wr * 64 + fr, col0 = u.pn * BM + wc * 32 + 8 * fq;
#pragma unroll
        for (int ai = 0; ai < 2; ++ai)
#pragma unroll
            for (int m = 0; m < 4; ++m) { const int r = row0 + ai * HALF + m * 16;
                const bf16_t* lg = proj + (size_t)r * NCOL + C_LOGIT + u.z * D + col0; bf16_t* mp = mrg + (size_t)r * D + col0;
#pragma unroll
                for (int bj = 0; bj < 2; ++bj) { const f32x4 v0 = acc[ai][bj][m][0], v1 = acc[ai][bj][m][1];
                    const u32x4 g = *(const u32x4*)(lg + bj * HALF);
                    float o[8];
                    o[0] = v0[0] * sigmoidf_(bflo(g.x)); o[1] = v0[1] * sigmoidf_(bfhi(g.x)); o[2] = v0[2] * sigmoidf_(bflo(g.y)); o[3] = v0[3] * sigmoidf_(bfhi(g.y));
                    o[4] = v1[0] * sigmoidf_(bflo(g.z)); o[5] = v1[1] * sigmoidf_(bfhi(g.z)); o[6] = v1[2] * sigmoidf_(bflo(g.w)); o[7] = v1[3] * sigmoidf_(bfhi(g.w));
                    if (u.z != 0) { const u32x4 p = *(const u32x4*)(mp + bj * HALF);
                        o[0] += bflo(p.x); o[1] += bfhi(p.x); o[2] += bflo(p.y); o[3] += bfhi(p.y); o[4] += bflo(p.z); o[5] += bfhi(p.z); o[6] += bflo(p.w); o[7] += bfhi(p.w); }
                    u32x4 w; w.x = pk2(o[0], o[1]); w.y = pk2(o[2], o[3]); w.z = pk2(o[4], o[5]); w.w = pk2(o[6], o[7]);
                    *(u32x4*)(mp + bj * HALF) = w; }
                if (m == 3) asm volatile("" ::: "memory"); }
    }
};
struct EpiY {
    static constexpr bool PERM = true;
    bf16_t* Y; float* ssq;
    __device__ __forceinline__ void operator()(const f32x4 (&acc)[2][2][4][2], const Unit& u, int wr, int wc, int fr, int fq) const {
        const int row0 = u.pm * BM + wr * 64 + fr, col0 = u.pn * BM + wc * 32 + 8 * fq;
#pragma unroll
        for (int ai = 0; ai < 2; ++ai)
#pragma unroll
            for (int m = 0; m < 4; ++m) { const int r = row0 + ai * HALF + m * 16; bf16_t* rowp = Y + (size_t)r * D + col0; float s = 0.f;
#pragma unroll
                for (int bj = 0; bj < 2; ++bj) { const f32x4 v0 = acc[ai][bj][m][0], v1 = acc[ai][bj][m][1];
                    s += (v0[0] * v0[0] + v0[1] * v0[1]) + (v0[2] * v0[2] + v0[3] * v0[3]) + (v1[0] * v1[0] + v1[1] * v1[1]) + (v1[2] * v1[2] + v1[3] * v1[3]);
                    u32x4 w; w.x = pk2(v0[0], v0[1]); w.y = pk2(v0[2], v0[3]); w.z = pk2(v1[0], v1[1]); w.w = pk2(v1[2], v1[3]);
                    *(u32x4*)(rowp + bj * HALF) = w; }
                s += __shfl_xor(s, 16); s += __shfl_xor(s, 32);
                if (fq == 0) ssq[(size_t)r * 16 + u.pn * 4 + wc] = s; }
    }
};

template <class Epi>
__device__ __forceinline__ void gemm_phase(LAS unsigned char* lds, const Gemm g, const Order& S, const Epi& E) {
    int tid = threadIdx.x; asm volatile("" : "+v"(tid));
    const int wid = __builtin_amdgcn_readfirstlane(tid >> 6), lane = tid & 63, wr = wid >> 2, wc = wid & 3, fr = lane & 15, fq = lane >> 4;
    const int K = g.K, nt = K / BK;
    unsigned voffA[2], voffB[2];
#pragma unroll
    for (int i = 0; i < 2; ++i) { int R, C; stage_rc(tid * 16 + i * 8192, R, C); const int Rb = Epi::PERM ? ((R & ~31) + perm32(R & 31)) : R;
        voffA[i] = (unsigned)(R * g.lda + C) * 2u; voffB[i] = (unsigned)(Rb * g.ldb + C) * 2u; }
    constexpr unsigned kstep = BK * 2;
    const unsigned hstepA = (unsigned)HALF * g.lda * 2, hstepB = (unsigned)HALF * g.ldb * 2;
    const unsigned tstepA = 2 * hstepA, tstepB = 2 * hstepB;
    const unsigned ldsw = (unsigned)wid * 1024u;
    const int aoff = lds_byte(wr * 64 + fr, fq * 8), boff = lds_byte(wc * 32 + fr, fq * 8);
#define PG8_SA(b, h) (((b) * 2 + (h)) * HTB)
#define PG8_SB(b, h) ((4 + (b) * 2 + (h)) * HTB)
#define PG8_STAGE(bufoff, gbase, voff) do { _Pragma("unroll") for (int _i = 0; _i < 2; ++_i) \
        __builtin_amdgcn_global_load_lds((const unsigned*)((const char*)(gbase) + (voff)[_i]), (LAS unsigned*)(lds + (bufoff) + ldsw + _i * 8192), 16, 0, 0); } while (0)
#define PG8_LDA(dst, b, h) do { _Pragma("unroll") for (int m = 0; m < 4; ++m) _Pragma("unroll") for (int k = 0; k < 2; ++k) dst[m][k] = *(const LAS bf16x8*)(lds + PG8_SA(b, h) + aoff + m * 2048 + k * 1024); } while (0)
#define PG8_LDB(dst, b, h) do { _Pragma("unroll") for (int n = 0; n < 2; ++n) _Pragma("unroll") for (int k = 0; k < 2; ++k) dst[n][k] = *(const LAS bf16x8*)(lds + PG8_SB(b, h) + boff + n * 2048 + k * 1024); } while (0)
#define PG8_MMA(ai, bj, At, Bt) do { __builtin_amdgcn_s_setprio(1); _Pragma("unroll") for (int m = 0; m < 4; ++m) _Pragma("unroll") for (int n = 0; n < 2; ++n) _Pragma("unroll") for (int k = 0; k < 2; ++k) \
        acc[ai][bj][m][n] = __builtin_amdgcn_mfma_f32_16x16x32_bf16(Bt[n][k], At[m][k], acc[ai][bj][m][n], 0, 0, 0); __builtin_amdgcn_s_setprio(0); } while (0)
#define PG8_WAIT_V(n) asm volatile("s_waitcnt vmcnt(" #n ")" ::: "memory")
#define PG8_WAIT_L(n) asm volatile("s_waitcnt lgkmcnt(" #n ")" ::: "memory")
#define PG8_BAR __builtin_amdgcn_s_barrier()
#define PG8_SCHED __builtin_amdgcn_sched_barrier(0)
    Unit cur, nxt; int ui = 0;
    if (!S.next(0, cur)) return;
    f32x4 acc[2][2][4][2];
#pragma unroll
    for (int a = 0; a < 2; ++a)
#pragma unroll
        for (int b = 0; b < 2; ++b)
#pragma unroll
            for (int m = 0; m < 4; ++m)
#pragma unroll
                for (int n = 0; n < 2; ++n) acc[a][b][m][n] = (f32x4){0.f, 0.f, 0.f, 0.f};
    bf16x8 At[4][2], B0[2][2], B1[2][2];
    const char* cA = (const char*)g.A + (size_t)((unsigned)cur.pm * tstepA + (unsigned)cur.z * g.zA); const char* cB = (const char*)g.Bt + (size_t)((unsigned)cur.pn * tstepB + (unsigned)cur.z * g.zB);
    PG8_STAGE(PG8_SB(0, 0), cB, voffB); PG8_STAGE(PG8_SB(0, 1), cB + hstepB, voffB); PG8_STAGE(PG8_SA(0, 0), cA, voffA); PG8_STAGE(PG8_SA(0, 1), cA + hstepA, voffA);
    if (wr == 1) PG8_BAR;
    PG8_WAIT_V(2); PG8_BAR;
    PG8_STAGE(PG8_SB(1, 0), cB + kstep, voffB); PG8_STAGE(PG8_SA(1, 0), cA + kstep, voffA); PG8_STAGE(PG8_SB(1, 1), cB + hstepB + kstep, voffB);
    PG8_WAIT_V(6); PG8_BAR;
    for (;;) {
        const bool has_next = S.next(ui + 1, nxt);
        const char* nA = has_next ? (const char*)g.A + (size_t)((unsigned)nxt.pm * tstepA + (unsigned)nxt.z * g.zA) : cA;
        const char* nB = has_next ? (const char*)g.Bt + (size_t)((unsigned)nxt.pn * tstepB + (unsigned)nxt.z * g.zB) : cB;
        for (int t = 0; t < nt; t += 2) {
            const bool last = (t == nt - 2);
            const char* a1 = cA + (unsigned)(t + 1) * kstep;
            const char* a2 = last ? nA : cA + (unsigned)(t + 2) * kstep; const char* b2 = last ? nB : cB + (unsigned)(t + 2) * kstep;
            const char* a3 = a2 + kstep; const char* b3 = b2 + kstep;
            PG8_LDB(B0, 0, 0); PG8_LDB(B1, 0, 1); PG8_SCHED; PG8_LDA(At, 0, 0); PG8_STAGE(PG8_SA(1, 1), a1 + hstepA, voffA);
            PG8_WAIT_V(8); PG8_WAIT_L(0); PG8_BAR; PG8_MMA(0, 0, At, B0); PG8_MMA(0, 1, At, B1); PG8_BAR; PG8_SCHED;
            PG8_LDA(At, 0, 1); PG8_STAGE(PG8_SB(0, 0), b2, voffB); PG8_STAGE(PG8_SB(0, 1), b2 + hstepB, voffB); PG8_STAGE(PG8_SA(0, 0), a2, voffA);
            PG8_WAIT_V(8); PG8_WAIT_L(0); PG8_BAR; PG8_MMA(1, 0, At, B0); PG8_MMA(1, 1, At, B1); PG8_BAR; PG8_SCHED;
            PG8_LDB(B0, 1, 0); PG8_LDB(B1, 1, 1); PG8_SCHED; PG8_LDA(At, 1, 0); PG8_STAGE(PG8_SA(0, 1), a2 + hstepA, voffA);
            PG8_WAIT_V(8); PG8_WAIT_L(0); PG8_BAR; PG8_MMA(0, 0, At, B0); PG8_MMA(0, 1, At, B1); PG8_BAR; PG8_SCHED;
            PG8_LDA(At, 1, 1); PG8_STAGE(PG8_SB(1, 0), b3, voffB); PG8_STAGE(PG8_SB(1, 1), b3 + hstepB, voffB); PG8_STAGE(PG8_SA(1, 0), a3, voffA);
            PG8_WAIT_V(8); PG8_WAIT_L(0); PG8_BAR; PG8_MMA(1, 0, At, B0); PG8_MMA(1, 1, At, B1); PG8_BAR; PG8_SCHED;
        }
        if (wr == 0) PG8_BAR;
        E(acc, cur, wr, wc, fr, fq);
        if (!has_next) break;
#pragma unroll
        for (int a = 0; a < 2; ++a)
#pragma unroll
            for (int b = 0; b < 2; ++b)
#pragma unroll
                for (int m = 0; m < 4; ++m)
#pragma unroll
                    for (int n = 0; n < 2; ++n) acc[a][b][m][n] = (f32x4){0.f, 0.f, 0.f, 0.f};
        cur = nxt; cA = nA; cB = nB; ++ui;
        if (wr == 1) PG8_BAR;
    }
    PG8_WAIT_V(0);
    PG8_BAR;
#undef PG8_SA
#undef PG8_SB
#undef PG8_STAGE
#undef PG8_LDA
#undef PG8_LDB
#undef PG8_MMA
#undef PG8_WAIT_V
#undef PG8_WAIT_L
#undef PG8_BAR
#undef PG8_SCHED
}
}


#define XB_TMO      128
#define XB_XCNT(j)  (256  + 64 * (j))
#define XB_XSUB(j)  (1280 + 64 * (j))
#define XB_XGEN(j)  (2304 + 64 * (j))
#define XB_TOP      3328
#define XB_TOPGEN   3392
#define XCD_BAR_WORDS 3456
#define XB_SPIN_CAP (1u << 22)
__device__ __forceinline__ unsigned xb_ld(unsigned* p)              { return __hip_atomic_load(p, __ATOMIC_RELAXED, __HIP_MEMORY_SCOPE_AGENT); }
__device__ __forceinline__ unsigned xb_add(unsigned* p, unsigned v) { return __hip_atomic_fetch_add(p, v, __ATOMIC_RELAXED, __HIP_MEMORY_SCOPE_AGENT); }
__device__ __forceinline__ unsigned xb_xcc_id() { return (unsigned)__builtin_amdgcn_s_getreg((3 << 11) | 20) & 0xFu; }
#define XB_SPIN(cond, bar) do { unsigned _sp = 0; while (cond) { __builtin_amdgcn_s_sleep(1); \
    if ((++_sp & 255u) == 0u) { if (xb_ld(&(bar)[XB_TMO])) break; if (_sp > XB_SPIN_CAP) { atomicAdd(&(bar)[XB_TMO], 1u); break; } } } } while (0)
struct XcdBarrier { unsigned* bar; unsigned x; volatile LAS unsigned* st; };
__device__ __forceinline__ XcdBarrier xcd_barrier_post(unsigned* bar, volatile LAS unsigned* st) {
    XcdBarrier b; b.bar = bar; b.x = xb_xcc_id(); b.st = st;
    if (threadIdx.x == 0) (void)xb_add(&bar[XB_XCNT(b.x)], 1u);
    return b;
}
__device__ __forceinline__ void xcd_barrier_complete(unsigned* bar, unsigned x, unsigned& nloc, unsigned& nx) {
    const unsigned G = gridDim.x * gridDim.y * gridDim.z;
    unsigned sum, cnt, mine, sp = 0u;
    for (;;) {
        sum = 0u; cnt = 0u; mine = 0u;
#pragma unroll
        for (unsigned j = 0; j < 16; ++j) { const unsigned c = xb_ld(&bar[XB_XCNT(j)]); sum += c; cnt += (c > 0u) ? 1u : 0u; mine = (j == x) ? c : mine; }
        if (sum == G) break;
        __builtin_amdgcn_s_sleep(1);
        if ((++sp & 255u) == 0u) { if (xb_ld(&bar[XB_TMO])) break; if (sp > XB_SPIN_CAP) { atomicAdd(&bar[XB_TMO], 1u); break; } }
    }
    nloc = mine > 0u ? mine : 1u; nx = cnt > 0u ? cnt : 1u;
}
__device__ __forceinline__ void xcd_barrier(const XcdBarrier& b) {
    asm volatile("s_waitcnt vmcnt(0)" ::: "memory");
    __syncthreads();
    if (threadIdx.x == 0) {
        unsigned* bar = b.bar;
        __builtin_amdgcn_s_waitcnt(0);
        unsigned nloc = b.st[0], nx = b.st[1];
        if (nloc == 0u) { xcd_barrier_complete(bar, b.x, nloc, nx); b.st[0] = nloc; b.st[1] = nx; }
        const unsigned old = xb_add(&bar[XB_XSUB(b.x)], 1u);
        const unsigned gen = old / nloc;
        if (old + 1u == (gen + 1u) * nloc) {
            __builtin_amdgcn_fence(__ATOMIC_RELEASE, "agent");
            asm volatile("s_waitcnt vmcnt(0)" ::: "memory");
            const unsigned og = xb_add(&bar[XB_TOP], 1u);
            const unsigned tg = og / nx;
            if (og + 1u == (tg + 1u) * nx) xb_add(&bar[XB_TOPGEN], 1u);
            else XB_SPIN(xb_ld(&bar[XB_TOPGEN]) == tg, bar);
            __builtin_amdgcn_fence(__ATOMIC_ACQUIRE, "agent");
            xb_add(&bar[XB_XGEN(b.x)], 1u);
            asm volatile("s_waitcnt vmcnt(0)" ::: "memory");
        } else {
            XB_SPIN(xb_ld(&bar[XB_XGEN(b.x)]) == gen, bar);
            __builtin_amdgcn_fence(__ATOMIC_ACQUIRE, "agent");
            asm volatile("s_waitcnt vmcnt(0)" ::: "memory");
        }
    }
    __syncthreads();
}

struct Params { const float* in[20]; float* out; unsigned char* ws; int ph_lo, ph_hi, use_cg, pad; };
enum { I_XP = 0, I_XS, I_SPOOL, I_SCONV, I_CK, I_CV, I_MEM, I_NPRE, I_NPOST, I_MNORM, I_WKV, I_WIN, I_POOLW, I_PSCALE, I_CONVW, I_CONVB, I_LNG, I_LNB, I_WBR, I_WOUT };

__device__ __forceinline__ void transpose_item(const float* W, int K, int N, bf16_t* WT, LAS float* scr, int item, int lane) {
    const int nblk = N / 32, kb = item / nblk, nb = item % nblk, k0 = 64 * kb, n0 = 32 * nb;
    const int kk = lane >> 3, n4 = (lane & 7) * 4;
    f32x4 v[8];
#pragma unroll
    for (int i = 0; i < 8; ++i) v[i] = *(const f32x4*)(W + (size_t)(k0 + kk + 8 * i) * N + n0 + n4);
#pragma unroll
    for (int i = 0; i < 8; ++i) { LAS float* d = scr + (kk + 8 * i) * 33 + n4; d[0] = v[i].x; d[1] = v[i].y; d[2] = v[i].z; d[3] = v[i].w; }
    LDS_WAIT();
    const int c = lane & 7;
#pragma unroll
    for (int j = 0; j < 4; ++j) { const int n = (lane >> 3) + 8 * j; const LAS float* s = scr + (8 * c) * 33 + n;
        u32x4 o; o.x = pk2(s[0 * 33], s[1 * 33]); o.y = pk2(s[2 * 33], s[3 * 33]); o.z = pk2(s[4 * 33], s[5 * 33]); o.w = pk2(s[6 * 33], s[7 * 33]);
        *(u32x4*)(WT + (size_t)(n0 + n) * K + k0 + 8 * c) = o; }
    LDS_WAIT();
}

__device__ __forceinline__ void p0_prologue(const Params& p, LAS unsigned char* lds, int gw, int NGW, int wave, int lane) {
    LAS float* scr = (LAS float*)(lds + wave * 8704);
    unsigned char* ws = p.ws;
    constexpr int I_IN = (D / 64) * (NCOL / 32), I_SQ = (D / 64) * (D / 32), I_BR = (512 / 64) * (D / 32), I_PL = 2 * 4;
    constexpr int NITEMS = 2 * I_IN + 2 * I_SQ + 6 * I_BR + 2 * I_SQ + 8 * I_PL;
    for (int it = gw; it < NITEMS; it += NGW) {
        int r = it;
        if (r < 2 * I_IN) { const int l = r / I_IN; transpose_item(p.in[I_WIN] + (size_t)l * D * NCOL, D, NCOL, (bf16_t*)(ws + WS_WIN) + (size_t)l * NCOL * D, scr, r % I_IN, lane); continue; } r -= 2 * I_IN;
        if (r < 2 * I_SQ) { const int l = r / I_SQ; transpose_item(p.in[I_WKV] + (size_t)l * D * D, D, D, (bf16_t*)(ws + WS_WKV) + (size_t)l * D * D, scr, r % I_SQ, lane); continue; } r -= 2 * I_SQ;
        if (r < 6 * I_BR) { const int l = r / I_BR; transpose_item(p.in[I_WBR] + (size_t)l * 512 * D, 512, D, (bf16_t*)(ws + WS_WBR) + (size_t)l * D * 512, scr, r % I_BR, lane); continue; } r -= 6 * I_BR;
        if (r < 2 * I_SQ) { const int l = r / I_SQ; transpose_item(p.in[I_WOUT] + (size_t)l * D * D, D, D, (bf16_t*)(ws + WS_WOUT) + (size_t)l * D * D, scr, r % I_SQ, lane); continue; } r -= 2 * I_SQ;
        { const int l = r / I_PL; transpose_item(p.in[I_POOLW] + (size_t)l * 128 * 128, 128, 128, (bf16_t*)(ws + WS_WPOOL) + (size_t)l * 128 * 128, scr, r % I_PL, lane); }
    }
    const float* g0 = p.in[I_NPRE];
    for (int m0 = gw; m0 < MT; m0 += 2 * NGW) {
        f32x4 v[2][4]; float s[2];
#pragma unroll
        for (int r = 0; r < 2; ++r) { const int mm = m0 + r * NGW, m = mm < MT ? mm : MT - 1;
            const float* xrow = (m < MP) ? p.in[I_XP] + (size_t)m * D : p.in[I_XS] + (size_t)(m - MP) * D; const f32x4* xr = (const f32x4*)xrow + lane;
#pragma unroll
            for (int j = 0; j < 4; ++j) v[r][j] = xr[64 * j]; }
#pragma unroll
        for (int r = 0; r < 2; ++r) { float t = 0.f;
#pragma unroll
            for (int j = 0; j < 4; ++j) t += (v[r][j].x * v[r][j].x + v[r][j].y * v[r][j].y) + (v[r][j].z * v[r][j].z + v[r][j].w * v[r][j].w);
            s[r] = 1.0f / sqrtf(wave_sum(t) * (1.f / D) + EPS); }
#pragma unroll
        for (int r = 0; r < 2; ++r) { const int mm = m0 + r * NGW; if (mm < MT) { u32x2* o = (u32x2*)((bf16_t*)(ws + WS_H) + (size_t)mm * D) + lane; const float rs = s[r];
#pragma unroll
            for (int j = 0; j < 4; ++j) { const f32x4 g = ((const f32x4*)g0)[lane + 64 * j]; u32x2 w; w.x = pk2(v[r][j].x * rs * g.x, v[r][j].y * rs * g.y); w.y = pk2(v[r][j].z * rs * g.z, v[r][j].w * rs * g.w); o[64 * j] = w; } } }
    }
    for (int m = gw; m < 2048; m += NGW) {
        const f32x4* xr = (const f32x4*)(p.in[I_MEM] + (size_t)m * D) + lane; f32x4 v[4]; float s = 0.f;
#pragma unroll
        for (int j = 0; j < 4; ++j) { v[j] = xr[64 * j]; s += (v[j].x * v[j].x + v[j].y * v[j].y) + (v[j].z * v[j].z + v[j].w * v[j].w); }
        const float rs = 1.0f / sqrtf(wave_sum(s) * (1.f / D) + EPS);
#pragma unroll
        for (int l = 0; l < 2; ++l) { u32x2* o = (u32x2*)((bf16_t*)(ws + WS_MEMN) + ((size_t)l * 2048 + m) * D) + lane;
#pragma unroll
            for (int j = 0; j < 4; ++j) { const f32x4 g = ((const f32x4*)(p.in[I_MNORM] + l * D))[lane + 64 * j]; u32x2 w; w.x = pk2(v[j].x * rs * g.x, v[j].y * rs * g.y); w.y = pk2(v[j].z * rs * g.z, v[j].w * rs * g.w); o[64 * j] = w; } }
    }
}

__device__ __forceinline__ void p5_residual(const Params& p, int layer, int gw, int NGW, int lane) {
    unsigned char* ws = p.ws;
    const bf16_t* Y = (const bf16_t*)(ws + WS_Y); const float* ssq = (const float*)(ws + WS_SSQ);
    const f32x4* gp = (const f32x4*)(p.in[I_NPOST] + layer * D); const f32x4* gn = (const f32x4*)(p.in[I_NPRE] + D);
    for (int m0 = gw; m0 < MT; m0 += 2 * NGW) {
        f32x4 x[2][4]; u32x2 y[2][4]; float sp[2];
#pragma unroll
        for (int r = 0; r < 2; ++r) { const int mm = m0 + r * NGW, m = mm < MT ? mm : MT - 1;
            const float* xrow = (layer == 0) ? ((m < MP) ? p.in[I_XP] + (size_t)m * D : p.in[I_XS] + (size_t)(m - MP) * D) : p.out + (size_t)m * D;
            sp[r] = (lane < 16) ? ssq[(size_t)m * 16 + lane] : 0.f;
            const f32x4* xr = (const f32x4*)xrow + lane; const u32x2* yr = (const u32x2*)(Y + (size_t)m * D) + lane;
#pragma unroll
            for (int j = 0; j < 4; ++j) { x[r][j] = xr[64 * j]; y[r][j] = yr[64 * j]; } }
#pragma unroll
        for (int r = 0; r < 2; ++r) { const int mm = m0 + r * NGW;
            const float rs = 1.0f / sqrtf(wave_sum(sp[r]) * (1.f / D) + EPS); float s = 0.f;
#pragma unroll
            for (int j = 0; j < 4; ++j) { const f32x4 g = gp[lane + 64 * j]; f32x4& v = x[r][j]; const u32x2 yy = y[r][j];
                v.x += bflo(yy.x) * rs * g.x; v.y += bfhi(yy.x) * rs * g.y; v.z += bflo(yy.y) * rs * g.z; v.w += bfhi(yy.y) * rs * g.w;
                s += (v.x * v.x + v.y * v.y) + (v.z * v.z + v.w * v.w); }
            if (mm < MT) {
                f32x4* orow = (f32x4*)(p.out + (size_t)mm * D) + lane;
#pragma unroll
                for (int j = 0; j < 4; ++j) orow[64 * j] = x[r][j];
            }
            if (layer == 0) {
                const float r2 = 1.0f / sqrtf(wave_sum(s) * (1.f / D) + EPS);
                if (mm < MT) { u32x2* o = (u32x2*)((bf16_t*)(ws + WS_H) + (size_t)mm * D) + lane;
#pragma unroll
                    for (int j = 0; j < 4; ++j) { const f32x4 g = gn[lane + 64 * j]; const f32x4 v = x[r][j]; u32x2 w; w.x = pk2(v.x * r2 * g.x, v.y * r2 * g.y); w.y = pk2(v.z * r2 * g.z, v.w * r2 * g.w); o[64 * j] = w; } }
            }
        }
    }
}

template <int T, bool SAMPLE>
__device__ __forceinline__ void pool_task(const Params& p, int layer, LAS unsigned char* lds, int task, int tid, int wave, int lane) {
    constexpr int R = T + 15, NRB = (T + 15) / 16;
    unsigned char* ws = p.ws;
    const bf16_t* proj = (const bf16_t*)(ws + WS_PROJ); bf16_t* br = (bf16_t*)(ws + WS_BR);
    LAS unsigned* PE = (LAS unsigned*)lds;
    LAS unsigned* MX = (LAS unsigned*)(lds + R * 1024);
    int b = 0, t0 = 0, seq = 0, rowbase;
    if (SAMPLE) { seq = task; rowbase = MP + seq * 8; } else { b = task >> 6; t0 = (task & 63) * T; rowbase = b * SEQ + t0; }
    __syncthreads();
    if (SAMPLE) {
        f32x4 sa[2], sb[2]; u32x4 pw;
#pragma unroll
        for (int i = 0; i < 2; ++i) { const int idx = tid + NTHREADS * i, row = idx < 960 ? (idx >> 6) : 0, c8 = idx & 63;
            const float* src = p.in[I_SPOOL] + (((size_t)layer * NSEQ + seq) * 15 + row) * 512 + 8 * c8; sa[i] = *(const f32x4*)src; sb[i] = *(const f32x4*)(src + 4); }
        { const int row = tid >> 6, c8 = tid & 63; pw = *(const u32x4*)(proj + (size_t)(rowbase + row) * NCOL + 8 * c8); }
#pragma unroll
        for (int i = 0; i < 2; ++i) { const int idx = tid + NTHREADS * i, row = idx >> 6, c8 = idx & 63;
            if (idx < 960) { u32x4 w; w.x = pk2(sa[i].x, sa[i].y); w.y = pk2(sa[i].z, sa[i].w); w.z = pk2(sb[i].x, sb[i].y); w.w = pk2(sb[i].z, sb[i].w);
                *(LAS u32x4*)(PE + row * 256 + 4 * c8) = w;
                if (row >= 8) { float* o = p.out + O_POOLS + (((size_t)layer * NSEQ + seq) * 15 + (row - 8)) * 512 + 8 * c8; *(f32x4*)o = sa[i]; *(f32x4*)(o + 4) = sb[i]; } } }
        { const int row = 15 + (tid >> 6), c8 = tid & 63; *(LAS u32x4*)(PE + row * 256 + 4 * c8) = pw;
            float* o = p.out + O_POOLS + (((size_t)layer * NSEQ + seq) * 15 + (row - 8)) * 512 + 8 * c8;
            *(f32x4*)o = (f32x4){bflo(pw.x), bfhi(pw.x), bflo(pw.y), bfhi(pw.y)}; *(f32x4*)(o + 4) = (f32x4){bflo(pw.z), bfhi(pw.z), bflo(pw.w), bfhi(pw.w)}; }
    } else {
        constexpr int NCH = R * 64, NIT = (NCH + NTHREADS - 1) / NTHREADS;
        u32x4 pw[NIT];
#pragma unroll
        for (int i = 0; i < NIT; ++i) { const int idx = tid + NTHREADS * i, row = idx >> 6, c8 = idx & 63; int grow = t0 - 15 + row; if (grow < 0 || idx >= NCH) grow = 0;
            pw[i] = *(const u32x4*)(proj + (size_t)(b * SEQ + grow) * NCOL + 8 * c8); }
#pragma unroll
        for (int i = 0; i < NIT; ++i) { const int idx = tid + NTHREADS * i, row = idx >> 6, c8 = idx & 63; const int grow = t0 - 15 + row;
            if (idx < NCH) { u32x4 w = pw[i]; if (grow < 0) w = (u32x4){0u, 0u, 0u, 0u};
                *(LAS u32x4*)(PE + row * 256 + 4 * c8) = w;
                if (grow >= SEQ - 15) { float* o = p.out + O_POOLP + (((size_t)layer * 8 + b) * 15 + (grow - (SEQ - 15))) * 512 + 8 * c8;
                    *(f32x4*)o = (f32x4){bflo(w.x), bfhi(w.x), bflo(w.y), bfhi(w.y)}; *(f32x4*)(o + 4) = (f32x4){bflo(w.z), bfhi(w.z), bflo(w.w), bfhi(w.w)}; } } }
    }
    __syncthreads();
    for (int idx = tid; idx < T * 256; idx += NTHREADS) {
        const int t = idx >> 8, cp = idx & 255, g = cp >> 6, win = 2 << g;
        float s0 = 0.f, s1 = 0.f;
        for (int j = 0; j < win; ++j) { const unsigned w = PE[(15 + t - j) * 256 + cp]; s0 += bflo(w); s1 += bfhi(w); }
        const unsigned cur = PE[(15 + t) * 256 + cp];
        float cnt = (float)win; if (!SAMPLE) { const int pp = t0 + t + 1; cnt = (float)(pp < win ? pp : win); }
        const float inv = 1.0f / cnt;
        MX[t * 260 + cp] = pk2(s0 * inv - bflo(cur), s1 * inv - bfhi(cur));
    }
    __syncthreads();
    {
        const int g = wave >> 1, ch = wave & 1, h4 = lane >> 4, c = lane & 15;
        const bf16_t* wt = (const bf16_t*)(ws + WS_WPOOL) + ((size_t)(layer * 4 + g) * 128 + 64 * ch) * 128;
        f32x4 acc[NRB][4];
#pragma unroll
        for (int rb = 0; rb < NRB; ++rb)
#pragma unroll
            for (int cb = 0; cb < 4; ++cb) acc[rb][cb] = (f32x4){0.f, 0.f, 0.f, 0.f};
#pragma unroll
        for (int ks = 0; ks < 4; ++ks) {
            bf16x8 bf[NRB];
#pragma unroll
            for (int rb = 0; rb < NRB; ++rb) bf[rb] = *(const LAS bf16x8*)((LAS unsigned char*)MX + (16 * rb + c) * 1040 + (128 * g + 32 * ks + 8 * h4) * 2);
#pragma unroll
            for (int cb = 0; cb < 4; ++cb) { const bf16x8 wf = *(const bf16x8*)(wt + (size_t)(16 * cb + c) * 128 + 32 * ks + 8 * h4);
#pragma unroll
                for (int rb = 0; rb < NRB; ++rb) acc[rb][cb] = __builtin_amdgcn_mfma_f32_16x16x32_bf16(wf, bf[rb], acc[rb][cb], 0, 0, 0); }
        }
        const float* psc = p.in[I_PSCALE] + layer * 512;
#pragma unroll
        for (int rb = 0; rb < NRB; ++rb) { const int tr = 16 * rb + c; if (tr < T) { const size_t row = (size_t)rowbase + tr;
#pragma unroll
                for (int cb = 0; cb < 4; ++cb) { const int col = 128 * g + 64 * ch + 16 * cb + 4 * h4;
                    const f32x4 sc = *(const f32x4*)(psc + col); const u32x2 gt = *(const u32x2*)(proj + row * NCOL + C_PGATE + col); const f32x4 a = acc[rb][cb];
                    u32x2 w; w.x = pk2(a[0] * sc.x * siluf_(bflo(gt.x)), a[1] * sc.y * siluf_(bfhi(gt.x))); w.y = pk2(a[2] * sc.z * siluf_(bflo(gt.y)), a[3] * sc.w * siluf_(bfhi(gt.y)));
                    *(u32x2*)(br + row * BR_LD + col) = w; } } }
    }
}

template <int T, bool SAMPLE>
__device__ __forceinline__ void conv_task(const Params& p, int layer, LAS unsigned char* lds, int task, int tid, int wave, int lane) {
    constexpr int R = T + 30, TT = T / 2;
    unsigned char* ws = p.ws;
    const bf16_t* proj = (const bf16_t*)(ws + WS_PROJ); bf16_t* br = (bf16_t*)(ws + WS_BR);
    LAS unsigned* U = (LAS unsigned*)lds;
    LAS float* CO = (LAS float*)(lds + R * 1024);
    int b = 0, t0 = 0, seq = 0, rowbase;
    if (SAMPLE) { seq = task; rowbase = MP + seq * 8; } else { b = task >> 6; t0 = (task & 63) * T; rowbase = b * SEQ + t0; }
    __syncthreads();
#define GLU8(cv, cg_, ua, ub) do { \
        ua = (f32x4){bflo(cv.x) * sigmoidf_(bflo(cg_.x)), bfhi(cv.x) * sigmoidf_(bfhi(cg_.x)), bflo(cv.y) * sigmoidf_(bflo(cg_.y)), bfhi(cv.y) * sigmoidf_(bfhi(cg_.y))}; \
        ub = (f32x4){bflo(cv.z) * sigmoidf_(bflo(cg_.z)), bfhi(cv.z) * sigmoidf_(bfhi(cg_.z)), bflo(cv.w) * sigmoidf_(bflo(cg_.w)), bfhi(cv.w) * sigmoidf_(bfhi(cg_.w))}; } while (0)
    if (SAMPLE) {
        f32x4 sa[4], sb[4]; u32x4 cv, cg_;
#pragma unroll
        for (int i = 0; i < 4; ++i) { const int idx = tid + NTHREADS * i, row = idx < 1920 ? (idx >> 6) : 0, c8 = idx & 63;
            const float* src = p.in[I_SCONV] + (((size_t)layer * NSEQ + seq) * 30 + row) * 512 + 8 * c8; sa[i] = *(const f32x4*)src; sb[i] = *(const f32x4*)(src + 4); }
        { const int row = tid >> 6, c8 = tid & 63; const bf16_t* src = proj + (size_t)(rowbase + row) * NCOL + 8 * c8; cv = *(const u32x4*)(src + C_CVAL); cg_ = *(const u32x4*)(src + C_CGLU); }
#pragma unroll
        for (int i = 0; i < 4; ++i) { const int idx = tid + NTHREADS * i, row = idx >> 6, c8 = idx & 63;
            if (idx < 1920) { u32x4 w; w.x = pk2(sa[i].x, sa[i].y); w.y = pk2(sa[i].z, sa[i].w); w.z = pk2(sb[i].x, sb[i].y); w.w = pk2(sb[i].z, sb[i].w);
                *(LAS u32x4*)(U + row * 256 + 4 * c8) = w;
                if (row >= 8) { float* o = p.out + O_CONVS + (((size_t)layer * NSEQ + seq) * 30 + (row - 8)) * 512 + 8 * c8; *(f32x4*)o = sa[i]; *(f32x4*)(o + 4) = sb[i]; } } }
        { const int row = 30 + (tid >> 6), c8 = tid & 63; f32x4 ua, ub; GLU8(cv, cg_, ua, ub);
            u32x4 w; w.x = pk2(ua.x, ua.y); w.y = pk2(ua.z, ua.w); w.z = pk2(ub.x, ub.y); w.w = pk2(ub.z, ub.w);
            *(LAS u32x4*)(U + row * 256 + 4 * c8) = w;
            float* o = p.out + O_CONVS + (((size_t)layer * NSEQ + seq) * 30 + (row - 8)) * 512 + 8 * c8; *(f32x4*)o = ua; *(f32x4*)(o + 4) = ub; }
    } else {
        constexpr int NCH = R * 64, NIT = (NCH + NTHREADS - 1) / NTHREADS;
        u32x4 cv[NIT], cg_[NIT];
#pragma unroll
        for (int i = 0; i < NIT; ++i) { const int idx = tid + NTHREADS * i, row = idx >> 6, c8 = idx & 63; int gs = t0 - 30 + row; if (gs < 0 || idx >= NCH) gs = 0;
            const bf16_t* src = proj + (size_t)(b * SEQ + gs) * NCOL + 8 * c8; cv[i] = *(const u32x4*)(src + C_CVAL); cg_[i] = *(const u32x4*)(src + C_CGLU); }
#pragma unroll
        for (int i = 0; i < NIT; ++i) { const int idx = tid + NTHREADS * i, row = idx >> 6, c8 = idx & 63; const int gs = t0 - 30 + row;
            if (idx < NCH) { f32x4 ua, ub; GLU8(cv[i], cg_[i], ua, ub); if (gs < 0) { ua = (f32x4){0.f, 0.f, 0.f, 0.f}; ub = ua; }
                u32x4 w; w.x = pk2(ua.x, ua.y); w.y = pk2(ua.z, ua.w); w.z = pk2(ub.x, ub.y); w.w = pk2(ub.z, ub.w);
                *(LAS u32x4*)(U + row * 256 + 4 * c8) = w;
                if (gs >= SEQ - 30) { float* o = p.out + O_CONVP + (((size_t)layer * 8 + b) * 30 + (gs - (SEQ - 30))) * 512 + 8 * c8; *(f32x4*)o = ua; *(f32x4*)(o + 4) = ub; } } }
    }
#undef GLU8
    __syncthreads();
    {
        const int cp = tid & 255, half = tid >> 8;
        const f32x2* cw = (const f32x2*)(p.in[I_CONVW] + (size_t)layer * 31 * 512) + cp;
        f32x2 wk[31];
#pragma unroll
        for (int k = 0; k < 31; ++k) wk[k] = cw[k * 256];
        const f32x2 bias = *((const f32x2*)(p.in[I_CONVB] + layer * 512) + cp);
        f32x2 acc[TT];
#pragma unroll
        for (int t = 0; t < TT; ++t) acc[t] = bias;
#pragma unroll
        for (int j = 0; j < TT + 30; ++j) {
            const unsigned uu = U[(half * TT + j) * 256 + cp]; const f32x2 uv = (f32x2){bflo(uu), bfhi(uu)};
#pragma unroll
            for (int t = 0; t < TT; ++t) { const int k = j - t; if (k >= 0 && k < 31) acc[t] += wk[k] * uv; }
        }
#pragma unroll
        for (int t = 0; t < TT; ++t) *(LAS f32x2*)(CO + (half * TT + t) * 512 + 2 * cp) = acc[t];
    }
    __syncthreads();
    {
        const float* lg = p.in[I_LNG] + layer * 512 + 8 * lane; const float* lb = p.in[I_LNB] + layer * 512 + 8 * lane;
        const f32x4 g0 = *(const f32x4*)lg, g1 = *(const f32x4*)(lg + 4), b0 = *(const f32x4*)lb, b1 = *(const f32x4*)(lb + 4);
        for (int t = wave; t < T; t += 8) {
            const f32x4 x0 = *(const LAS f32x4*)(CO + t * 512 + 8 * lane), x1 = *(const LAS f32x4*)(CO + t * 512 + 8 * lane + 4);
            const float mean = wave_sum((x0.x + x0.y) + (x0.z + x0.w) + (x1.x + x1.y) + (x1.z + x1.w)) * (1.f / 512.f);
            const f32x4 d0 = x0 - mean, d1 = x1 - mean;
            const float var = wave_sum((d0.x * d0.x + d0.y * d0.y) + (d0.z * d0.z + d0.w * d0.w) + (d1.x * d1.x + d1.y * d1.y) + (d1.z * d1.z + d1.w * d1.w)) * (1.f / 512.f);
            const float rstd = 1.0f / sqrtf(var + EPS);
            const f32x4 y0 = d0 * rstd * g0 + b0, y1 = d1 * rstd * g1 + b1;
            const size_t row = (size_t)rowbase + t;
            const u32x4 gt = *(const u32x4*)(proj + row * NCOL + C_CGATE + 8 * lane);
            u32x4 w;
            w.x = pk2(siluf_(y0.x) * siluf_(bflo(gt.x)), siluf_(y0.y) * siluf_(bfhi(gt.x))); w.y = pk2(siluf_(y0.z) * siluf_(bflo(gt.y)), siluf_(y0.w) * siluf_(bfhi(gt.y)));
            w.z = pk2(siluf_(y1.x) * siluf_(bflo(gt.z)), siluf_(y1.y) * siluf_(bfhi(gt.z))); w.w = pk2(siluf_(y1.z) * siluf_(bflo(gt.w)), siluf_(y1.w) * siluf_(bfhi(gt.w)));
            *(u32x4*)(br + row * BR_LD + 512 + 8 * lane) = w;
        }
    }
}

constexpr int KS_STRIDE = 272, VT_STRIDE = 528, VT_OFF = 256 * KS_STRIDE;
template <bool SAMPLE>
__device__ __forceinline__ void attn_task(const Params& p, int layer, LAS unsigned char* lds, int task, int tid, int wave, int lane) {
    unsigned char* ws = p.ws;
    const bf16_t* proj = (const bf16_t*)(ws + WS_PROJ); bf16_t* br = (bf16_t*)(ws + WS_BR);
    int b = 0, head, qc = 0, seq = 0;
    if (SAMPLE) { seq = task >> 2; head = task & 3; } else { b = task >> 5; head = (task >> 3) & 3; qc = task & 7; }
    __syncthreads();
    if (SAMPLE) {
        const float* kb = p.in[I_CK] + (((size_t)layer * NSEQ + seq) * 256) * 512 + head * 128; const float* vb = p.in[I_CV] + (((size_t)layer * NSEQ + seq) * 256) * 512 + head * 128;
#pragma unroll
        for (int hf = 0; hf < 2; ++hf) { f32x4 ka[4], kc[4];
#pragma unroll
            for (int i = 0; i < 4; ++i) { const int c = tid + NTHREADS * (4 * hf + i), key = c >> 4, dc = c & 15; const float* src = kb + (size_t)key * 512 + dc * 8; ka[i] = *(const f32x4*)src; kc[i] = *(const f32x4*)(src + 4); }
#pragma unroll
            for (int i = 0; i < 4; ++i) { const int c = tid + NTHREADS * (4 * hf + i), key = c >> 4, dc = c & 15;
                u32x4 w; w.x = pk2(ka[i].x, ka[i].y); w.y = pk2(ka[i].z, ka[i].w); w.z = pk2(kc[i].x, kc[i].y); w.w = pk2(kc[i].z, kc[i].w);
                *(LAS u32x4*)(lds + key * KS_STRIDE + dc * 16) = w; }
            asm volatile("" ::: "memory"); }
        const int d4 = 8 * (wave & 3) + (lane >> 3);
#pragma unroll
        for (int i = 0; i < 2; ++i) { const int ch = (lane & 7) + 8 * (wave >> 2) + 16 * i; const float* src = vb + (size_t)(8 * ch) * 512 + 4 * d4;
            f32x4 v[8];
#pragma unroll
            for (int j = 0; j < 8; ++j) v[j] = *(const f32x4*)(src + (size_t)j * 512);
#pragma unroll
            for (int q = 0; q < 4; ++q) { u32x4 w; w.x = pk2(v[0][q], v[1][q]); w.y = pk2(v[2][q], v[3][q]); w.z = pk2(v[4][q], v[5][q]); w.w = pk2(v[6][q], v[7][q]);
                *(LAS u32x4*)(lds + VT_OFF + (4 * d4 + q) * VT_STRIDE + ch * 16) = w; }
            asm volatile("" ::: "memory"); }
    } else {
        const bf16_t* kb = (const bf16_t*)(ws + WS_KVB) + ((size_t)layer * 2048 + b * 256) * 512 + head * 128;
        const bf16_t* vt = (const bf16_t*)(ws + WS_KVB) + (size_t)2 * 2048 * 512 + ((size_t)layer * 512 + head * 128) * 2048 + b * 256;
        u32x4 kw[8], vw[8];
#pragma unroll
        for (int i = 0; i < 8; ++i) { const int c = tid + NTHREADS * i; kw[i] = *(const u32x4*)(kb + (size_t)(c >> 4) * 512 + (c & 15) * 8); vw[i] = *(const u32x4*)(vt + (size_t)(c >> 5) * 2048 + (c & 31) * 8); }
#pragma unroll
        for (int i = 0; i < 8; ++i) { const int c = tid + NTHREADS * i;
            *(LAS u32x4*)(lds + (c >> 4) * KS_STRIDE + (c & 15) * 16) = kw[i]; *(LAS u32x4*)(lds + VT_OFF + (c >> 5) * VT_STRIDE + (c & 31) * 16) = vw[i]; }
    }
    __syncthreads();
    const int h4 = lane >> 4, c = lane & 15;
    const int ntiles = SAMPLE ? 1 : 16, nvalid = SAMPLE ? 8 : 16;
    for (int wt = wave; wt < ntiles; wt += 8) {
        const int qrow0 = SAMPLE ? (MP + seq * 8) : (b * SEQ + qc * 256 + wt * 16);
        const int cr = c < nvalid ? c : nvalid - 1;
        const bf16_t* qrow = proj + (size_t)(qrow0 + cr) * NCOL + C_Q + head * 128 + 8 * h4;
        bf16x8 qf[4];
#pragma unroll
        for (int ks = 0; ks < 4; ++ks) qf[ks] = *(const bf16x8*)(qrow + 32 * ks);
        f32x4 s[16];
#pragma unroll
        for (int nb = 0; nb < 16; ++nb) {
            s[nb] = (f32x4){0.f, 0.f, 0.f, 0.f};
            const int keyrow = 32 * (nb >> 1) + 8 * (c >> 2) + 4 * (nb & 1) + (c & 3);
#pragma unroll
            for (int ks = 0; ks < 4; ++ks) { const bf16x8 kf = *(const LAS bf16x8*)(lds + keyrow * KS_STRIDE + (32 * ks + 8 * h4) * 2);
                s[nb] = __builtin_amdgcn_mfma_f32_16x16x32_bf16(kf, qf[ks], s[nb], 0, 0, 0); }
            if (nb & 1) asm volatile("" ::: "memory");
        }
        float mx = -3.0e38f;
#pragma unroll
        for (int nb = 0; nb < 16; ++nb) mx = fmaxf(fmaxf(fmaxf(s[nb][0], s[nb][1]), fmaxf(s[nb][2], s[nb][3])), mx);
        mx = fmaxf(mx, __shfl_xor(mx, 16)); mx = fmaxf(mx, __shfl_xor(mx, 32));
        const float sc = 0.08838834764831845f * 1.4426950408889634f;
        float sum = 0.f;
#pragma unroll
        for (int nb = 0; nb < 16; ++nb)
#pragma unroll
            for (int i = 0; i < 4; ++i) { const float e = __builtin_amdgcn_exp2f((s[nb][i] - mx) * sc); s[nb][i] = e; sum += e; }
        sum += __shfl_xor(sum, 16); sum += __shfl_xor(sum, 32);
        const float inv = 1.0f / sum;
        bf16x8 pf[8];
#pragma unroll
        for (int si = 0; si < 8; ++si) { u32x4 w; w.x = pk2(s[2 * si][0], s[2 * si][1]); w.y = pk2(s[2 * si][2], s[2 * si][3]); w.z = pk2(s[2 * si + 1][0], s[2 * si + 1][1]); w.w = pk2(s[2 * si + 1][2], s[2 * si + 1][3]);
            pf[si] = __builtin_bit_cast(bf16x8, w); }
#pragma unroll
        for (int nd = 0; nd < 8; ++nd) {
            f32x4 o = (f32x4){0.f, 0.f, 0.f, 0.f};
#pragma unroll
            for (int si = 0; si < 8; ++si) { const bf16x8 vf = *(const LAS bf16x8*)(lds + VT_OFF + (16 * nd + c) * VT_STRIDE + (32 * si + 8 * h4) * 2);
                o = __builtin_amdgcn_mfma_f32_16x16x32_bf16(vf, pf[si], o, 0, 0, 0); }
            if (c < nvalid) { const size_t row = (size_t)qrow0 + c; const int col = head * 128 + 16 * nd + 4 * h4;
                const u32x2 gt = *(const u32x2*)(proj + row * NCOL + C_XGATE + col);
                u32x2 w; w.x = pk2(o[0] * inv * siluf_(bflo(gt.x)), o[1] * inv * siluf_(bfhi(gt.x))); w.y = pk2(o[2] * inv * siluf_(bflo(gt.y)), o[3] * inv * siluf_(bfhi(gt.y)));
                *(u32x2*)(br + row * BR_LD + 1024 + col) = w; }
            asm volatile("" ::: "memory");
        }
    }
}


template <int KSTEPS>
__device__ __forceinline__ void small_mma(const bf16_t* A, int lda, const bf16_t* Bt, int ldb, int lane, f32x4 (&acc)[2]) {
    const int h4 = lane >> 4, r = lane & 15;
    const bf16_t* ap = A + (size_t)r * lda + 8 * h4; const bf16_t* b0 = Bt + (size_t)r * ldb + 8 * h4; const bf16_t* b1 = b0 + (size_t)16 * ldb;
#pragma unroll 8
    for (int ks = 0; ks < KSTEPS; ++ks) { const bf16x8 af = *(const bf16x8*)(ap + 32 * ks), w0 = *(const bf16x8*)(b0 + 32 * ks), w1 = *(const bf16x8*)(b1 + 32 * ks);
        acc[0] = __builtin_amdgcn_mfma_f32_16x16x32_bf16(w0, af, acc[0], 0, 0, 0); acc[1] = __builtin_amdgcn_mfma_f32_16x16x32_bf16(w1, af, acc[1], 0, 0, 0); }
}
__device__ __forceinline__ void p3_small(const Params& p, int layer, int task, int wave, int lane) {
    unsigned char* ws = p.ws; const bf16_t* proj = (const bf16_t*)(ws + WS_PROJ);
    const int rt = task >> 4, ct = task & 15, wr = wave >> 1, wc = wave & 1, h4 = lane >> 4, c = lane & 15;
    const int row = MP + 64 * rt + 16 * wr + c, col0 = 64 * ct + 32 * wc + 4 * h4;
    f32x4 mg[2] = {(f32x4){0.f, 0.f, 0.f, 0.f}, (f32x4){0.f, 0.f, 0.f, 0.f}};
#pragma unroll 1
    for (int z = 0; z < 3; ++z) {
        f32x4 acc[2] = {(f32x4){0.f, 0.f, 0.f, 0.f}, (f32x4){0.f, 0.f, 0.f, 0.f}};
        u32x2 lg[2];
#pragma unroll
        for (int n = 0; n < 2; ++n) lg[n] = *(const u32x2*)(proj + (size_t)row * NCOL + C_LOGIT + z * D + col0 + 16 * n);
        small_mma<16>((const bf16_t*)(ws + WS_BR) + (size_t)(MP + 64 * rt + 16 * wr) * BR_LD + z * 512, BR_LD,
                      (const bf16_t*)(ws + WS_WBR) + ((size_t)(layer * 3 + z) * D + 64 * ct + 32 * wc) * 512, 512, lane, acc);
#pragma unroll
        for (int n = 0; n < 2; ++n) { mg[n][0] += acc[n][0] * sigmoidf_(bflo(lg[n].x)); mg[n][1] += acc[n][1] * sigmoidf_(bfhi(lg[n].x)); mg[n][2] += acc[n][2] * sigmoidf_(bflo(lg[n].y)); mg[n][3] += acc[n][3] * sigmoidf_(bfhi(lg[n].y)); }
    }
#pragma unroll
    for (int n = 0; n < 2; ++n) { u32x2 w; w.x = pk2(mg[n][0], mg[n][1]); w.y = pk2(mg[n][2], mg[n][3]); *(u32x2*)((bf16_t*)(ws + WS_MRG) + (size_t)row * D + col0 + 16 * n) = w; }
}
__device__ __forceinline__ void p4_small(const Params& p, int layer, LAS unsigned char* lds, int task, int wave, int lane) {
    unsigned char* ws = p.ws;
    const int rt = task >> 4, ct = task & 15, wr = wave >> 1, wc = wave & 1, h4 = lane >> 4, c = lane & 15;
    const int row = MP + 64 * rt + 16 * wr + c, col0 = 64 * ct + 32 * wc + 4 * h4;
    f32x4 acc[2] = {(f32x4){0.f, 0.f, 0.f, 0.f}, (f32x4){0.f, 0.f, 0.f, 0.f}};
    small_mma<32>((const bf16_t*)(ws + WS_MRG) + (size_t)(MP + 64 * rt + 16 * wr) * D, D, (const bf16_t*)(ws + WS_WOUT) + ((size_t)layer * D + 64 * ct + 32 * wc) * D, D, lane, acc);
    float s = 0.f;
#pragma unroll
    for (int n = 0; n < 2; ++n) { const f32x4 v = acc[n]; s += (v[0] * v[0] + v[1] * v[1]) + (v[2] * v[2] + v[3] * v[3]);
        u32x2 w; w.x = pk2(v[0], v[1]); w.y = pk2(v[2], v[3]); *(u32x2*)((bf16_t*)(ws + WS_Y) + (size_t)row * D + col0 + 16 * n) = w; }
    s += __shfl_xor(s, 16); s += __shfl_xor(s, 32);
    LAS float* red = (LAS float*)lds;
    __syncthreads();
    if (h4 == 0) red[(16 * wr + c) * 2 + wc] = s;
    __syncthreads();
    if (threadIdx.x < 64) ((float*)(ws + WS_SSQ))[(size_t)(MP + 64 * rt + threadIdx.x) * 16 + ct] = red[threadIdx.x * 2] + red[threadIdx.x * 2 + 1];
}

__global__ void __launch_bounds__(NTHREADS, 2) mk_fwd(Params p) {
    extern __shared__ __attribute__((aligned(16))) unsigned char lds_raw[];
    LAS unsigned char* lds = (LAS unsigned char*)lds_raw;
    cg::grid_group grid = cg::this_grid();
    const int G = gridDim.x, bx = blockIdx.x;
    const int vcu = (G % 8 == 0) ? (bx % 8) * (G / 8) + bx / 8 : bx;
    const int NGW = G * 8;
#define IDS() int tid = threadIdx.x; asm volatile("" : "+v"(tid)); const int lane = tid & 63, wave = __builtin_amdgcn_readfirstlane(tid >> 6), gw = vcu * 8 + wave; (void)gw; (void)lane
    unsigned char* ws = p.ws;
    const int lo = p.ph_lo, hi = p.ph_hi;
#define IN(k) (lo <= (k) && (k) < hi)
    if (threadIdx.x < 4) ((LAS unsigned*)(lds + LDS_BAR_OFF))[threadIdx.x] = 0u;
    __syncthreads();
    XcdBarrier xbar; xbar.bar = (unsigned*)(ws + WS_BAR); xbar.x = 0; xbar.st = (volatile LAS unsigned*)(lds + LDS_BAR_OFF);
    if (hi - lo > 1) xbar = xcd_barrier_post((unsigned*)(ws + WS_BAR), (volatile LAS unsigned*)(lds + LDS_BAR_OFF));
#define SEAM(k) do { if (IN(k) && IN((k) + 1)) { if (p.use_cg) grid.sync(); else xcd_barrier(xbar); } } while (0)

    if (IN(0)) for (int rep = 0; rep < REP0; ++rep) { IDS(); p0_prologue(p, lds, gw, NGW, wave, lane); }
    SEAM(0);
#pragma unroll 1
    for (int layer = 0; layer < 2; ++layer) {
        const int pb = 1 + 5 * layer;
        if (IN(pb)) for (int rep = 0; rep < REP1; ++rep) {
            { pg8::Gemm g{(const bf16_t*)(ws + WS_H), (const bf16_t*)(ws + WS_WIN) + (size_t)layer * NCOL * D, D, D, D, 0, 0};
              pg8::Order S; S.init(MT, NCOL, 1, 0, G, bx);
              pg8::EpiStoreBf16 E{(bf16_t*)(ws + WS_PROJ), NCOL};
              pg8::gemm_phase<pg8::EpiStoreBf16>(lds, g, S, E); }
            if (layer == 0) {
              { pg8::Gemm g{(const bf16_t*)(ws + WS_MEMN), (const bf16_t*)(ws + WS_WKV), D, D, D, 2048u * D * 2u, (unsigned)D * D * 2u};
                pg8::Order S; S.init(2048, 512, 2, 0, G, G - 1 - bx);
                pg8::EpiK E{p.out + O_MK, (bf16_t*)(ws + WS_KVB)};
                pg8::gemm_phase<pg8::EpiK>(lds, g, S, E); }
              { pg8::Gemm g{(const bf16_t*)(ws + WS_WKV) + (size_t)512 * D, (const bf16_t*)(ws + WS_MEMN), D, D, D, (unsigned)D * D * 2u, 2048u * D * 2u};
                int cv = G - 33 - bx; if (cv < 0) cv += G;
                pg8::Order S; S.init(512, 2048, 2, 0, G, cv);
                pg8::EpiVt E{p.out + O_MV, (bf16_t*)(ws + WS_KVB) + (size_t)2 * 2048 * 512};
                pg8::gemm_phase<pg8::EpiVt>(lds, g, S, E); }
            }
        }
        SEAM(pb);
        if (IN(pb + 1)) for (int rep = 0; rep < REP2; ++rep) {
            IDS();
            for (int t = bx; t < 512; t += G) pool_task<32, false>(p, layer, lds, t, tid, wave, lane);
            for (int t = bx; t < 512; t += G) conv_task<32, false>(p, layer, lds, t, tid, wave, lane);
            for (int t = bx; t < 256; t += G) { if (t < 128) pool_task<8, true>(p, layer, lds, t, tid, wave, lane); else conv_task<8, true>(p, layer, lds, t - 128, tid, wave, lane); }
            for (int t = bx; t < 256; t += G) attn_task<false>(p, layer, lds, t, tid, wave, lane);
            for (int t = bx; t < 512; t += G) attn_task<true>(p, layer, lds, t, tid, wave, lane);
        }
        SEAM(pb + 1);
        if (IN(pb + 2)) for (int rep = 0; rep < REP3; ++rep) {
            pg8::Gemm g{(const bf16_t*)(ws + WS_BR), (const bf16_t*)(ws + WS_WBR) + (size_t)layer * 3 * D * 512, 512, BR_LD, 512, 512u * 2u, (unsigned)D * 512u * 2u};
            pg8::Order S; S.init(MP, D, 3, 1, G, bx);
            pg8::EpiMerge E{(const bf16_t*)(ws + WS_PROJ), (bf16_t*)(ws + WS_MRG)};
            pg8::gemm_phase<pg8::EpiMerge>(lds, g, S, E);
            { IDS(); for (int t = bx; t < 256; t += G) p3_small(p, layer, t, wave, lane); }
        }
        SEAM(pb + 2);
        if (IN(pb + 3)) for (int rep = 0; rep < REP4; ++rep) {
            pg8::Gemm g{(const bf16_t*)(ws + WS_MRG), (const bf16_t*)(ws + WS_WOUT) + (size_t)layer * D * D, D, D, D, 0, 0};
            pg8::Order S; S.init(MP, D, 1, 0, G, bx);
            pg8::EpiY E{(bf16_t*)(ws + WS_Y), (float*)(ws + WS_SSQ)};
            pg8::gemm_phase<pg8::EpiY>(lds, g, S, E);
            { IDS(); for (int t = bx; t < 256; t += G) p4_small(p, layer, lds, t, wave, lane); }
        }
        SEAM(pb + 3);
        if (IN(pb + 4)) for (int rep = 0; rep < (layer == 0 ? REP5 : 1); ++rep) { IDS(); p5_residual(p, layer, gw, NGW, lane); }
        if (layer == 0) SEAM(pb + 4);
    }
#undef IN
#undef SEAM
#undef IDS
}

extern "C" void kernel_launch(void* const* d_in, const int* in_sizes, int n_in, void* d_out, int out_size, void* d_ws, size_t ws_size, hipStream_t stream) {
    static int grid = 0;
    if (grid == 0) {
        if (n_in != 20 || ws_size < WS_END) { fprintf(stderr, "kernel_launch: expected 20 inputs and >= %zu bytes of workspace (got %d, %zu)\n", (size_t)WS_END, n_in, ws_size); grid = -1; return; }
        int dev = 0, cus = 0, per_cu = 0;
        if (hipGetDevice(&dev) != hipSuccess || hipDeviceGetAttribute(&cus, hipDeviceAttributeMultiprocessorCount, dev) != hipSuccess) { grid = -1; return; }
        if (hipFuncSetAttribute((const void*)mk_fwd, hipFuncAttributeMaxDynamicSharedMemorySize, LDS_BYTES) != hipSuccess) { fprintf(stderr, "kernel_launch: hipFuncSetAttribute failed\n"); grid = -1; return; }
        if (hipOccupancyMaxActiveBlocksPerMultiprocessor(&per_cu, (const void*)mk_fwd, NTHREADS, LDS_BYTES) != hipSuccess || per_cu < 1) { fprintf(stderr, "kernel_launch: occupancy query says %d blocks per CU\n", per_cu); (void)hipGetLastError(); per_cu = 1; }
        grid = cus;
    }
    if (grid < 0) return;
    Params p{};
    for (int i = 0; i < 20; ++i) p.in[i] = (const float*)d_in[i];
    p.out = (float*)d_out; p.ws = (unsigned char*)d_ws;
#if MK_LAUNCHES == 1
    p.ph_lo = 0; p.ph_hi = NPHASES;
    if (hipMemsetAsync((char*)d_ws + WS_BAR, 0, XCD_BAR_WORDS * 4, stream) != hipSuccess) { fprintf(stderr, "kernel_launch: memset of the barrier words failed\n"); return; }
    void* args[] = {&p};
    hipError_t e = hipLaunchCooperativeKernel((const void*)mk_fwd, dim3(grid), dim3(NTHREADS), args, LDS_BYTES, stream);
    if (e != hipSuccess) fprintf(stderr, "cooperative launch failed: %s (grid %d)\n", hipGetErrorString(e), grid);
#else
    for (int k = 0; k < NPHASES; ++k) { p.ph_lo = k; p.ph_hi = k + 1; hipLaunchKernelGGL(mk_fwd, dim3(grid), dim3(NTHREADS), LDS_BYTES, stream, p); }
#endif
}
```

```cpp
#include <hip/hip_runtime.h>
#include <hip/hip_cooperative_groups.h>
#include <cstdio>
#include <cstdint>
namespace cg = cooperative_groups;

#define LAS __attribute__((address_space(3)))
typedef unsigned short bf16_t;
typedef short bf16x8 __attribute__((ext_vector_type(8)));
typedef float f32x4 __attribute__((ext_vector_type(4)));
typedef float f32x2 __attribute__((ext_vector_type(2)));
typedef unsigned u32x4 __attribute__((ext_vector_type(4)));
typedef unsigned u32x2 __attribute__((ext_vector_type(2)));

constexpr int D = 1024, NCOL = 6656, MP = 16384, MS = 1024, MT = MP + MS, SEQ = 2048, NSEQ = 128;
constexpr int C_PGATE = 512, C_CVAL = 1024, C_CGLU = 1536, C_CGATE = 2048, C_Q = 2560, C_XGATE = 3072, C_LOGIT = 3584;
constexpr int BR_LD = 1536;
constexpr float EPS = 1e-6f;
constexpr size_t O_POOLP = 17825792, O_CONVP = 17948672, O_MK = 18194432, O_MV = 20291584, O_POOLS = 22388736, O_CONVS = 24354816;
constexpr size_t WS_WIN = 0;
constexpr size_t WS_WKV = WS_WIN + (size_t)2 * NCOL * D * 2;
constexpr size_t WS_WBR = WS_WKV + (size_t)2 * D * D * 2;
constexpr size_t WS_WOUT = WS_WBR + (size_t)6 * D * 512 * 2;
constexpr size_t WS_WPOOL = WS_WOUT + (size_t)2 * D * D * 2;
constexpr size_t WS_H = WS_WPOOL + (size_t)8 * 128 * 128 * 2;
constexpr size_t WS_MEMN = WS_H + (size_t)MT * D * 2;
constexpr size_t WS_PROJ = WS_MEMN + (size_t)2 * 2048 * D * 2;
constexpr size_t WS_KVB = WS_PROJ + (size_t)MT * NCOL * 2;
constexpr size_t WS_BR = WS_KVB + (size_t)2 * 2048 * D * 2;
constexpr size_t WS_MRG = WS_BR + (size_t)MT * BR_LD * 2;
constexpr size_t WS_Y = WS_MRG + (size_t)MT * D * 2;
constexpr size_t WS_SSQ = WS_Y + (size_t)MT * D * 2;
constexpr size_t WS_BAR = WS_SSQ + (size_t)MT * 16 * 4;
constexpr size_t WS_END = WS_BAR + 3456 * 4;
constexpr int LDS_BAR_OFF = 140 * 1024 - 16;
constexpr int LDS_BYTES = 140 * 1024;
constexpr int NTHREADS = 512;

#ifndef MK_LAUNCHES
#define MK_LAUNCHES 1
#endif
constexpr int NPHASES = 11;
constexpr int R2A = 1, R2B = 1, R2C = 1, R2D = 1, R2E = 1;
constexpr int REP0 = 1, REP1 = 1, REP2 = 1, REP3 = 1, REP4 = 1, REP5 = 1;

__device__ __forceinline__ unsigned pk2(float lo, float hi) { unsigned r; asm("v_cvt_pk_bf16_f32 %0, %1, %2" : "=v"(r) : "v"(lo), "v"(hi)); return r; }
__device__ __forceinline__ float bflo(unsigned w) { return __uint_as_float(w << 16); }
__device__ __forceinline__ float bfhi(unsigned w) { return __uint_as_float(w & 0xffff0000u); }
__device__ __forceinline__ float bf1(bf16_t b) { return __uint_as_float(((unsigned)b) << 16); }
__device__ __forceinline__ float sigmoidf_(float x) { return __builtin_amdgcn_rcpf(1.0f + __builtin_amdgcn_exp2f(-1.4426950408889634f * x)); }
__device__ __forceinline__ float siluf_(float x) { return x * sigmoidf_(x); }
__device__ __forceinline__ float wave_sum(float v) {
#pragma unroll
    for (int o = 1; o < 64; o <<= 1) v += __shfl_xor(v, o);
    return v;
}
#define LDS_WAIT() asm volatile("s_waitcnt lgkmcnt(0)" ::: "memory")

namespace pg8 {
constexpr int BM = 256, BK = 64, HALF = 128, HTB = HALF * BK * 2, STAGE_BYTES = 8 * HTB, NXCD = 8, WGM = 8;
__host__ __device__ __forceinline__ int lds_byte(int r, int c) { const int st = (r >> 4) * 2 + (c >> 5), rr = r & 15, cc = c & 31, ob = rr * 64 + cc * 2; return st * 1024 + (ob ^ (((ob >> 9) & 1) << 5)); }
__host__ __device__ __forceinline__ void stage_rc(int b, int& R, int& C) { const int st = b / 1024, sb = b % 1024, swz = sb ^ (((sb >> 9) & 1) << 5); R = (st >> 1) * 16 + swz / 64; C = (st & 1) * 32 + (swz % 64) / 2; }
__host__ __device__ __forceinline__ int perm32(int rho) { const int n = rho >> 4, i = rho & 15; return 8 * (i >> 2) + 4 * n + (i & 3); }

struct Unit { int pm, pn, z; };
struct Gemm { const bf16_t* A; const bf16_t* Bt; int K, lda, ldb; unsigned zA, zB; };

struct Order {
    int nM, nN, ntile, nz, zinner, G, c;
    __device__ void init(int M, int N, int nz_, int zinner_, int G_, int c_) { nM = M / BM; nN = N / BM; ntile = nM * nN; nz = nz_; zinner = zinner_; G = G_; c = c_; }
    __device__ bool next(int i, Unit& u) const {
        int tix, z;
        if (zinner) { tix = (i / nz) * G + c; z = i % nz; if (tix >= ntile) return false; }
        else { const long L = (long)i * G + c; if (L >= (long)ntile * nz) return false; z = (int)(L / ntile); tix = (int)(L % ntile); }
        int wgid = tix; { const int q = ntile / NXCD, r = ntile % NXCD, xcd = wgid % NXCD, off = wgid / NXCD; wgid = (xcd < r ? xcd * (q + 1) : r * (q + 1) + (xcd - r) * q) + off; }
        const int nig = WGM * nN, gid = wgid / nig, fm = gid * WGM, gsz = (nM - fm) < WGM ? (nM - fm) : WGM;
        u.pm = fm + ((wgid % nig) % gsz); u.pn = (wgid % nig) / gsz; u.z = z; return true;
    }
};

struct EpiStoreBf16 {
    static constexpr bool PERM = true;
    bf16_t* O; int ldc;
    __device__ __forceinline__ void operator()(const f32x4 (&acc)[2][2][4][2], const Unit& u, int wr, int wc, int fr, int fq) const {
        const int row0 = u.pm * BM + wr * 64 + fr, col0 = u.pn * BM + wc * 32 + 8 * fq;
#pragma unroll
        for (int ai = 0; ai < 2; ++ai)
#pragma unroll
            for (int m = 0; m < 4; ++m) { bf16_t* rowp = O + (size_t)(row0 + ai * HALF + m * 16) * ldc + col0;
#pragma unroll
                for (int bj = 0; bj < 2; ++bj) { const f32x4 v0 = acc[ai][bj][m][0], v1 = acc[ai][bj][m][1];
                    u32x4 w; w.x = pk2(v0[0], v0[1]); w.y = pk2(v0[2], v0[3]); w.z = pk2(v1[0], v1[1]); w.w = pk2(v1[2], v1[3]);
                    *(u32x4*)(rowp + bj * HALF) = w; } }
    }
};
struct EpiK {
    static constexpr bool PERM = false;
    float* outK; bf16_t* kb;
    __device__ __forceinline__ void operator()(const f32x4 (&acc)[2][2][4][2], const Unit& u, int wr, int wc, int fr, int fq) const {
        const int row0 = u.pm * BM + wr * 64 + fr, col0 = u.pn * BM + wc * 32 + 4 * fq;
        float* of = outK + (size_t)u.z * 2048 * 512; bf16_t* ob = kb + (size_t)u.z * 2048 * 512;
#pragma unroll
        for (int ai = 0; ai < 2; ++ai)
#pragma unroll
            for (int m = 0; m < 4; ++m) { const int r = row0 + ai * HALF + m * 16;
#pragma unroll
                for (int bj = 0; bj < 2; ++bj)
#pragma unroll
                    for (int n = 0; n < 2; ++n) { const f32x4 v = acc[ai][bj][m][n]; const int c = col0 + bj * HALF + n * 16;
                        *(f32x4*)(of + (size_t)r * 512 + c) = v;
                        u32x2 w; w.x = pk2(v[0], v[1]); w.y = pk2(v[2], v[3]);
                        *(u32x2*)(ob + (size_t)r * 512 + c) = w; } }
    }
};
struct EpiVt {
    static constexpr bool PERM = true;
    float* outV; bf16_t* vt;
    __device__ __forceinline__ void operator()(const f32x4 (&acc)[2][2][4][2], const Unit& u, int wr, int wc, int fr, int fq) const {
        const int row0 = u.pm * BM + wr * 64 + fr, col0 = u.pn * BM + wc * 32 + 8 * fq;
        float* of = outV + (size_t)u.z * 2048 * 512; bf16_t* ob = vt + (size_t)u.z * 512 * 2048;
#pragma unroll
        for (int ai = 0; ai < 2; ++ai)
#pragma unroll
            for (int m = 0; m < 4; ++m) { const int r = row0 + ai * HALF + m * 16;
#pragma unroll
                for (int bj = 0; bj < 2; ++bj) { const f32x4 v0 = acc[ai][bj][m][0], v1 = acc[ai][bj][m][1]; const int c = col0 + bj * HALF;
                    u32x4 w; w.x = pk2(v0[0], v0[1]); w.y = pk2(v0[2], v0[3]); w.z = pk2(v1[0], v1[1]); w.w = pk2(v1[2], v1[3]);
                    *(u32x4*)(ob + (size_t)r * 2048 + c) = w;
#pragma unroll
                    for (int j = 0; j < 4; ++j) { of[(size_t)(c + j) * 512 + r] = v0[j]; of[(size_t)(c + 4 + j) * 512 + r] = v1[j]; } } }
    }
};
struct EpiMerge {
    static constexpr bool PERM = true;
    const bf16_t* proj; bf16_t* mrg;
    __device__ __forceinline__ void operator()(const f32x4 (&acc)[2][2][4][2], const Unit& u, int wr, int wc, int fr, int fq) const {
        const int row0 = u.pm * BM + wr * 64 + fr, col0 = u.pn * BM + wc * 32 + 8 * fq;
#pragma unroll
        for (int ai = 0; ai < 2; ++ai)
#pragma unroll
            for (int m = 0; m < 4; ++m) { const int r = row0 + ai * HALF + m * 16;
                const bf16_t* lg = proj + (size_t)r * NCOL + C_LOGIT + u.z * D + col0; bf16_t* mp = mrg + (size_t)r * D + col0;
#pragma unroll
                for (int bj = 0; bj < 2; ++bj) { const f32x4 v0 = acc[ai][bj][m][0], v1 = acc[ai][bj][m][1];
                    const u32x4 g = *(const u32x4*)(lg + bj * HALF);
                    float o[8];
                    o[0] = v0[0] * sigmoidf_(bflo(g.x)); o[1] = v0[1] * sigmoidf_(bfhi(g.x)); o[2] = v0[2] * sigmoidf_(bflo(g.y)); o[3] = v0[3] * sigmoidf_(bfhi(g.y));
                    o[4] = v1[0] * sigmoidf_(bflo(g.z)); o[5] = v1[1] * sigmoidf_(bfhi(g.z)); o[6] = v1[2] * sigmoidf_(bflo(g.w)); o[7] = v1[3] * sigmoidf_(bfhi(g.w));
                    if (u.z != 0) { const u32x4 p = *(const u32x4*)(mp + bj * HALF);
                        o[0] += bflo(p.x); o[1] += bfhi(p.x); o[2] += bflo(p.y); o[3] += bfhi(p.y); o[4] += bflo(p.z); o[5] += bfhi(p.z); o[6] += bflo(p.w); o[7] += bfhi(p.w); }
                    u32x4 w; w.x = pk2(o[0], o[1]); w.y = pk2(o[2], o[3]); w.z = pk2(o[4], o[5]); w.w = pk2(o[6], o[7]);
                    *(u32x4*)(mp + bj * HALF) = w; }
                if (m == 3) asm volatile("" ::: "memory"); }
    }
};
struct EpiY {
    static constexpr bool PERM = true;
    bf16_t* Y; float* ssq;
    __device__ __forceinline__ void operator()(const f32x4 (&acc)[2][2][4][2], const Unit& u, int wr, int wc, int fr, int fq) const {
        const int row0 = u.pm * BM + wr * 64 + fr, col0 = u.pn * BM + wc * 32 + 8 * fq;
#pragma unroll
        for (int ai = 0; ai < 2; ++ai)
#pragma unroll
            for (int m = 0; m < 4; ++m) { const int r = row0 + ai * HALF + m * 16; bf16_t* rowp = Y + (size_t)r * D + col0; float s = 0.f;
#pragma unroll
                for (int bj = 0; bj < 2; ++bj) { const f32x4 v0 = acc[ai][bj][m][0], v1 = acc[ai][bj][m][1];
                    s += (v0[0] * v0[0] + v0[1] * v0[1]) + (v0[2] * v0[2] + v0[3] * v0[3]) + (v1[0] * v1[0] + v1[1] * v1[1]) + (v1[2] * v1[2] + v1[3] * v1[3]);
                    u32x4 w; w.x = pk2(v0[0], v0[1]); w.y = pk2(v0[2], v0[3]); w.z = pk2(v1[0], v1[1]); w.w = pk2(v1[2], v1[3]);
                    *(u32x4*)(rowp + bj * HALF) = w; }
                s += __shfl_xor(s, 16); s += __shfl_xor(s, 32);
                if (fq == 0) ssq[(size_t)r * 16 + u.pn * 4 + wc] = s; }
    }
};

template <class Epi>
__device__ __forceinline__ void gemm_phase(LAS unsigned char* lds, const Gemm g, const Order& S, const Epi& E) {
    int tid = threadIdx.x; asm volatile("" : "+v"(tid));
    const int wid = __builtin_amdgcn_readfirstlane(tid >> 6), lane = tid & 63, wr = wid >> 2, wc = wid & 3, fr = lane & 15, fq = lane >> 4;
    const int K = g.K, nt = K / BK;
    unsigned voffA[2], voffB[2];
#pragma unroll
    for (int i = 0; i < 2; ++i) { int R, C; stage_rc(tid * 16 + i * 8192, R, C); const int Rb = Epi::PERM ? ((R & ~31) + perm32(R & 31)) : R;
        voffA[i] = (unsigned)(R * g.lda + C) * 2u; voffB[i] = (unsigned)(Rb * g.ldb + C) * 2u; }
    constexpr unsigned kstep = BK * 2;
    const unsigned hstepA = (unsigned)HALF * g.lda * 2, hstepB = (unsigned)HALF * g.ldb * 2;
    const unsigned tstepA = 2 * hstepA, tstepB = 2 * hstepB;
    const unsigned ldsw = (unsigned)wid * 1024u;
    const int aoff = lds_byte(wr * 64 + fr, fq * 8), boff = lds_byte(wc * 32 + fr, fq * 8);
#define PG8_SA(b, h) (((b) * 2 + (h)) * HTB)
#define PG8_SB(b, h) ((4 + (b) * 2 + (h)) * HTB)
#define PG8_STAGE(bufoff, gbase, voff) do { _Pragma("unroll") for (int _i = 0; _i < 2; ++_i) \
        __builtin_amdgcn_global_load_lds((const unsigned*)((const char*)(gbase) + (voff)[_i]), (LAS unsigned*)(lds + (bufoff) + ldsw + _i * 8192), 16, 0, 0); } while (0)
#define PG8_LDA(dst, b, h) do { _Pragma("unroll") for (int m = 0; m < 4; ++m) _Pragma("unroll") for (int k = 0; k < 2; ++k) dst[m][k] = *(const LAS bf16x8*)(lds + PG8_SA(b, h) + aoff + m * 2048 + k * 1024); } while (0)
#define PG8_LDB(dst, b, h) do { _Pragma("unroll") for (int n = 0; n < 2; ++n) _Pragma("unroll") for (int k = 0; k < 2; ++k) dst[n][k] = *(const LAS bf16x8*)(lds + PG8_SB(b, h) + boff + n * 2048 + k * 1024); } while (0)
#define PG8_MMA(ai, bj, At, Bt) do { __builtin_amdgcn_s_setprio(1); _Pragma("unroll") for (int m = 0; m < 4; ++m) _Pragma("unroll") for (int n = 0; n < 2; ++n) _Pragma("unroll") for (int k = 0; k < 2; ++k) \
        acc[ai][bj][m][n] = __builtin_amdgcn_mfma_f32_16x16x32_bf16(Bt[n][k], At[m][k], acc[ai][bj][m][n], 0, 0, 0); __builtin_amdgcn_s_setprio(0); } while (0)
#define PG8_WAIT_V(n) asm volatile("s_waitcnt vmcnt(" #n ")" ::: "memory")
#define PG8_WAIT_L(n) asm volatile("s_waitcnt lgkmcnt(" #n ")" ::: "memory")
#define PG8_BAR __builtin_amdgcn_s_barrier()
#define PG8_SCHED __builtin_amdgcn_sched_barrier(0)
    Unit cur, nxt; int ui = 0;
    if (!S.next(0, cur)) return;
    f32x4 acc[2][2][4][2];
#pragma unroll
    for (int a = 0; a < 2; ++a)
#pragma unroll
        for (int b = 0; b < 2; ++b)
#pragma unroll
            for (int m = 0; m < 4; ++m)
#pragma unroll
                for (int n = 0; n < 2; ++n) acc[a][b][m][n] = (f32x4){0.f, 0.f, 0.f, 0.f};
    bf16x8 At[4][2], B0[2][2], B1[2][2];
    const char* cA = (const char*)g.A + (size_t)((unsigned)cur.pm * tstepA + (unsigned)cur.z * g.zA); const char* cB = (const char*)g.Bt + (size_t)((unsigned)cur.pn * tstepB + (unsigned)cur.z * g.zB);
    PG8_STAGE(PG8_SB(0, 0), cB, voffB); PG8_STAGE(PG8_SB(0, 1), cB + hstepB, voffB); PG8_STAGE(PG8_SA(0, 0), cA, voffA); PG8_STAGE(PG8_SA(0, 1), cA + hstepA, voffA);
    if (wr == 1) PG8_BAR;
    PG8_WAIT_V(2); PG8_BAR;
    PG8_STAGE(PG8_SB(1, 0), cB + kstep, voffB); PG8_STAGE(PG8_SA(1, 0), cA + kstep, voffA); PG8_STAGE(PG8_SB(1, 1), cB + hstepB + kstep, voffB);
    PG8_WAIT_V(6); PG8_BAR;
    for (;;) {
        const bool has_next = S.next(ui + 1, nxt);
        const char* nA = has_next ? (const char*)g.A + (size_t)((unsigned)nxt.pm * tstepA + (unsigned)nxt.z * g.zA) : cA;
        const char* nB = has_next ? (const char*)g.Bt + (size_t)((unsigned)nxt.pn * tstepB + (unsigned)nxt.z * g.zB) : cB;
        for (int t = 0; t < nt; t += 2) {
            const bool last = (t == nt - 2);
            const char* a1 = cA + (unsigned)(t + 1) * kstep;
            const char* a2 = last ? nA : cA + (unsigned)(t + 2) * kstep; const char* b2 = last ? nB : cB + (unsigned)(t + 2) * kstep;
            const char* a3 = a2 + kstep; const char* b3 = b2 + kstep;
            PG8_LDB(B0, 0, 0); PG8_LDB(B1, 0, 1); PG8_SCHED; PG8_LDA(At, 0, 0); PG8_STAGE(PG8_SA(1, 1), a1 + hstepA, voffA);
            PG8_WAIT_V(8); PG8_WAIT_L(0); PG8_BAR; PG8_MMA(0, 0, At, B0); PG8_MMA(0, 1, At, B1); PG8_BAR; PG8_SCHED;
            PG8_LDA(At, 0, 1); PG8_STAGE(PG8_SB(0, 0), b2, voffB); PG8_STAGE(PG8_SB(0, 1), b2 + hstepB, voffB); PG8_STAGE(PG8_SA(0, 0), a2, voffA);
            PG8_WAIT_V(8); PG8_WAIT_L(0); PG8_BAR; PG8_MMA(1, 0, At, B0); PG8_MMA(1, 1, At, B1); PG8_BAR; PG8_SCHED;
            PG8_LDB(B0, 1, 0); PG8_LDB(B1, 1, 1); PG8_SCHED; PG8_LDA(At, 1, 0); PG8_STAGE(PG8_SA(0, 1), a2 + hstepA, voffA);
            PG8_WAIT_V(8); PG8_WAIT_L(0); PG8_BAR; PG8_MMA(0, 0, At, B0); PG8_MMA(0, 1, At, B1); PG8_BAR; PG8_SCHED;
            PG8_LDA(At, 1, 1); PG8_STAGE(PG8_SB(1, 0), b3, voffB); PG8_STAGE(PG8_SB(1, 1), b3 + hstepB, voffB); PG8_STAGE(PG8_SA(1, 0), a3, voffA);
            PG8_WAIT_V(8); PG8_WAIT_L(0); PG8_BAR; PG8_MMA(1, 0, At, B0); PG8_MMA(1, 1, At, B1); PG8_BAR; PG8_SCHED;
        }
        if (wr == 0) PG8_BAR;
        E(acc, cur, wr, wc, fr, fq);
        if (!has_next) break;
#pragma unroll
        for (int a = 0; a < 2; ++a)
#pragma unroll
            for (int b = 0; b < 2; ++b)
#pragma unroll
                for (int m = 0; m < 4; ++m)
#pragma unroll
                    for (int n = 0; n < 2; ++n) acc[a][b][m][n] = (f32x4){0.f, 0.f, 0.f, 0.f};
        cur = nxt; cA = nA; cB = nB; ++ui;
        if (wr == 1) PG8_BAR;
    }
    PG8_WAIT_V(0);
    PG8_BAR;
#undef PG8_SA
#undef PG8_SB
#undef PG8_STAGE
#undef PG8_LDA
#undef PG8_LDB
#undef PG8_MMA
#undef PG8_WAIT_V
#undef PG8_WAIT_L
#undef PG8_BAR
#undef PG8_SCHED
}
}


#define XB_TMO      128
#define XB_XCNT(j)  (256  + 64 * (j))
#define XB_XSUB(j)  (1280 + 64 * (j))
#define XB_XGEN(j)  (2304 + 64 * (j))
#define XB_TOP      3328
#define XB_TOPGEN   3392
#define XCD_BAR_WORDS 3456
#define XB_SPIN_CAP (1u << 22)
__device__ __forceinline__ unsigned xb_ld(unsigned* p)              { return __hip_atomic_load(p, __ATOMIC_RELAXED, __HIP_MEMORY_SCOPE_AGENT); }
__device__ __forceinline__ unsigned xb_add(unsigned* p, unsigned v) { return __hip_atomic_fetch_add(p, v, __ATOMIC_RELAXED, __HIP_MEMORY_SCOPE_AGENT); }
__device__ __forceinline__ unsigned xb_xcc_id() { return (unsigned)__builtin_amdgcn_s_getreg((3 << 11) | 20) & 0xFu; }
#define XB_SPIN(cond, bar) do { unsigned _sp = 0; while (cond) { __builtin_amdgcn_s_sleep(1); \
    if ((++_sp & 255u) == 0u) { if (xb_ld(&(bar)[XB_TMO])) break; if (_sp > XB_SPIN_CAP) { atomicAdd(&(bar)[XB_TMO], 1u); break; } } } } while (0)
struct XcdBarrier { unsigned* bar; unsigned x; volatile LAS unsigned* st; };
__device__ __forceinline__ XcdBarrier xcd_barrier_post(unsigned* bar, volatile LAS unsigned* st) {
    XcdBarrier b; b.bar = bar; b.x = xb_xcc_id(); b.st = st;
    if (threadIdx.x == 0) (void)xb_add(&bar[XB_XCNT(b.x)], 1u);
    return b;
}
__device__ __forceinline__ void xcd_barrier_complete(unsigned* bar, unsigned x, unsigned& nloc, unsigned& nx) {
    const unsigned G = gridDim.x * gridDim.y * gridDim.z;
    unsigned sum, cnt, mine, sp = 0u;
    for (;;) {
        sum = 0u; cnt = 0u; mine = 0u;
#pragma unroll 1
        for (unsigned j = 0; j < 16; ++j) { const unsigned c = xb_ld(&bar[XB_XCNT(j)]); sum += c; cnt += (c > 0u) ? 1u : 0u; mine = (j == x) ? c : mine; }
        if (sum == G) break;
        __builtin_amdgcn_s_sleep(1);
        if ((++sp & 255u) == 0u) { if (xb_ld(&bar[XB_TMO])) break; if (sp > XB_SPIN_CAP) { atomicAdd(&bar[XB_TMO], 1u); break; } }
    }
    nloc = mine > 0u ? mine : 1u; nx = cnt > 0u ? cnt : 1u;
}
__device__ __forceinline__ void xcd_barrier(const XcdBarrier& b) {
    asm volatile("s_waitcnt vmcnt(0)" ::: "memory");
    __syncthreads();
    if (threadIdx.x == 0) {
        unsigned* bar = b.bar; asm volatile("" : "+s"(bar));
        __builtin_amdgcn_s_waitcnt(0);
        unsigned nloc = b.st[0], nx = b.st[1];
        if (nloc == 0u) { xcd_barrier_complete(bar, b.x, nloc, nx); b.st[0] = nloc; b.st[1] = nx; }
        const unsigned old = xb_add(&bar[XB_XSUB(b.x)], 1u);
        const unsigned gen = old / nloc;
        if (old + 1u == (gen + 1u) * nloc) {
            __builtin_amdgcn_fence(__ATOMIC_RELEASE, "agent");
            asm volatile("s_waitcnt vmcnt(0)" ::: "memory");
            const unsigned og = xb_add(&bar[XB_TOP], 1u);
            const unsigned tg = og / nx;
            if (og + 1u == (tg + 1u) * nx) xb_add(&bar[XB_TOPGEN], 1u);
            else XB_SPIN(xb_ld(&bar[XB_TOPGEN]) == tg, bar);
            __builtin_amdgcn_fence(__ATOMIC_ACQUIRE, "agent");
            xb_add(&bar[XB_XGEN(b.x)], 1u);
            asm volatile("s_waitcnt vmcnt(0)" ::: "memory");
        } else {
            XB_SPIN(xb_ld(&bar[XB_XGEN(b.x)]) == gen, bar);
            __builtin_amdgcn_fence(__ATOMIC_ACQUIRE, "agent");
            asm volatile("s_waitcnt vmcnt(0)" ::: "memory");
        }
    }
    __syncthreads();
}

struct Params { const float* in[20]; float* out; unsigned char* ws; int ph_lo, ph_hi, use_cg, pad; };
enum { I_XP = 0, I_XS, I_SPOOL, I_SCONV, I_CK, I_CV, I_MEM, I_NPRE, I_NPOST, I_MNORM, I_WKV, I_WIN, I_POOLW, I_PSCALE, I_CONVW, I_CONVB, I_LNG, I_LNB, I_WBR, I_WOUT };

__device__ __forceinline__ void transpose_item(const float* W, int K, int N, bf16_t* WT, LAS float* scr, int item, int lane) {
    const int nblk = N / 32, kb = item / nblk, nb = item % nblk, k0 = 64 * kb, n0 = 32 * nb;
    const int kk = lane >> 3, n4 = (lane & 7) * 4;
    f32x4 v[8];
#pragma unroll
    for (int i = 0; i < 8; ++i) v[i] = *(const f32x4*)(W + (size_t)(k0 + kk + 8 * i) * N + n0 + n4);
#pragma unroll
    for (int i = 0; i < 8; ++i) { LAS float* d = scr + (kk + 8 * i) * 33 + n4; d[0] = v[i].x; d[1] = v[i].y; d[2] = v[i].z; d[3] = v[i].w; }
    LDS_WAIT();
    const int c = lane & 7;
#pragma unroll
    for (int j = 0; j < 4; ++j) { const int n = (lane >> 3) + 8 * j; const LAS float* s = scr + (8 * c) * 33 + n;
        u32x4 o; o.x = pk2(s[0 * 33], s[1 * 33]); o.y = pk2(s[2 * 33], s[3 * 33]); o.z = pk2(s[4 * 33], s[5 * 33]); o.w = pk2(s[6 * 33], s[7 * 33]);
        *(u32x4*)(WT + (size_t)(n0 + n) * K + k0 + 8 * c) = o; }
    LDS_WAIT();
}

__device__ __forceinline__ void p0_prologue(const Params& p, LAS unsigned char* lds, int gw, int NGW, int wave, int lane) {
    LAS float* scr = (LAS float*)(lds + wave * 8704);
    unsigned char* ws = p.ws;
    constexpr int I_IN = (D / 64) * (NCOL / 32), I_SQ = (D / 64) * (D / 32), I_BR = (512 / 64) * (D / 32), I_PL = 2 * 4;
    constexpr int NITEMS = 2 * I_IN + 2 * I_SQ + 6 * I_BR + 2 * I_SQ + 8 * I_PL;
    for (int it = gw; it < NITEMS; it += NGW) {
        int r = it;
        if (r < 2 * I_IN) { const int l = r / I_IN; transpose_item(p.in[I_WIN] + (size_t)l * D * NCOL, D, NCOL, (bf16_t*)(ws + WS_WIN) + (size_t)l * NCOL * D, scr, r % I_IN, lane); continue; } r -= 2 * I_IN;
        if (r < 2 * I_SQ) { const int l = r / I_SQ; transpose_item(p.in[I_WKV] + (size_t)l * D * D, D, D, (bf16_t*)(ws + WS_WKV) + (size_t)l * D * D, scr, r % I_SQ, lane); continue; } r -= 2 * I_SQ;
        if (r < 6 * I_BR) { const int l = r / I_BR; transpose_item(p.in[I_WBR] + (size_t)l * 512 * D, 512, D, (bf16_t*)(ws + WS_WBR) + (size_t)l * D * 512, scr, r % I_BR, lane); continue; } r -= 6 * I_BR;
        if (r < 2 * I_SQ) { const int l = r / I_SQ; transpose_item(p.in[I_WOUT] + (size_t)l * D * D, D, D, (bf16_t*)(ws + WS_WOUT) + (size_t)l * D * D, scr, r % I_SQ, lane); continue; } r -= 2 * I_SQ;
        { const int l = r / I_PL; transpose_item(p.in[I_POOLW] + (size_t)l * 128 * 128, 128, 128, (bf16_t*)(ws + WS_WPOOL) + (size_t)l * 128 * 128, scr, r % I_PL, lane); }
    }
    const float* g0 = p.in[I_NPRE];
    for (int m0 = gw; m0 < MT; m0 += 2 * NGW) {
        f32x4 v[2][4]; float s[2];
#pragma unroll
        for (int r = 0; r < 2; ++r) { const int mm = m0 + r * NGW, m = mm < MT ? mm : MT - 1;
            const float* xrow = (m < MP) ? p.in[I_XP] + (size_t)m * D : p.in[I_XS] + (size_t)(m - MP) * D; const f32x4* xr = (const f32x4*)xrow + lane;
#pragma unroll
            for (int j = 0; j < 4; ++j) v[r][j] = xr[64 * j]; }
#pragma unroll
        for (int r = 0; r < 2; ++r) { float t = 0.f;
#pragma unroll
            for (int j = 0; j < 4; ++j) t += (v[r][j].x * v[r][j].x + v[r][j].y * v[r][j].y) + (v[r][j].z * v[r][j].z + v[r][j].w * v[r][j].w);
            s[r] = 1.0f / sqrtf(wave_sum(t) * (1.f / D) + EPS); }
#pragma unroll
        for (int r = 0; r < 2; ++r) { const int mm = m0 + r * NGW; if (mm < MT) { u32x2* o = (u32x2*)((bf16_t*)(ws + WS_H) + (size_t)mm * D) + lane; const float rs = s[r];
#pragma unroll
            for (int j = 0; j < 4; ++j) { const f32x4 g = ((const f32x4*)g0)[lane + 64 * j]; u32x2 w; w.x = pk2(v[r][j].x * rs * g.x, v[r][j].y * rs * g.y); w.y = pk2(v[r][j].z * rs * g.z, v[r][j].w * rs * g.w); o[64 * j] = w; } } }
    }
    for (int m = gw; m < 2048; m += NGW) {
        const f32x4* xr = (const f32x4*)(p.in[I_MEM] + (size_t)m * D) + lane; f32x4 v[4]; float s = 0.f;
#pragma unroll
        for (int j = 0; j < 4; ++j) { v[j] = xr[64 * j]; s += (v[j].x * v[j].x + v[j].y * v[j].y) + (v[j].z * v[j].z + v[j].w * v[j].w); }
        const float rs = 1.0f / sqrtf(wave_sum(s) * (1.f / D) + EPS);
#pragma unroll
        for (int l = 0; l < 2; ++l) { u32x2* o = (u32x2*)((bf16_t*)(ws + WS_MEMN) + ((size_t)l * 2048 + m) * D) + lane;
#pragma unroll
            for (int j = 0; j < 4; ++j) { const f32x4 g = ((const f32x4*)(p.in[I_MNORM] + l * D))[lane + 64 * j]; u32x2 w; w.x = pk2(v[j].x * rs * g.x, v[j].y * rs * g.y); w.y = pk2(v[j].z * rs * g.z, v[j].w * rs * g.w); o[64 * j] = w; } }
    }
}

__device__ __forceinline__ void p5_residual(const Params& p, int layer, int gw, int NGW, int lane) {
    unsigned char* ws = p.ws;
    const bf16_t* Y = (const bf16_t*)(ws + WS_Y); const float* ssq = (const float*)(ws + WS_SSQ);
    const f32x4* gp = (const f32x4*)(p.in[I_NPOST] + layer * D); const f32x4* gn = (const f32x4*)(p.in[I_NPRE] + D);
    for (int m0 = gw; m0 < MT; m0 += 2 * NGW) {
        f32x4 x[2][4]; u32x2 y[2][4]; float sp[2];
#pragma unroll
        for (int r = 0; r < 2; ++r) { const int mm = m0 + r * NGW, m = mm < MT ? mm : MT - 1;
            const float* xrow = (layer == 0) ? ((m < MP) ? p.in[I_XP] + (size_t)m * D : p.in[I_XS] + (size_t)(m - MP) * D) : p.out + (size_t)m * D;
            sp[r] = (lane < 16) ? ssq[(size_t)m * 16 + lane] : 0.f;
            const f32x4* xr = (const f32x4*)xrow + lane; const u32x2* yr = (const u32x2*)(Y + (size_t)m * D) + lane;
#pragma unroll
            for (int j = 0; j < 4; ++j) { x[r][j] = xr[64 * j]; y[r][j] = yr[64 * j]; } }
#pragma unroll
        for (int r = 0; r < 2; ++r) { const int mm = m0 + r * NGW;
            const float rs = 1.0f / sqrtf(wave_sum(sp[r]) * (1.f / D) + EPS); float s = 0.f;
#pragma unroll
            for (int j = 0; j < 4; ++j) { const f32x4 g = gp[lane + 64 * j]; f32x4& v = x[r][j]; const u32x2 yy = y[r][j];
                v.x += bflo(yy.x) * rs * g.x; v.y += bfhi(yy.x) * rs * g.y; v.z += bflo(yy.y) * rs * g.z; v.w += bfhi(yy.y) * rs * g.w;
                s += (v.x * v.x + v.y * v.y) + (v.z * v.z + v.w * v.w); }
            if (mm < MT) {
                f32x4* orow = (f32x4*)(p.out + (size_t)mm * D) + lane;
#pragma unroll
                for (int j = 0; j < 4; ++j) orow[64 * j] = x[r][j];
            }
            if (layer == 0) {
                const float r2 = 1.0f / sqrtf(wave_sum(s) * (1.f / D) + EPS);
                if (mm < MT) { u32x2* o = (u32x2*)((bf16_t*)(ws + WS_H) + (size_t)mm * D) + lane;
#pragma unroll
                    for (int j = 0; j < 4; ++j) { const f32x4 g = gn[lane + 64 * j]; const f32x4 v = x[r][j]; u32x2 w; w.x = pk2(v.x * r2 * g.x, v.y * r2 * g.y); w.y = pk2(v.z * r2 * g.z, v.w * r2 * g.w); o[64 * j] = w; } }
            }
        }
    }
}

template <int T, bool SAMPLE>
__device__ __forceinline__ void pool_task(const Params& p, int layer, LAS unsigned char* lds, int task, int tid, int wave, int lane) {
    constexpr int R = T + 15, NRB = (T + 15) / 16;
    unsigned char* ws = p.ws;
    const bf16_t* proj = (const bf16_t*)(ws + WS_PROJ); bf16_t* br = (bf16_t*)(ws + WS_BR);
    LAS unsigned* PE = (LAS unsigned*)lds;
    LAS unsigned* MX = (LAS unsigned*)(lds + R * 1024);
    int b = 0, t0 = 0, seq = 0, rowbase;
    if (SAMPLE) { seq = task; rowbase = MP + seq * 8; } else { b = task >> 6; t0 = (task & 63) * T; rowbase = b * SEQ + t0; }
    const int g_ = wave >> 1, ch_ = wave & 1, h4_ = lane >> 4, c_ = lane & 15;
    f32x4 scl[4]; u32x2 gtp[NRB][4];
    {
#pragma unroll
      for (int cb = 0; cb < 4; ++cb) scl[cb] = *(const f32x4*)(p.in[I_PSCALE] + layer * 512 + 128 * g_ + 64 * ch_ + 16 * cb + 4 * h4_);
#pragma unroll
      for (int rb = 0; rb < NRB; ++rb) { const int tr = 16 * rb + c_;
#pragma unroll
        for (int cb = 0; cb < 4; ++cb) gtp[rb][cb] = *(const u32x2*)(proj + (size_t)(rowbase + (tr < T ? tr : 0)) * NCOL + C_PGATE + 128 * g_ + 64 * ch_ + 16 * cb + 4 * h4_); } }
    __syncthreads();
    if (SAMPLE) {
        f32x4 sa[2], sb[2]; u32x4 pw;
#pragma unroll
        for (int i = 0; i < 2; ++i) { const int idx = tid + NTHREADS * i, row = idx < 960 ? (idx >> 6) : 0, c8 = idx & 63;
            const float* src = p.in[I_SPOOL] + (((size_t)layer * NSEQ + seq) * 15 + row) * 512 + 8 * c8; sa[i] = *(const f32x4*)src; sb[i] = *(const f32x4*)(src + 4); }
        { const int row = tid >> 6, c8 = tid & 63; pw = *(const u32x4*)(proj + (size_t)(rowbase + row) * NCOL + 8 * c8); }
#pragma unroll
        for (int i = 0; i < 2; ++i) { const int idx = tid + NTHREADS * i, row = idx >> 6, c8 = idx & 63;
            if (idx < 960) { u32x4 w; w.x = pk2(sa[i].x, sa[i].y); w.y = pk2(sa[i].z, sa[i].w); w.z = pk2(sb[i].x, sb[i].y); w.w = pk2(sb[i].z, sb[i].w);
                *(LAS u32x4*)(PE + row * 256 + 4 * c8) = w;
                if (row >= 8) { float* o = p.out + O_POOLS + (((size_t)layer * NSEQ + seq) * 15 + (row - 8)) * 512 + 8 * c8; *(f32x4*)o = sa[i]; *(f32x4*)(o + 4) = sb[i]; } } }
        { const int row = 15 + (tid >> 6), c8 = tid & 63; *(LAS u32x4*)(PE + row * 256 + 4 * c8) = pw;
            float* o = p.out + O_POOLS + (((size_t)layer * NSEQ + seq) * 15 + (row - 8)) * 512 + 8 * c8;
            *(f32x4*)o = (f32x4){bflo(pw.x), bfhi(pw.x), bflo(pw.y), bfhi(pw.y)}; *(f32x4*)(o + 4) = (f32x4){bflo(pw.z), bfhi(pw.z), bflo(pw.w), bfhi(pw.w)}; }
    } else {
        constexpr int NCH = R * 64, NIT = (NCH + NTHREADS - 1) / NTHREADS;
        u32x4 pw[NIT];
#pragma unroll
        for (int i = 0; i < NIT; ++i) { const int idx = tid + NTHREADS * i, row = idx >> 6, c8 = idx & 63; int grow = t0 - 15 + row; if (grow < 0 || idx >= NCH) grow = 0;
            pw[i] = *(const u32x4*)(proj + (size_t)(b * SEQ + grow) * NCOL + 8 * c8); }
#pragma unroll
        for (int i = 0; i < NIT; ++i) { const int idx = tid + NTHREADS * i, row = idx >> 6, c8 = idx & 63; const int grow = t0 - 15 + row;
            if (idx < NCH) { u32x4 w = pw[i]; if (grow < 0) w = (u32x4){0u, 0u, 0u, 0u};
                *(LAS u32x4*)(PE + row * 256 + 4 * c8) = w;
                if (grow >= SEQ - 15) { float* o = p.out + O_POOLP + (((size_t)layer * 8 + b) * 15 + (grow - (SEQ - 15))) * 512 + 8 * c8;
                    *(f32x4*)o = (f32x4){bflo(w.x), bfhi(w.x), bflo(w.y), bfhi(w.y)}; *(f32x4*)(o + 4) = (f32x4){bflo(w.z), bfhi(w.z), bflo(w.w), bfhi(w.w)}; } } }
    }
    __syncthreads();
    for (int idx = tid; idx < T * 256; idx += NTHREADS) {
        const int t = idx >> 8, cp = idx & 255, g = cp >> 6, win = 2 << g;
        float s0 = 0.f, s1 = 0.f;
        for (int j = 0; j < win; ++j) { const unsigned w = PE[(15 + t - j) * 256 + cp]; s0 += bflo(w); s1 += bfhi(w); }
        const unsigned cur = PE[(15 + t) * 256 + cp];
        float cnt = (float)win; if (!SAMPLE) { const int pp = t0 + t + 1; cnt = (float)(pp < win ? pp : win); }
        const float inv = 1.0f / cnt;
        MX[t * 260 + cp] = pk2(s0 * inv - bflo(cur), s1 * inv - bfhi(cur));
    }
    __syncthreads();
    {
        const int g = g_, ch = ch_, h4 = h4_, c = c_;
        const bf16_t* wt = (const bf16_t*)(ws + WS_WPOOL) + ((size_t)(layer * 4 + g) * 128 + 64 * ch) * 128;
        bf16x8 wf[4][4];
#pragma unroll
        for (int ks = 0; ks < 4; ++ks)
#pragma unroll
            for (int cb = 0; cb < 4; ++cb) wf[ks][cb] = *(const bf16x8*)(wt + (size_t)(16 * cb + c) * 128 + 32 * ks + 8 * h4);
        f32x4 acc[NRB][4];
#pragma unroll
        for (int rb = 0; rb < NRB; ++rb)
#pragma unroll
            for (int cb = 0; cb < 4; ++cb) acc[rb][cb] = (f32x4){0.f, 0.f, 0.f, 0.f};
#pragma unroll
        for (int ks = 0; ks < 4; ++ks) {
            bf16x8 bf[NRB];
#pragma unroll
            for (int rb = 0; rb < NRB; ++rb) bf[rb] = *(const LAS bf16x8*)((LAS unsigned char*)MX + (16 * rb + c) * 1040 + (128 * g + 32 * ks + 8 * h4) * 2);
#pragma unroll
            for (int cb = 0; cb < 4; ++cb)
#pragma unroll
                for (int rb = 0; rb < NRB; ++rb) acc[rb][cb] = __builtin_amdgcn_mfma_f32_16x16x32_bf16(wf[ks][cb], bf[rb], acc[rb][cb], 0, 0, 0);
        }
#pragma unroll
        for (int rb = 0; rb < NRB; ++rb) { const int tr = 16 * rb + c; if (tr < T) { const size_t row = (size_t)rowbase + tr;
#pragma unroll
                for (int cb = 0; cb < 4; ++cb) { const int col = 128 * g + 64 * ch + 16 * cb + 4 * h4;
                    const f32x4 sc = scl[cb]; const u32x2 gt = gtp[rb][cb]; const f32x4 a = acc[rb][cb];
                    u32x2 w; w.x = pk2(a[0] * sc.x * siluf_(bflo(gt.x)), a[1] * sc.y * siluf_(bfhi(gt.x))); w.y = pk2(a[2] * sc.z * siluf_(bflo(gt.y)), a[3] * sc.w * siluf_(bfhi(gt.y)));
                    *(u32x2*)(br + row * BR_LD + col) = w; } } }
    }
}

template <int T, bool SAMPLE>
__device__ __forceinline__ void conv_task(const Params& p, int layer, LAS unsigned char* lds, int task, int tid, int wave, int lane) {
    constexpr int R = T + 30, TT = T / 2;
    unsigned char* ws = p.ws;
    const bf16_t* proj = (const bf16_t*)(ws + WS_PROJ); bf16_t* br = (bf16_t*)(ws + WS_BR);
    LAS unsigned* U = (LAS unsigned*)lds;
    LAS float* CO = (LAS float*)(lds + R * 1024);
    int b = 0, t0 = 0, seq = 0, rowbase;
    if (SAMPLE) { seq = task; rowbase = MP + seq * 8; } else { b = task >> 6; t0 = (task & 63) * T; rowbase = b * SEQ + t0; }
    const int cp = tid & 255, half = tid >> 8;
    constexpr int NTK = (T + 7) / 8;
    u32x4 gts[NTK];
#pragma unroll
    for (int i = 0; i < NTK; ++i) { const int t = wave + 8 * i; gts[i] = *(const u32x4*)(proj + (size_t)(rowbase + (t < T ? t : 0)) * NCOL + C_CGATE + 8 * lane); }
    __syncthreads();
#define GLU8(cv, cg_, ua, ub) do { \
        ua = (f32x4){bflo(cv.x) * sigmoidf_(bflo(cg_.x)), bfhi(cv.x) * sigmoidf_(bfhi(cg_.x)), bflo(cv.y) * sigmoidf_(bflo(cg_.y)), bfhi(cv.y) * sigmoidf_(bfhi(cg_.y))}; \
        ub = (f32x4){bflo(cv.z) * sigmoidf_(bflo(cg_.z)), bfhi(cv.z) * sigmoidf_(bfhi(cg_.z)), bflo(cv.w) * sigmoidf_(bflo(cg_.w)), bfhi(cv.w) * sigmoidf_(bfhi(cg_.w))}; } while (0)
    if (SAMPLE) {
        f32x4 sa[4], sb[4]; u32x4 cv, cg_;
#pragma unroll
        for (int i = 0; i < 4; ++i) { const int idx = tid + NTHREADS * i, row = idx < 1920 ? (idx >> 6) : 0, c8 = idx & 63;
            const float* src = p.in[I_SCONV] + (((size_t)layer * NSEQ + seq) * 30 + row) * 512 + 8 * c8; sa[i] = *(const f32x4*)src; sb[i] = *(const f32x4*)(src + 4); }
        { const int row = tid >> 6, c8 = tid & 63; const bf16_t* src = proj + (size_t)(rowbase + row) * NCOL + 8 * c8; cv = *(const u32x4*)(src + C_CVAL); cg_ = *(const u32x4*)(src + C_CGLU); }
#pragma unroll
        for (int i = 0; i < 4; ++i) { const int idx = tid + NTHREADS * i, row = idx >> 6, c8 = idx & 63;
            if (idx < 1920) { u32x4 w; w.x = pk2(sa[i].x, sa[i].y); w.y = pk2(sa[i].z, sa[i].w); w.z = pk2(sb[i].x, sb[i].y); w.w = pk2(sb[i].z, sb[i].w);
                *(LAS u32x4*)(U + row * 256 + 4 * c8) = w;
                if (row >= 8) { float* o = p.out + O_CONVS + (((size_t)layer * NSEQ + seq) * 30 + (row - 8)) * 512 + 8 * c8; *(f32x4*)o = sa[i]; *(f32x4*)(o + 4) = sb[i]; } } }
        { const int row = 30 + (tid >> 6), c8 = tid & 63; f32x4 ua, ub; GLU8(cv, cg_, ua, ub);
            u32x4 w; w.x = pk2(ua.x, ua.y); w.y = pk2(ua.z, ua.w); w.z = pk2(ub.x, ub.y); w.w = pk2(ub.z, ub.w);
            *(LAS u32x4*)(U + row * 256 + 4 * c8) = w;
            float* o = p.out + O_CONVS + (((size_t)layer * NSEQ + seq) * 30 + (row - 8)) * 512 + 8 * c8; *(f32x4*)o = ua; *(f32x4*)(o + 4) = ub; }
    } else {
        constexpr int NCH = R * 64, NIT = (NCH + NTHREADS - 1) / NTHREADS;
        u32x4 cv[NIT], cg_[NIT];
#pragma unroll
        for (int i = 0; i < NIT; ++i) { const int idx = tid + NTHREADS * i, row = idx >> 6, c8 = idx & 63; int gs = t0 - 30 + row; if (gs < 0 || idx >= NCH) gs = 0;
            const bf16_t* src = proj + (size_t)(b * SEQ + gs) * NCOL + 8 * c8; cv[i] = *(const u32x4*)(src + C_CVAL); cg_[i] = *(const u32x4*)(src + C_CGLU); }
#pragma unroll
        for (int i = 0; i < NIT; ++i) { const int idx = tid + NTHREADS * i, row = idx >> 6, c8 = idx & 63; const int gs = t0 - 30 + row;
            if (idx < NCH) { f32x4 ua, ub; GLU8(cv[i], cg_[i], ua, ub); if (gs < 0) { ua = (f32x4){0.f, 0.f, 0.f, 0.f}; ub = ua; }
                u32x4 w; w.x = pk2(ua.x, ua.y); w.y = pk2(ua.z, ua.w); w.z = pk2(ub.x, ub.y); w.w = pk2(ub.z, ub.w);
                *(LAS u32x4*)(U + row * 256 + 4 * c8) = w;
                if (gs >= SEQ - 30) { float* o = p.out + O_CONVP + (((size_t)layer * 8 + b) * 30 + (gs - (SEQ - 30))) * 512 + 8 * c8; *(f32x4*)o = ua; *(f32x4*)(o + 4) = ub; } } }
    }
#undef GLU8
    __syncthreads();
    {
        f32x2 wk[31];
        { const f32x2* cw = (const f32x2*)(p.in[I_CONVW] + (size_t)layer * 31 * 512) + cp;
#pragma unroll
          for (int k = 0; k < 31; ++k) wk[k] = cw[k * 256]; }
        const f32x2 bias = *((const f32x2*)(p.in[I_CONVB] + layer * 512) + cp);
        f32x2 acc[TT];
#pragma unroll
        for (int t = 0; t < TT; ++t) acc[t] = bias;
#pragma unroll
        for (int j = 0; j < TT + 30; ++j) {
            const unsigned uu = U[(half * TT + j) * 256 + cp]; const f32x2 uv = (f32x2){bflo(uu), bfhi(uu)};
#pragma unroll
            for (int t = 0; t < TT; ++t) { const int k = j - t; if (k >= 0 && k < 31) acc[t] += wk[k] * uv; }
        }
#pragma unroll
        for (int t = 0; t < TT; ++t) *(LAS f32x2*)(CO + (half * TT + t) * 512 + 2 * cp) = acc[t];
    }
    __syncthreads();
    {
        const float* lg = p.in[I_LNG] + layer * 512 + 8 * lane; const float* lb = p.in[I_LNB] + layer * 512 + 8 * lane;
        const f32x4 g0 = *(const f32x4*)lg, g1 = *(const f32x4*)(lg + 4), b0 = *(const f32x4*)lb, b1 = *(const f32x4*)(lb + 4);
#pragma unroll
        for (int ti = 0; ti < NTK; ++ti) { const int t = wave + 8 * ti; if (t >= T) break;
            const f32x4 x0 = *(const LAS f32x4*)(CO + t * 512 + 8 * lane), x1 = *(const LAS f32x4*)(CO + t * 512 + 8 * lane + 4);
            const float mean = wave_sum((x0.x + x0.y) + (x0.z + x0.w) + (x1.x + x1.y) + (x1.z + x1.w)) * (1.f / 512.f);
            const f32x4 d0 = x0 - mean, d1 = x1 - mean;
            const float var = wave_sum((d0.x * d0.x + d0.y * d0.y) + (d0.z * d0.z + d0.w * d0.w) + (d1.x * d1.x + d1.y * d1.y) + (d1.z * d1.z + d1.w * d1.w)) * (1.f / 512.f);
            const float rstd = 1.0f / sqrtf(var + EPS);
            const f32x4 y0 = d0 * rstd * g0 + b0, y1 = d1 * rstd * g1 + b1;
            const size_t row = (size_t)rowbase + t;
            const u32x4 gt = gts[ti];
            u32x4 w;
            w.x = pk2(siluf_(y0.x) * siluf_(bflo(gt.x)), siluf_(y0.y) * siluf_(bfhi(gt.x))); w.y = pk2(siluf_(y0.z) * siluf_(bflo(gt.y)), siluf_(y0.w) * siluf_(bfhi(gt.y)));
            w.z = pk2(siluf_(y1.x) * siluf_(bflo(gt.z)), siluf_(y1.y) * siluf_(bfhi(gt.z))); w.w = pk2(siluf_(y1.z) * siluf_(bflo(gt.w)), siluf_(y1.w) * siluf_(bfhi(gt.w)));
            *(u32x4*)(br + row * BR_LD + 512 + 8 * lane) = w;
        }
    }
}

constexpr int KS_STRIDE = 272, VT_STRIDE = 528, VT_OFF = 256 * KS_STRIDE;
template <bool SAMPLE>
__device__ __forceinline__ void attn_task(const Params& p, int layer, LAS unsigned char* lds, int task, int tid, int wave, int lane) {
    unsigned char* ws = p.ws;
    const bf16_t* proj = (const bf16_t*)(ws + WS_PROJ); bf16_t* br = (bf16_t*)(ws + WS_BR);
    int b = 0, head, qc = 0, seq = 0;
    if (SAMPLE) { seq = task >> 2; head = task & 3; } else { b = task >> 5; head = (task >> 3) & 3; qc = task & 7; }
    __syncthreads();
    if (SAMPLE) {
        const float* kb = p.in[I_CK] + (((size_t)layer * NSEQ + seq) * 256) * 512 + head * 128; const float* vb = p.in[I_CV] + (((size_t)layer * NSEQ + seq) * 256) * 512 + head * 128;
#pragma unroll
        for (int hf = 0; hf < 2; ++hf) { f32x4 ka[4], kc[4];
#pragma unroll
            for (int i = 0; i < 4; ++i) { const int c = tid + NTHREADS * (4 * hf + i), key = c >> 4, dc = c & 15; const float* src = kb + (size_t)key * 512 + dc * 8; ka[i] = *(const f32x4*)src; kc[i] = *(const f32x4*)(src + 4); }
#pragma unroll
            for (int i = 0; i < 4; ++i) { const int c = tid + NTHREADS * (4 * hf + i), key = c >> 4, dc = c & 15;
                u32x4 w; w.x = pk2(ka[i].x, ka[i].y); w.y = pk2(ka[i].z, ka[i].w); w.z = pk2(kc[i].x, kc[i].y); w.w = pk2(kc[i].z, kc[i].w);
                *(LAS u32x4*)(lds + key * KS_STRIDE + dc * 16) = w; }
            asm volatile("" ::: "memory"); }
        const int d4 = 8 * (wave & 3) + (lane >> 3);
#pragma unroll
        for (int i = 0; i < 2; ++i) { const int ch = (lane & 7) + 8 * (wave >> 2) + 16 * i; const float* src = vb + (size_t)(8 * ch) * 512 + 4 * d4;
            f32x4 v[8];
#pragma unroll
            for (int j = 0; j < 8; ++j) v[j] = *(const f32x4*)(src + (size_t)j * 512);
#pragma unroll
            for (int q = 0; q < 4; ++q) { u32x4 w; w.x = pk2(v[0][q], v[1][q]); w.y = pk2(v[2][q], v[3][q]); w.z = pk2(v[4][q], v[5][q]); w.w = pk2(v[6][q], v[7][q]);
                *(LAS u32x4*)(lds + VT_OFF + (4 * d4 + q) * VT_STRIDE + ch * 16) = w; }
            asm volatile("" ::: "memory"); }
    } else {
        const bf16_t* kb = (const bf16_t*)(ws + WS_KVB) + ((size_t)layer * 2048 + b * 256) * 512 + head * 128;
        const bf16_t* vt = (const bf16_t*)(ws + WS_KVB) + (size_t)2 * 2048 * 512 + ((size_t)layer * 512 + head * 128) * 2048 + b * 256;
        u32x4 kw[8], vw[8];
#pragma unroll
        for (int i = 0; i < 8; ++i) { const int c = tid + NTHREADS * i; kw[i] = *(const u32x4*)(kb + (size_t)(c >> 4) * 512 + (c & 15) * 8); vw[i] = *(const u32x4*)(vt + (size_t)(c >> 5) * 2048 + (c & 31) * 8); }
#pragma unroll
        for (int i = 0; i < 8; ++i) { const int c = tid + NTHREADS * i;
            *(LAS u32x4*)(lds + (c >> 4) * KS_STRIDE + (c & 15) * 16) = kw[i]; *(LAS u32x4*)(lds + VT_OFF + (c >> 5) * VT_STRIDE + (c & 31) * 16) = vw[i]; }
    }
    __syncthreads();
    const int h4 = lane >> 4, c = lane & 15;
    const int ntiles = SAMPLE ? 1 : 16, nvalid = SAMPLE ? 8 : 16;
    for (int wt = wave; wt < ntiles; wt += 8) {
        const int qrow0 = SAMPLE ? (MP + seq * 8) : (b * SEQ + qc * 256 + wt * 16);
        const int cr = c < nvalid ? c : nvalid - 1;
        const bf16_t* qrow = proj + (size_t)(qrow0 + cr) * NCOL + C_Q + head * 128 + 8 * h4;
        bf16x8 qf[4];
#pragma unroll
        for (int ks = 0; ks < 4; ++ks) qf[ks] = *(const bf16x8*)(qrow + 32 * ks);
        u32x2 gt[8];
#pragma unroll
        for (int nd = 0; nd < 8; ++nd) gt[nd] = *(const u32x2*)(proj + (size_t)(qrow0 + cr) * NCOL + C_XGATE + head * 128 + 16 * nd + 4 * h4);
        f32x4 s[16];
#pragma unroll
        for (int nb = 0; nb < 16; ++nb) {
            s[nb] = (f32x4){0.f, 0.f, 0.f, 0.f};
            const int keyrow = 32 * (nb >> 1) + 8 * (c >> 2) + 4 * (nb & 1) + (c & 3);
#pragma unroll
            for (int ks = 0; ks < 4; ++ks) { const bf16x8 kf = *(const LAS bf16x8*)(lds + keyrow * KS_STRIDE + (32 * ks + 8 * h4) * 2);
                s[nb] = __builtin_amdgcn_mfma_f32_16x16x32_bf16(kf, qf[ks], s[nb], 0, 0, 0); }
            if (nb & 1) asm volatile("" ::: "memory");
        }
        float mx = -3.0e38f;
#pragma unroll
        for (int nb = 0; nb < 16; ++nb) mx = fmaxf(fmaxf(fmaxf(s[nb][0], s[nb][1]), fmaxf(s[nb][2], s[nb][3])), mx);
        mx = fmaxf(mx, __shfl_xor(mx, 16)); mx = fmaxf(mx, __shfl_xor(mx, 32));
        const float sc = 0.08838834764831845f * 1.4426950408889634f;
        float sum = 0.f;
#pragma unroll
        for (int nb = 0; nb < 16; ++nb)
#pragma unroll
            for (int i = 0; i < 4; ++i) { const float e = __builtin_amdgcn_exp2f((s[nb][i] - mx) * sc); s[nb][i] = e; sum += e; }
        sum += __shfl_xor(sum, 16); sum += __shfl_xor(sum, 32);
        const float inv = 1.0f / sum;
        bf16x8 pf[8];
#pragma unroll
        for (int si = 0; si < 8; ++si) { u32x4 w; w.x = pk2(s[2 * si][0], s[2 * si][1]); w.y = pk2(s[2 * si][2], s[2 * si][3]); w.z = pk2(s[2 * si + 1][0], s[2 * si + 1][1]); w.w = pk2(s[2 * si + 1][2], s[2 * si + 1][3]);
            pf[si] = __builtin_bit_cast(bf16x8, w); }
#pragma unroll
        for (int nd = 0; nd < 8; ++nd) {
            f32x4 o = (f32x4){0.f, 0.f, 0.f, 0.f};
#pragma unroll
            for (int si = 0; si < 8; ++si) { const bf16x8 vf = *(const LAS bf16x8*)(lds + VT_OFF + (16 * nd + c) * VT_STRIDE + (32 * si + 8 * h4) * 2);
                o = __builtin_amdgcn_mfma_f32_16x16x32_bf16(vf, pf[si], o, 0, 0, 0); }
            if (c < nvalid) { const size_t row = (size_t)qrow0 + c; const int col = head * 128 + 16 * nd + 4 * h4;
                const u32x2 g2 = gt[nd];
                u32x2 w; w.x = pk2(o[0] * inv * siluf_(bflo(g2.x)), o[1] * inv * siluf_(bfhi(g2.x))); w.y = pk2(o[2] * inv * siluf_(bflo(g2.y)), o[3] * inv * siluf_(bfhi(g2.y)));
                *(u32x2*)(br + row * BR_LD + 1024 + col) = w; }
            asm volatile("" ::: "memory");
        }
    }
}


template <int KSTEPS>
__device__ __forceinline__ void small_mma(const bf16_t* A, int lda, const bf16_t* Bt, int ldb, int lane, f32x4 (&acc)[2]) {
    const int h4 = lane >> 4, r = lane & 15;
    const bf16_t* ap = A + (size_t)r * lda + 8 * h4; const bf16_t* b0 = Bt + (size_t)r * ldb + 8 * h4; const bf16_t* b1 = b0 + (size_t)16 * ldb;
#pragma unroll 8
    for (int ks = 0; ks < KSTEPS; ++ks) { const bf16x8 af = *(const bf16x8*)(ap + 32 * ks), w0 = *(const bf16x8*)(b0 + 32 * ks), w1 = *(const bf16x8*)(b1 + 32 * ks);
        acc[0] = __builtin_amdgcn_mfma_f32_16x16x32_bf16(w0, af, acc[0], 0, 0, 0); acc[1] = __builtin_amdgcn_mfma_f32_16x16x32_bf16(w1, af, acc[1], 0, 0, 0); }
}
__device__ __forceinline__ void p3_small(const Params& p, int layer, int task, int wave, int lane) {
    unsigned char* ws = p.ws; const bf16_t* proj = (const bf16_t*)(ws + WS_PROJ);
    const int rt = task >> 4, ct = task & 15, wr = wave >> 1, wc = wave & 1, h4 = lane >> 4, c = lane & 15;
    const int row = MP + 64 * rt + 16 * wr + c, col0 = 64 * ct + 32 * wc + 4 * h4;
    f32x4 mg[2] = {(f32x4){0.f, 0.f, 0.f, 0.f}, (f32x4){0.f, 0.f, 0.f, 0.f}};
#pragma unroll 1
    for (int z = 0; z < 3; ++z) {
        f32x4 acc[2] = {(f32x4){0.f, 0.f, 0.f, 0.f}, (f32x4){0.f, 0.f, 0.f, 0.f}};
        u32x2 lg[2];
#pragma unroll
        for (int n = 0; n < 2; ++n) lg[n] = *(const u32x2*)(proj + (size_t)row * NCOL + C_LOGIT + z * D + col0 + 16 * n);
        small_mma<16>((const bf16_t*)(ws + WS_BR) + (size_t)(MP + 64 * rt + 16 * wr) * BR_LD + z * 512, BR_LD,
                      (const bf16_t*)(ws + WS_WBR) + ((size_t)(layer * 3 + z) * D + 64 * ct + 32 * wc) * 512, 512, lane, acc);
#pragma unroll
        for (int n = 0; n < 2; ++n) { mg[n][0] += acc[n][0] * sigmoidf_(bflo(lg[n].x)); mg[n][1] += acc[n][1] * sigmoidf_(bfhi(lg[n].x)); mg[n][2] += acc[n][2] * sigmoidf_(bflo(lg[n].y)); mg[n][3] += acc[n][3] * sigmoidf_(bfhi(lg[n].y)); }
    }
#pragma unroll
    for (int n = 0; n < 2; ++n) { u32x2 w; w.x = pk2(mg[n][0], mg[n][1]); w.y = pk2(mg[n][2], mg[n][3]); *(u32x2*)((bf16_t*)(ws + WS_MRG) + (size_t)row * D + col0 + 16 * n) = w; }
}
__device__ __forceinline__ void p4_small(const Params& p, int layer, LAS unsigned char* lds, int task, int wave, int lane) {
    unsigned char* ws = p.ws;
    const int rt = task >> 4, ct = task & 15, wr = wave >> 1, wc = wave & 1, h4 = lane >> 4, c = lane & 15;
    const int row = MP + 64 * rt + 16 * wr + c, col0 = 64 * ct + 32 * wc + 4 * h4;
    f32x4 acc[2] = {(f32x4){0.f, 0.f, 0.f, 0.f}, (f32x4){0.f, 0.f, 0.f, 0.f}};
    small_mma<32>((const bf16_t*)(ws + WS_MRG) + (size_t)(MP + 64 * rt + 16 * wr) * D, D, (const bf16_t*)(ws + WS_WOUT) + ((size_t)layer * D + 64 * ct + 32 * wc) * D, D, lane, acc);
    float s = 0.f;
#pragma unroll
    for (int n = 0; n < 2; ++n) { const f32x4 v = acc[n]; s += (v[0] * v[0] + v[1] * v[1]) + (v[2] * v[2] + v[3] * v[3]);
        u32x2 w; w.x = pk2(v[0], v[1]); w.y = pk2(v[2], v[3]); *(u32x2*)((bf16_t*)(ws + WS_Y) + (size_t)row * D + col0 + 16 * n) = w; }
    s += __shfl_xor(s, 16); s += __shfl_xor(s, 32);
    LAS float* red = (LAS float*)lds;
    __syncthreads();
    if (h4 == 0) red[(16 * wr + c) * 2 + wc] = s;
    __syncthreads();
    if (threadIdx.x < 64) ((float*)(ws + WS_SSQ))[(size_t)(MP + 64 * rt + threadIdx.x) * 16 + ct] = red[threadIdx.x * 2] + red[threadIdx.x * 2 + 1];
}

__device__ __forceinline__ void stagger_start(int bx, unsigned ticks) {
    const unsigned long long t0 = __builtin_amdgcn_s_memrealtime(); const unsigned long long w = (unsigned long long)(((unsigned)bx >> 3) & 3u) * ticks;
    while (__builtin_amdgcn_s_memrealtime() - t0 < w) __builtin_amdgcn_s_sleep(16);
}
constexpr unsigned STAG1 = 0, STAG3 = 0;

__global__ void __launch_bounds__(NTHREADS, 2) mk_fwd(Params p) {
    extern __shared__ __attribute__((aligned(16))) unsigned char lds_raw[];
    LAS unsigned char* lds = (LAS unsigned char*)lds_raw;
    cg::grid_group grid = cg::this_grid();
    const int G = gridDim.x, bx = blockIdx.x;
    const int vcu = (G % 8 == 0) ? (bx % 8) * (G / 8) + bx / 8 : bx;
    const int NGW = G * 8;
#define PQ() unsigned long long ka_ = (unsigned long long)__builtin_amdgcn_kernarg_segment_ptr(); asm volatile("" : "+s"(ka_)); \
    const __attribute__((address_space(4))) Params* kp_ = (const __attribute__((address_space(4))) Params*)ka_; Params q; \
    _Pragma("unroll") for (int i_ = 0; i_ < 20; ++i_) q.in[i_] = kp_->in[i_]; q.out = kp_->out; q.ws = kp_->ws; q.ph_lo = 0; q.ph_hi = 0; q.use_cg = 0; q.pad = 0
#define IDS() int tid = threadIdx.x; asm volatile("" : "+v"(tid)); const int lane = tid & 63, wave = __builtin_amdgcn_readfirstlane(tid >> 6), gw = vcu * 8 + wave; (void)gw; (void)lane
    unsigned char* ws = p.ws;
    const int lo = p.ph_lo, hi = p.ph_hi;
#define IN(k) (lo <= (k) && (k) < hi)
    if (threadIdx.x < 4) ((LAS unsigned*)(lds + LDS_BAR_OFF))[threadIdx.x] = 0u;
    __syncthreads();
    XcdBarrier xbar; xbar.bar = (unsigned*)(ws + WS_BAR); xbar.x = 0; xbar.st = (volatile LAS unsigned*)(lds + LDS_BAR_OFF);
    if (hi - lo > 1) xbar = xcd_barrier_post((unsigned*)(ws + WS_BAR), (volatile LAS unsigned*)(lds + LDS_BAR_OFF));
#define SEAM(k) do { if (IN(k) && IN((k) + 1)) { if (p.use_cg) grid.sync(); else xcd_barrier(xbar); } } while (0)

    if (IN(0)) for (int rep = 0; rep < REP0; ++rep) { IDS(); PQ(); p0_prologue(q, lds, gw, NGW, wave, lane); }
    SEAM(0);
#pragma unroll 1
    for (int layer = 0; layer < 2; ++layer) {
        const int pb = 1 + 5 * layer;
        if (IN(pb)) for (int rep = 0; rep < REP1; ++rep) {
            PQ(); unsigned char* const ws = q.ws;
            if (STAG1) stagger_start(bx, STAG1);
            { pg8::Gemm g{(const bf16_t*)(ws + WS_H), (const bf16_t*)(ws + WS_WIN) + (size_t)layer * NCOL * D, D, D, D, 0, 0};
              pg8::Order S; S.init(MT, NCOL, 1, 0, G, bx);
              pg8::EpiStoreBf16 E{(bf16_t*)(ws + WS_PROJ), NCOL};
              pg8::gemm_phase<pg8::EpiStoreBf16>(lds, g, S, E); }
            if (layer == 0) {
              { pg8::Gemm g{(const bf16_t*)(ws + WS_MEMN), (const bf16_t*)(ws + WS_WKV), D, D, D, 2048u * D * 2u, (unsigned)D * D * 2u};
                pg8::Order S; S.init(2048, 512, 2, 0, G, G - 1 - bx);
                pg8::EpiK E{q.out + O_MK, (bf16_t*)(ws + WS_KVB)};
                pg8::gemm_phase<pg8::EpiK>(lds, g, S, E); }
              { pg8::Gemm g{(const bf16_t*)(ws + WS_WKV) + (size_t)512 * D, (const bf16_t*)(ws + WS_MEMN), D, D, D, (unsigned)D * D * 2u, 2048u * D * 2u};
                int cv = G - 33 - bx; if (cv < 0) cv += G;
                pg8::Order S; S.init(512, 2048, 2, 0, G, cv);
                pg8::EpiVt E{q.out + O_MV, (bf16_t*)(ws + WS_KVB) + (size_t)2 * 2048 * 512};
                pg8::gemm_phase<pg8::EpiVt>(lds, g, S, E); }
            }
        }
        SEAM(pb);
        if (IN(pb + 1)) for (int rep = 0; rep < REP2; ++rep) {
            IDS(); PQ();
            for (int r2 = 0; r2 < R2A; ++r2) for (int t = bx; t < 512; t += G) pool_task<32, false>(q, layer, lds, t, tid, wave, lane);
            for (int r2 = 0; r2 < R2B; ++r2) for (int t = bx; t < 512; t += G) conv_task<32, false>(q, layer, lds, t, tid, wave, lane);
            for (int r2 = 0; r2 < R2C; ++r2) for (int t = bx; t < 256; t += G) { if (t < 128) pool_task<8, true>(q, layer, lds, t, tid, wave, lane); else conv_task<8, true>(q, layer, lds, t - 128, tid, wave, lane); }
            for (int r2 = 0; r2 < R2D; ++r2) for (int t = bx; t < 256; t += G) attn_task<false>(q, layer, lds, t, tid, wave, lane);
            for (int r2 = 0; r2 < R2E; ++r2) for (int t = bx; t < 512; t += G) attn_task<true>(q, layer, lds, t, tid, wave, lane);
        }
        SEAM(pb + 1);
        if (IN(pb + 2)) for (int rep = 0; rep < REP3; ++rep) {
            PQ(); unsigned char* const ws = q.ws;
            if (STAG3) stagger_start(bx, STAG3);
            pg8::Gemm g{(const bf16_t*)(ws + WS_BR), (const bf16_t*)(ws + WS_WBR) + (size_t)layer * 3 * D * 512, 512, BR_LD, 512, 512u * 2u, (unsigned)D * 512u * 2u};
            pg8::Order S; S.init(MP, D, 3, 1, G, bx);
            pg8::EpiMerge E{(const bf16_t*)(ws + WS_PROJ), (bf16_t*)(ws + WS_MRG)};
            const bool small_first = ((bx >> 3) & 1) != 0;
            if (small_first) { IDS(); for (int t = bx; t < 256; t += G) p3_small(q, layer, t, wave, lane); }
            pg8::gemm_phase<pg8::EpiMerge>(lds, g, S, E);
            if (!small_first) { IDS(); for (int t = bx; t < 256; t += G) p3_small(q, layer, t, wave, lane); }
        }
        SEAM(pb + 2);
        if (IN(pb + 3)) for (int rep = 0; rep < REP4; ++rep) {
            PQ(); unsigned char* const ws = q.ws;
            pg8::Gemm g{(const bf16_t*)(ws + WS_MRG), (const bf16_t*)(ws + WS_WOUT) + (size_t)layer * D * D, D, D, D, 0, 0};
            pg8::Order S; S.init(MP, D, 1, 0, G, bx);
            pg8::EpiY E{(bf16_t*)(ws + WS_Y), (float*)(ws + WS_SSQ)};
            pg8::gemm_phase<pg8::EpiY>(lds, g, S, E);
            { IDS(); for (int t = bx; t < 256; t += G) p4_small(q, layer, lds, t, wave, lane); }
        }
        SEAM(pb + 3);
        if (IN(pb + 4)) for (int rep = 0; rep < (layer == 0 ? REP5 : 1); ++rep) { IDS(); PQ(); p5_residual(q, layer, gw, NGW, lane); }
        if (layer == 0) SEAM(pb + 4);
    }
#undef IN
#undef SEAM
#undef IDS
#undef PQ
}

extern "C" void kernel_launch(void* const* d_in, const int* in_sizes, int n_in, void* d_out, int out_size, void* d_ws, size_t ws_size, hipStream_t stream) {
    static int grid = 0;
    if (grid == 0) {
        if (n_in != 20 || ws_size < WS_END) { fprintf(stderr, "kernel_launch: expected 20 inputs and >= %zu bytes of workspace (got %d, %zu)\n", (size_t)WS_END, n_in, ws_size); grid = -1; return; }
        int dev = 0, cus = 0, per_cu = 0;
        if (hipGetDevice(&dev) != hipSuccess || hipDeviceGetAttribute(&cus, hipDeviceAttributeMultiprocessorCount, dev) != hipSuccess) { grid = -1; return; }
        if (hipFuncSetAttribute((const void*)mk_fwd, hipFuncAttributeMaxDynamicSharedMemorySize, LDS_BYTES) != hipSuccess) { fprintf(stderr, "kernel_launch: hipFuncSetAttribute failed\n"); grid = -1; return; }
        if (hipOccupancyMaxActiveBlocksPerMultiprocessor(&per_cu, (const void*)mk_fwd, NTHREADS, LDS_BYTES) != hipSuccess || per_cu < 1) { fprintf(stderr, "kernel_launch: occupancy query says %d blocks per CU\n", per_cu); (void)hipGetLastError(); per_cu = 1; }
        grid = cus;
    }
    if (grid < 0) return;
    Params p{};
    for (int i = 0; i < 20; ++i) p.in[i] = (const float*)d_in[i];
    p.out = (float*)d_out; p.ws = (unsigned char*)d_ws;
#if MK_LAUNCHES == 1
    p.ph_lo = 0; p.ph_hi = NPHASES;
    if (hipMemsetAsync((char*)d_ws + WS_BAR, 0, XCD_BAR_WORDS * 4, stream) != hipSuccess) { fprintf(stderr, "kernel_launch: memset of the barrier words failed\n"); return; }
    void* args[] = {&p};
    hipError_t e = hipLaunchCooperativeKernel((const void*)mk_fwd, dim3(grid), dim3(NTHREADS), args, LDS_BYTES, stream);
    if (e != hipSuccess) fprintf(stderr, "cooperative launch failed: %s (grid %d)\n", hipGetErrorString(e), grid);
#else
    for (int k = 0; k < NPHASES; ++k) { p.ph_lo = k; p.ph_hi = k + 1; hipLaunchKernelGGL(mk_fwd, dim3(grid), dim3(NTHREADS), LDS_BYTES, stream, p); }
#endif
}
```

```cpp
#include <hip/hip_runtime.h>
#include <hip/hip_cooperative_groups.h>
#include <cstdio>
#include <cstdint>
namespace cg = cooperative_groups;

#define LAS __attribute__((address_space(3)))
typedef unsigned short bf16_t;
typedef short bf16x8 __attribute__((ext_vector_type(8)));
typedef float f32x4 __attribute__((ext_vector_type(4)));
typedef float f32x2 __attribute__((ext_vector_type(2)));
typedef unsigned u32x4 __attribute__((ext_vector_type(4)));
typedef unsigned u32x2 __attribute__((ext_vector_type(2)));

constexpr int D = 1024, NCOL = 6656, MP = 16384, MS = 1024, MT = MP + MS, SEQ = 2048, NSEQ = 128;
constexpr int C_PGATE = 512, C_CVAL = 1024, C_CGLU = 1536, C_CGATE = 2048, C_Q = 2560, C_XGATE = 3072, C_LOGIT = 3584;
constexpr int BR_LD = 1536;
constexpr float EPS = 1e-6f;
constexpr size_t O_POOLP = 17825792, O_CONVP = 17948672, O_MK = 18194432, O_MV = 20291584, O_POOLS = 22388736, O_CONVS = 24354816;
constexpr size_t WS_WIN = 0;
constexpr size_t WS_WKV = WS_WIN + (size_t)2 * NCOL * D * 2;
constexpr size_t WS_WBR = WS_WKV + (size_t)2 * D * D * 2;
constexpr size_t WS_WOUT = WS_WBR + (size_t)6 * D * 512 * 2;
constexpr size_t WS_WPOOL = WS_WOUT + (size_t)2 * D * D * 2;
constexpr size_t WS_H = WS_WPOOL + (size_t)8 * 128 * 128 * 2;
constexpr size_t WS_MEMN = WS_H + (size_t)MT * D * 2;
constexpr size_t WS_PROJ = WS_MEMN + (size_t)2 * 2048 * D * 2;
constexpr size_t WS_KVB = WS_PROJ + (size_t)MT * NCOL * 2;
constexpr size_t WS_BR = WS_KVB + (size_t)2 * 2048 * D * 2;
constexpr size_t WS_MRG = WS_BR + (size_t)MT * BR_LD * 2;
constexpr size_t WS_Y = WS_MRG + (size_t)MT * D * 2;
constexpr size_t WS_SSQ = WS_Y + (size_t)MT * D * 2;
constexpr size_t WS_BAR = WS_SSQ + (size_t)MT * 16 * 4;
constexpr size_t WS_END = WS_BAR + 3456 * 4;
constexpr int LDS_BAR_OFF = 140 * 1024 - 16;
constexpr int LDS_BYTES = 140 * 1024;
constexpr int NTHREADS = 512;

#ifndef MK_LAUNCHES
#define MK_LAUNCHES 1
#endif
constexpr int NPHASES = 11;
constexpr int R2A = 1, R2B = 1, R2C = 1, R2D = 1, R2E = 1;
constexpr int RSM = 1;
constexpr int REP0 = 1, REP1 = 1, REP2 = 1, REP3 = 1, REP4 = 1, REP5 = 1;

__device__ __forceinline__ unsigned pk2(float lo, float hi) { unsigned r; asm("v_cvt_pk_bf16_f32 %0, %1, %2" : "=v"(r) : "v"(lo), "v"(hi)); return r; }
__device__ __forceinline__ float bflo(unsigned w) { return __uint_as_float(w << 16); }
__device__ __forceinline__ float bfhi(unsigned w) { return __uint_as_float(w & 0xffff0000u); }
__device__ __forceinline__ float bf1(bf16_t b) { return __uint_as_float(((unsigned)b) << 16); }
__device__ __forceinline__ float sigmoidf_(float x) { return __builtin_amdgcn_rcpf(1.0f + __builtin_amdgcn_exp2f(-1.4426950408889634f * x)); }
__device__ __forceinline__ float siluf_(float x) { return x * sigmoidf_(x); }
__device__ __forceinline__ float wave_sum(float v) {
#pragma unroll
    for (int o = 1; o < 64; o <<= 1) v += __shfl_xor(v, o);
    return v;
}
#define LDS_WAIT() asm volatile("s_waitcnt lgkmcnt(0)" ::: "memory")

namespace pg8 {
constexpr int BM = 256, BK = 64, HALF = 128, HTB = HALF * BK * 2, STAGE_BYTES = 8 * HTB, NXCD = 8, WGM = 8;
__host__ __device__ __forceinline__ int lds_byte(int r, int c) { const int st = (r >> 4) * 2 + (c >> 5), rr = r & 15, cc = c & 31, ob = rr * 64 + cc * 2; return st * 1024 + (ob ^ (((ob >> 9) & 1) << 5)); }
__host__ __device__ __forceinline__ void stage_rc(int b, int& R, int& C) { const int st = b / 1024, sb = b % 1024, swz = sb ^ (((sb >> 9) & 1) << 5); R = (st >> 1) * 16 + swz / 64; C = (st & 1) * 32 + (swz % 64) / 2; }
__host__ __device__ __forceinline__ int perm32(int rho) { const int n = rho >> 4, i = rho & 15; return 8 * (i >> 2) + 4 * n + (i & 3); }

struct Unit { int pm, pn, z; };
struct Gemm { const bf16_t* A; const bf16_t* Bt; int K, lda, ldb; unsigned zA, zB; };

struct Order {
    int nM, nN, ntile, nz, zinner, G, c;
    __device__ void init(int M, int N, int nz_, int zinner_, int G_, int c_) { nM = M / BM; nN = N / BM; ntile = nM * nN; nz = nz_; zinner = zinner_; G = G_; c = c_; }
    __device__ bool next(int i, Unit& u) const {
        int tix, z;
        if (zinner) { tix = (i / nz) * G + c; z = i % nz; if (tix >= ntile) return false; }
        else { const long L = (long)i * G + c; if (L >= (long)ntile * nz) return false; z = (int)(L / ntile); tix = (int)(L % ntile); }
        int wgid = tix; { const int q = ntile / NXCD, r = ntile % NXCD, xcd = wgid % NXCD, off = wgid / NXCD; wgid = (xcd < r ? xcd * (q + 1) : r * (q + 1) + (xcd - r) * q) + off; }
        const int nig = WGM * nN, gid = wgid / nig, fm = gid * WGM, gsz = (nM - fm) < WGM ? (nM - fm) : WGM;
        u.pm = fm + ((wgid % nig) % gsz); u.pn = (wgid % nig) / gsz; u.z = z; return true;
    }
};

struct EpiStoreBf16 {
    static constexpr bool PERM = true;
    bf16_t* O; int ldc;
    __device__ __forceinline__ void operator()(const f32x4 (&acc)[2][2][4][2], const Unit& u, int wr, int wc, int fr, int fq) const {
        const int row0 = u.pm * BM + wr * 64 + fr, col0 = u.pn * BM + wc * 32 + 8 * fq;
#pragma unroll
        for (int ai = 0; ai < 2; ++ai)
#pragma unroll
            for (int m = 0; m < 4; ++m) { bf16_t* rowp = O + (size_t)(row0 + ai * HALF + m * 16) * ldc + col0;
#pragma unroll
                for (int bj = 0; bj < 2; ++bj) { const f32x4 v0 = acc[ai][bj][m][0], v1 = acc[ai][bj][m][1];
                    u32x4 w; w.x = pk2(v0[0], v0[1]); w.y = pk2(v0[2], v0[3]); w.z = pk2(v1[0], v1[1]); w.w = pk2(v1[2], v1[3]);
                    *(u32x4*)(rowp + bj * HALF) = w; } }
    }
};
struct EpiK {
    static constexpr bool PERM = false;
    float* outK; bf16_t* kb;
    __device__ __forceinline__ void operator()(const f32x4 (&acc)[2][2][4][2], const Unit& u, int wr, int wc, int fr, int fq) const {
        const int row0 = u.pm * BM + wr * 64 + fr, col0 = u.pn * BM + wc * 32 + 4 * fq;
        float* of = outK + (size_t)u.z * 2048 * 512; bf16_t* ob = kb + (size_t)u.z * 2048 * 512;
#pragma unroll
        for (int ai = 0; ai < 2; ++ai)
#pragma unroll
            for (int m = 0; m < 4; ++m) { const int r = row0 + ai * HALF + m * 16;
#pragma unroll
                for (int bj = 0; bj < 2; ++bj)
#pragma unroll
                    for (int n = 0; n < 2; ++n) { const f32x4 v = acc[ai][bj][m][n]; const int c = col0 + bj * HALF + n * 16;
                        *(f32x4*)(of + (size_t)r * 512 + c) = v;
                        u32x2 w; w.x = pk2(v[0], v[1]); w.y = pk2(v[2], v[3]);
                        *(u32x2*)(ob + (size_t)r * 512 + c) = w; } }
    }
};
struct EpiVt {
    static constexpr bool PERM = true;
    float* outV; bf16_t* vt;
    __device__ __forceinline__ void operator()(const f32x4 (&acc)[2][2][4][2], const Unit& u, int wr, int wc, int fr, int fq) const {
        const int row0 = u.pm * BM + wr * 64 + fr, col0 = u.pn * BM + wc * 32 + 8 * fq;
        float* of = outV + (size_t)u.z * 2048 * 512; bf16_t* ob = vt + (size_t)u.z * 512 * 2048;
#pragma unroll
        for (int ai = 0; ai < 2; ++ai)
#pragma unroll
            for (int m = 0; m < 4; ++m) { const int r = row0 + ai * HALF + m * 16;
#pragma unroll
                for (int bj = 0; bj < 2; ++bj) { const f32x4 v0 = acc[ai][bj][m][0], v1 = acc[ai][bj][m][1]; const int c = col0 + bj * HALF;
                    u32x4 w; w.x = pk2(v0[0], v0[1]); w.y = pk2(v0[2], v0[3]); w.z = pk2(v1[0], v1[1]); w.w = pk2(v1[2], v1[3]);
                    *(u32x4*)(ob + (size_t)r * 2048 + c) = w;
#pragma unroll
                    for (int j = 0; j < 4; ++j) { of[(size_t)(c + j) * 512 + r] = v0[j]; of[(size_t)(c + 4 + j) * 512 + r] = v1[j]; } } }
    }
};
struct EpiMerge {
    static constexpr bool PERM = true;
    const bf16_t* proj; bf16_t* mrg;
    __device__ __forceinline__ void operator()(const f32x4 (&acc)[2][2][4][2], const Unit& u, int wr, int wc, int fr, int fq) const {
        const int row0 = u.pm * BM + wr * 64 + fr, col0 = u.pn * BM + wc * 32 + 8 * fq;
#pragma unroll
        for (int ai = 0; ai < 2; ++ai)
#pragma unroll
            for (int m = 0; m < 4; ++m) { const int r = row0 + ai * HALF + m * 16;
                const bf16_t* lg = proj + (size_t)r * NCOL + C_LOGIT + u.z * D + col0; bf16_t* mp = mrg + (size_t)r * D + col0;
#pragma unroll
                for (int bj = 0; bj < 2; ++bj) { const f32x4 v0 = acc[ai][bj][m][0], v1 = acc[ai][bj][m][1];
                    const u32x4 g = *(const u32x4*)(lg + bj * HALF);
                    float o[8];
                    o[0] = v0[0] * sigmoidf_(bflo(g.x)); o[1] = v0[1] * sigmoidf_(bfhi(g.x)); o[2] = v0[2] * sigmoidf_(bflo(g.y)); o[3] = v0[3] * sigmoidf_(bfhi(g.y));
                    o[4] = v1[0] * sigmoidf_(bflo(g.z)); o[5] = v1[1] * sigmoidf_(bfhi(g.z)); o[6] = v1[2] * sigmoidf_(bflo(g.w)); o[7] = v1[3] * sigmoidf_(bfhi(g.w));
                    if (u.z != 0) { const u32x4 p = *(const u32x4*)(mp + bj * HALF);
                        o[0] += bflo(p.x); o[1] += bfhi(p.x); o[2] += bflo(p.y); o[3] += bfhi(p.y); o[4] += bflo(p.z); o[5] += bfhi(p.z); o[6] += bflo(p.w); o[7] += bfhi(p.w); }
                    u32x4 w; w.x = pk2(o[0], o[1]); w.y = pk2(o[2], o[3]); w.z = pk2(o[4], o[5]); w.w = pk2(o[6], o[7]);
                    *(u32x4*)(mp + bj * HALF) = w; }
                if (m == 3) asm volatile("" ::: "memory"); }
    }
};
struct EpiY {
    static constexpr bool PERM = true;
    bf16_t* Y; float* ssq;
    __device__ __forceinline__ void operator()(const f32x4 (&acc)[2][2][4][2], const Unit& u, int wr, int wc, int fr, int fq) const {
        const int row0 = u.pm * BM + wr * 64 + fr, col0 = u.pn * BM + wc * 32 + 8 * fq;
#pragma unroll
        for (int ai = 0; ai < 2; ++ai)
#pragma unroll
            for (int m = 0; m < 4; ++m) { const int r = row0 + ai * HALF + m * 16; bf16_t* rowp = Y + (size_t)r * D + col0; float s = 0.f;
#pragma unroll
                for (int bj = 0; bj < 2; ++bj) { const f32x4 v0 = acc[ai][bj][m][0], v1 = acc[ai][bj][m][1];
                    s += (v0[0] * v0[0] + v0[1] * v0[1]) + (v0[2] * v0[2] + v0[3] * v0[3]) + (v1[0] * v1[0] + v1[1] * v1[1]) + (v1[2] * v1[2] + v1[3] * v1[3]);
                    u32x4 w; w.x = pk2(v0[0], v0[1]); w.y = pk2(v0[2], v0[3]); w.z = pk2(v1[0], v1[1]); w.w = pk2(v1[2], v1[3]);
                    *(u32x4*)(rowp + bj * HALF) = w; }
                s += __shfl_xor(s, 16); s += __shfl_xor(s, 32);
                if (fq == 0) ssq[(size_t)r * 16 + u.pn * 4 + wc] = s; }
    }
};

template <class Epi>
__device__ __forceinline__ void gemm_phase(LAS unsigned char* lds, const Gemm g, const Order& S, const Epi& E, int tid_in) {
    int tid = tid_in; asm volatile("" : "+v"(tid));
    const int wid = __builtin_amdgcn_readfirstlane(tid >> 6), lane = tid & 63, wr = wid >> 2, wc = wid & 3, fr = lane & 15, fq = lane >> 4;
    const int K = g.K, nt = K / BK;
    unsigned voffA[2], voffB[2];
#pragma unroll
    for (int i = 0; i < 2; ++i) { int R, C; stage_rc(tid * 16 + i * 8192, R, C); const int Rb = Epi::PERM ? ((R & ~31) + perm32(R & 31)) : R;
        voffA[i] = (unsigned)(R * g.lda + C) * 2u; voffB[i] = (unsigned)(Rb * g.ldb + C) * 2u; }
    constexpr unsigned kstep = BK * 2;
    const unsigned hstepA = (unsigned)HALF * g.lda * 2, hstepB = (unsigned)HALF * g.ldb * 2;
    const unsigned tstepA = 2 * hstepA, tstepB = 2 * hstepB;
    const unsigned ldsw = (unsigned)wid * 1024u;
    const int aoff = lds_byte(wr * 64 + fr, fq * 8), boff = lds_byte(wc * 32 + fr, fq * 8);
#define PG8_SA(b, h) (((b) * 2 + (h)) * HTB)
#define PG8_SB(b, h) ((4 + (b) * 2 + (h)) * HTB)
#define PG8_STAGE(bufoff, gbase, voff) do { _Pragma("unroll") for (int _i = 0; _i < 2; ++_i) \
        __builtin_amdgcn_global_load_lds((const unsigned*)((const char*)(gbase) + (voff)[_i]), (LAS unsigned*)(lds + (bufoff) + ldsw + _i * 8192), 16, 0, 0); } while (0)
#define PG8_LDA(dst, b, h) do { _Pragma("unroll") for (int m = 0; m < 4; ++m) _Pragma("unroll") for (int k = 0; k < 2; ++k) dst[m][k] = *(const LAS bf16x8*)(lds + PG8_SA(b, h) + aoff + m * 2048 + k * 1024); } while (0)
#define PG8_LDB(dst, b, h) do { _Pragma("unroll") for (int n = 0; n < 2; ++n) _Pragma("unroll") for (int k = 0; k < 2; ++k) dst[n][k] = *(const LAS bf16x8*)(lds + PG8_SB(b, h) + boff + n * 2048 + k * 1024); } while (0)
#define PG8_MMA(ai, bj, At, Bt) do { __builtin_amdgcn_s_setprio(1); _Pragma("unroll") for (int m = 0; m < 4; ++m) _Pragma("unroll") for (int n = 0; n < 2; ++n) _Pragma("unroll") for (int k = 0; k < 2; ++k) \
        acc[ai][bj][m][n] = __builtin_amdgcn_mfma_f32_16x16x32_bf16(Bt[n][k], At[m][k], acc[ai][bj][m][n], 0, 0, 0); __builtin_amdgcn_s_setprio(0); } while (0)
#define PG8_WAIT_V(n) asm volatile("s_waitcnt vmcnt(" #n ")" ::: "memory")
#define PG8_WAIT_L(n) asm volatile("s_waitcnt lgkmcnt(" #n ")" ::: "memory")
#define PG8_BAR __builtin_amdgcn_s_barrier()
#define PG8_SCHED __builtin_amdgcn_sched_barrier(0)
    Unit cur, nxt; int ui = 0;
    if (!S.next(0, cur)) return;
    f32x4 acc[2][2][4][2];
#pragma unroll
    for (int a = 0; a < 2; ++a)
#pragma unroll
        for (int b = 0; b < 2; ++b)
#pragma unroll
            for (int m = 0; m < 4; ++m)
#pragma unroll
                for (int n = 0; n < 2; ++n) acc[a][b][m][n] = (f32x4){0.f, 0.f, 0.f, 0.f};
    bf16x8 At[4][2], B0[2][2], B1[2][2];
    const char* cA = (const char*)g.A + (size_t)((unsigned)cur.pm * tstepA + (unsigned)cur.z * g.zA); const char* cB = (const char*)g.Bt + (size_t)((unsigned)cur.pn * tstepB + (unsigned)cur.z * g.zB);
    PG8_STAGE(PG8_SB(0, 0), cB, voffB); PG8_STAGE(PG8_SB(0, 1), cB + hstepB, voffB); PG8_STAGE(PG8_SA(0, 0), cA, voffA); PG8_STAGE(PG8_SA(0, 1), cA + hstepA, voffA);
    if (wr == 1) PG8_BAR;
    PG8_WAIT_V(2); PG8_BAR;
    PG8_STAGE(PG8_SB(1, 0), cB + kstep, voffB); PG8_STAGE(PG8_SA(1, 0), cA + kstep, voffA); PG8_STAGE(PG8_SB(1, 1), cB + hstepB + kstep, voffB);
    PG8_WAIT_V(6); PG8_BAR;
    for (;;) {
        const bool has_next = S.next(ui + 1, nxt);
        const char* nA = has_next ? (const char*)g.A + (size_t)((unsigned)nxt.pm * tstepA + (unsigned)nxt.z * g.zA) : cA;
        const char* nB = has_next ? (const char*)g.Bt + (size_t)((unsigned)nxt.pn * tstepB + (unsigned)nxt.z * g.zB) : cB;
        for (int t = 0; t < nt; t += 2) {
            const bool last = (t == nt - 2);
            const char* a1 = cA + (unsigned)(t + 1) * kstep;
            const char* a2 = last ? nA : cA + (unsigned)(t + 2) * kstep; const char* b2 = last ? nB : cB + (unsigned)(t + 2) * kstep;
            const char* a3 = a2 + kstep; const char* b3 = b2 + kstep;
            PG8_LDB(B0, 0, 0); PG8_LDB(B1, 0, 1); PG8_SCHED; PG8_LDA(At, 0, 0); PG8_STAGE(PG8_SA(1, 1), a1 + hstepA, voffA);
            PG8_WAIT_V(8); PG8_WAIT_L(0); PG8_BAR; PG8_MMA(0, 0, At, B0); PG8_MMA(0, 1, At, B1); PG8_BAR; PG8_SCHED;
            PG8_LDA(At, 0, 1); PG8_STAGE(PG8_SB(0, 0), b2, voffB); PG8_STAGE(PG8_SB(0, 1), b2 + hstepB, voffB); PG8_STAGE(PG8_SA(0, 0), a2, voffA);
            PG8_WAIT_V(8); PG8_WAIT_L(0); PG8_BAR; PG8_MMA(1, 0, At, B0); PG8_MMA(1, 1, At, B1); PG8_BAR; PG8_SCHED;
            PG8_LDB(B0, 1, 0); PG8_LDB(B1, 1, 1); PG8_SCHED; PG8_LDA(At, 1, 0); PG8_STAGE(PG8_SA(0, 1), a2 + hstepA, voffA);
            PG8_WAIT_V(8); PG8_WAIT_L(0); PG8_BAR; PG8_MMA(0, 0, At, B0); PG8_MMA(0, 1, At, B1); PG8_BAR; PG8_SCHED;
            PG8_LDA(At, 1, 1); PG8_STAGE(PG8_SB(1, 0), b3, voffB); PG8_STAGE(PG8_SB(1, 1), b3 + hstepB, voffB); PG8_STAGE(PG8_SA(1, 0), a3, voffA);
            PG8_WAIT_V(8); PG8_WAIT_L(0); PG8_BAR; PG8_MMA(1, 0, At, B0); PG8_MMA(1, 1, At, B1); PG8_BAR; PG8_SCHED;
        }
        if (wr == 0) PG8_BAR;
        E(acc, cur, wr, wc, fr, fq);
        if (!has_next) break;
#pragma unroll
        for (int a = 0; a < 2; ++a)
#pragma unroll
            for (int b = 0; b < 2; ++b)
#pragma unroll
                for (int m = 0; m < 4; ++m)
#pragma unroll
                    for (int n = 0; n < 2; ++n) acc[a][b][m][n] = (f32x4){0.f, 0.f, 0.f, 0.f};
        cur = nxt; cA = nA; cB = nB; ++ui;
        if (wr == 1) PG8_BAR;
    }
    PG8_WAIT_V(0);
    PG8_BAR;
#undef PG8_SA
#undef PG8_SB
#undef PG8_STAGE
#undef PG8_LDA
#undef PG8_LDB
#undef PG8_MMA
#undef PG8_WAIT_V
#undef PG8_WAIT_L
#undef PG8_BAR
#undef PG8_SCHED
}
}


#define XB_TMO      128
#define XB_XCNT(j)  (256  + 64 * (j))
#define XB_XSUB(j)  (1280 + 64 * (j))
#define XB_XGEN(j)  (2304 + 64 * (j))
#define XB_TOP      3328
#define XB_TOPGEN   3392
#define XCD_BAR_WORDS 3456
#define XB_SPIN_CAP (1u << 22)
__device__ __forceinline__ unsigned xb_ld(unsigned* p)              { return __hip_atomic_load(p, __ATOMIC_RELAXED, __HIP_MEMORY_SCOPE_AGENT); }
__device__ __forceinline__ unsigned xb_add(unsigned* p, unsigned v) { return __hip_atomic_fetch_add(p, v, __ATOMIC_RELAXED, __HIP_MEMORY_SCOPE_AGENT); }
__device__ __forceinline__ unsigned xb_xcc_id() { return (unsigned)__builtin_amdgcn_s_getreg((3 << 11) | 20) & 0xFu; }
#define XB_SPIN(cond, bar) do { unsigned _sp = 0; while (cond) { __builtin_amdgcn_s_sleep(1); \
    if ((++_sp & 255u) == 0u) { if (xb_ld(&(bar)[XB_TMO])) break; if (_sp > XB_SPIN_CAP) { atomicAdd(&(bar)[XB_TMO], 1u); break; } } } } while (0)
struct XcdBarrier { unsigned* bar; unsigned x; volatile LAS unsigned* st; };
__device__ __forceinline__ XcdBarrier xcd_barrier_post(unsigned* bar, volatile LAS unsigned* st, bool leader) {
    XcdBarrier b; b.bar = bar; b.x = xb_xcc_id(); b.st = st;
    if (leader) (void)xb_add(&bar[XB_XCNT(b.x)], 1u);
    return b;
}
__device__ __forceinline__ void xcd_barrier_complete(unsigned* bar, unsigned x, unsigned& nloc, unsigned& nx) {
    const unsigned G = gridDim.x * gridDim.y * gridDim.z;
    unsigned sum, cnt, mine, sp = 0u;
    for (;;) {
        sum = 0u; cnt = 0u; mine = 0u;
#pragma unroll 1
        for (unsigned j = 0; j < 16; ++j) { const unsigned c = xb_ld(&bar[XB_XCNT(j)]); sum += c; cnt += (c > 0u) ? 1u : 0u; mine = (j == x) ? c : mine; }
        if (sum == G) break;
        __builtin_amdgcn_s_sleep(1);
        if ((++sp & 255u) == 0u) { if (xb_ld(&bar[XB_TMO])) break; if (sp > XB_SPIN_CAP) { atomicAdd(&bar[XB_TMO], 1u); break; } }
    }
    nloc = mine > 0u ? mine : 1u; nx = cnt > 0u ? cnt : 1u;
}
__device__ __forceinline__ void xcd_barrier(const XcdBarrier& b, bool leader) {
    asm volatile("s_waitcnt vmcnt(0)" ::: "memory");
    __syncthreads();
    if (leader) {
        unsigned* bar = b.bar; asm volatile("" : "+s"(bar));
        __builtin_amdgcn_s_waitcnt(0);
        unsigned nloc = b.st[0], nx = b.st[1];
        if (nloc == 0u) { xcd_barrier_complete(bar, b.x, nloc, nx); b.st[0] = nloc; b.st[1] = nx; }
        const unsigned old = xb_add(&bar[XB_XSUB(b.x)], 1u);
        const unsigned gen = old / nloc;
        if (old + 1u == (gen + 1u) * nloc) {
            __builtin_amdgcn_fence(__ATOMIC_RELEASE, "agent");
            asm volatile("s_waitcnt vmcnt(0)" ::: "memory");
            const unsigned og = xb_add(&bar[XB_TOP], 1u);
            const unsigned tg = og / nx;
            if (og + 1u == (tg + 1u) * nx) xb_add(&bar[XB_TOPGEN], 1u);
            else XB_SPIN(xb_ld(&bar[XB_TOPGEN]) == tg, bar);
            __builtin_amdgcn_fence(__ATOMIC_ACQUIRE, "agent");
            xb_add(&bar[XB_XGEN(b.x)], 1u);
            asm volatile("s_waitcnt vmcnt(0)" ::: "memory");
        } else {
            XB_SPIN(xb_ld(&bar[XB_XGEN(b.x)]) == gen, bar);
            __builtin_amdgcn_fence(__ATOMIC_ACQUIRE, "agent");
            asm volatile("s_waitcnt vmcnt(0)" ::: "memory");
        }
    }
    __syncthreads();
}

struct Params { const float* in[20]; float* out; unsigned char* ws; int ph_lo, ph_hi, use_cg, pad; };
enum { I_XP = 0, I_XS, I_SPOOL, I_SCONV, I_CK, I_CV, I_MEM, I_NPRE, I_NPOST, I_MNORM, I_WKV, I_WIN, I_POOLW, I_PSCALE, I_CONVW, I_CONVB, I_LNG, I_LNB, I_WBR, I_WOUT };

__device__ __forceinline__ void transpose_item(const float* W, int K, int N, bf16_t* WT, LAS float* scr, int item, int lane) {
    const int nblk = N / 32, kb = item / nblk, nb = item % nblk, k0 = 64 * kb, n0 = 32 * nb;
    const int kk = lane >> 3, n4 = (lane & 7) * 4;
    f32x4 v[8];
#pragma unroll
    for (int i = 0; i < 8; ++i) v[i] = *(const f32x4*)(W + (size_t)(k0 + kk + 8 * i) * N + n0 + n4);
#pragma unroll
    for (int i = 0; i < 8; ++i) { LAS float* d = scr + (kk + 8 * i) * 33 + n4; d[0] = v[i].x; d[1] = v[i].y; d[2] = v[i].z; d[3] = v[i].w; }
    LDS_WAIT();
    const int c = lane & 7;
#pragma unroll
    for (int j = 0; j < 4; ++j) { const int n = (lane >> 3) + 8 * j; const LAS float* s = scr + (8 * c) * 33 + n;
        u32x4 o; o.x = pk2(s[0 * 33], s[1 * 33]); o.y = pk2(s[2 * 33], s[3 * 33]); o.z = pk2(s[4 * 33], s[5 * 33]); o.w = pk2(s[6 * 33], s[7 * 33]);
        *(u32x4*)(WT + (size_t)(n0 + n) * K + k0 + 8 * c) = o; }
    LDS_WAIT();
}

__device__ __forceinline__ void p0_prologue(const Params& p, LAS unsigned char* lds, int gw, int NGW, int wave, int lane) {
    LAS float* scr = (LAS float*)(lds + wave * 8704);
    unsigned char* ws = p.ws;
    constexpr int I_IN = (D / 64) * (NCOL / 32), I_SQ = (D / 64) * (D / 32), I_BR = (512 / 64) * (D / 32), I_PL = 2 * 4;
    constexpr int NITEMS = 2 * I_IN + 2 * I_SQ + 6 * I_BR + 2 * I_SQ + 8 * I_PL;
    for (int it = gw; it < NITEMS; it += NGW) {
        int r = it;
        if (r < 2 * I_IN) { const int l = r / I_IN; transpose_item(p.in[I_WIN] + (size_t)l * D * NCOL, D, NCOL, (bf16_t*)(ws + WS_WIN) + (size_t)l * NCOL * D, scr, r % I_IN, lane); continue; } r -= 2 * I_IN;
        if (r < 2 * I_SQ) { const int l = r / I_SQ; transpose_item(p.in[I_WKV] + (size_t)l * D * D, D, D, (bf16_t*)(ws + WS_WKV) + (size_t)l * D * D, scr, r % I_SQ, lane); continue; } r -= 2 * I_SQ;
        if (r < 6 * I_BR) { const int l = r / I_BR; transpose_item(p.in[I_WBR] + (size_t)l * 512 * D, 512, D, (bf16_t*)(ws + WS_WBR) + (size_t)l * D * 512, scr, r % I_BR, lane); continue; } r -= 6 * I_BR;
        if (r < 2 * I_SQ) { const int l = r / I_SQ; transpose_item(p.in[I_WOUT] + (size_t)l * D * D, D, D, (bf16_t*)(ws + WS_WOUT) + (size_t)l * D * D, scr, r % I_SQ, lane); continue; } r -= 2 * I_SQ;
        { const int l = r / I_PL; transpose_item(p.in[I_POOLW] + (size_t)l * 128 * 128, 128, 128, (bf16_t*)(ws + WS_WPOOL) + (size_t)l * 128 * 128, scr, r % I_PL, lane); }
    }
    const float* g0 = p.in[I_NPRE];
    for (int m0 = gw; m0 < MT; m0 += 2 * NGW) {
        f32x4 v[2][4]; float s[2];
#pragma unroll
        for (int r = 0; r < 2; ++r) { const int mm = m0 + r * NGW, m = mm < MT ? mm : MT - 1;
            const float* xrow = (m < MP) ? p.in[I_XP] + (size_t)m * D : p.in[I_XS] + (size_t)(m - MP) * D; const f32x4* xr = (const f32x4*)xrow + lane;
#pragma unroll
            for (int j = 0; j < 4; ++j) v[r][j] = xr[64 * j]; }
#pragma unroll
        for (int r = 0; r < 2; ++r) { float t = 0.f;
#pragma unroll
            for (int j = 0; j < 4; ++j) t += (v[r][j].x * v[r][j].x + v[r][j].y * v[r][j].y) + (v[r][j].z * v[r][j].z + v[r][j].w * v[r][j].w);
            s[r] = 1.0f / sqrtf(wave_sum(t) * (1.f / D) + EPS); }
#pragma unroll
        for (int r = 0; r < 2; ++r) { const int mm = m0 + r * NGW; if (mm < MT) { u32x2* o = (u32x2*)((bf16_t*)(ws + WS_H) + (size_t)mm * D) + lane; const float rs = s[r];
#pragma unroll
            for (int j = 0; j < 4; ++j) { const f32x4 g = ((const f32x4*)g0)[lane + 64 * j]; u32x2 w; w.x = pk2(v[r][j].x * rs * g.x, v[r][j].y * rs * g.y); w.y = pk2(v[r][j].z * rs * g.z, v[r][j].w * rs * g.w); o[64 * j] = w; } } }
    }
    for (int m = gw; m < 2048; m += NGW) {
        const f32x4* xr = (const f32x4*)(p.in[I_MEM] + (size_t)m * D) + lane; f32x4 v[4]; float s = 0.f;
#pragma unroll
        for (int j = 0; j < 4; ++j) { v[j] = xr[64 * j]; s += (v[j].x * v[j].x + v[j].y * v[j].y) + (v[j].z * v[j].z + v[j].w * v[j].w); }
        const float rs = 1.0f / sqrtf(wave_sum(s) * (1.f / D) + EPS);
#pragma unroll
        for (int l = 0; l < 2; ++l) { u32x2* o = (u32x2*)((bf16_t*)(ws + WS_MEMN) + ((size_t)l * 2048 + m) * D) + lane;
#pragma unroll
            for (int j = 0; j < 4; ++j) { const f32x4 g = ((const f32x4*)(p.in[I_MNORM] + l * D))[lane + 64 * j]; u32x2 w; w.x = pk2(v[j].x * rs * g.x, v[j].y * rs * g.y); w.y = pk2(v[j].z * rs * g.z, v[j].w * rs * g.w); o[64 * j] = w; } }
    }
}

__device__ __forceinline__ void p5_residual(const Params& p, int layer, int gw, int NGW, int lane) {
    unsigned char* ws = p.ws;
    const bf16_t* Y = (const bf16_t*)(ws + WS_Y); const float* ssq = (const float*)(ws + WS_SSQ);
    const f32x4* gp = (const f32x4*)(p.in[I_NPOST] + layer * D); const f32x4* gn = (const f32x4*)(p.in[I_NPRE] + D);
    for (int m0 = gw; m0 < MT; m0 += 2 * NGW) {
        f32x4 x[2][4]; u32x2 y[2][4]; float sp[2];
#pragma unroll
        for (int r = 0; r < 2; ++r) { const int mm = m0 + r * NGW, m = mm < MT ? mm : MT - 1;
            const float* xrow = (layer == 0) ? ((m < MP) ? p.in[I_XP] + (size_t)m * D : p.in[I_XS] + (size_t)(m - MP) * D) : p.out + (size_t)m * D;
            sp[r] = (lane < 16) ? ssq[(size_t)m * 16 + lane] : 0.f;
            const f32x4* xr = (const f32x4*)xrow + lane; const u32x2* yr = (const u32x2*)(Y + (size_t)m * D) + lane;
#pragma unroll
            for (int j = 0; j < 4; ++j) { x[r][j] = xr[64 * j]; y[r][j] = yr[64 * j]; } }
#pragma unroll
        for (int r = 0; r < 2; ++r) { const int mm = m0 + r * NGW;
            const float rs = 1.0f / sqrtf(wave_sum(sp[r]) * (1.f / D) + EPS); float s = 0.f;
#pragma unroll
            for (int j = 0; j < 4; ++j) { const f32x4 g = gp[lane + 64 * j]; f32x4& v = x[r][j]; const u32x2 yy = y[r][j];
                v.x += bflo(yy.x) * rs * g.x; v.y += bfhi(yy.x) * rs * g.y; v.z += bflo(yy.y) * rs * g.z; v.w += bfhi(yy.y) * rs * g.w;
                s += (v.x * v.x + v.y * v.y) + (v.z * v.z + v.w * v.w); }
            if (mm < MT) {
                f32x4* orow = (f32x4*)(p.out + (size_t)mm * D) + lane;
#pragma unroll
                for (int j = 0; j < 4; ++j) orow[64 * j] = x[r][j];
            }
            if (layer == 0) {
                const float r2 = 1.0f / sqrtf(wave_sum(s) * (1.f / D) + EPS);
                if (mm < MT) { u32x2* o = (u32x2*)((bf16_t*)(ws + WS_H) + (size_t)mm * D) + lane;
#pragma unroll
                    for (int j = 0; j < 4; ++j) { const f32x4 g = gn[lane + 64 * j]; const f32x4 v = x[r][j]; u32x2 w; w.x = pk2(v.x * r2 * g.x, v.y * r2 * g.y); w.y = pk2(v.z * r2 * g.z, v.w * r2 * g.w); o[64 * j] = w; } }
            }
        }
    }
}

template <int T, bool SAMPLE>
__device__ __forceinline__ void pool_task(const Params& p, int layer, LAS unsigned char* lds, int task, int tid, int wave, int lane) {
    constexpr int R = T + 15, NRB = (T + 15) / 16;
    unsigned char* ws = p.ws;
    const bf16_t* proj = (const bf16_t*)(ws + WS_PROJ); bf16_t* br = (bf16_t*)(ws + WS_BR);
    LAS unsigned* PE = (LAS unsigned*)lds;
    LAS unsigned* MX = (LAS unsigned*)(lds + R * 1024);
    int b = 0, t0 = 0, seq = 0, rowbase;
    if (SAMPLE) { seq = task; rowbase = MP + seq * 8; } else { b = task >> 6; t0 = (task & 63) * T; rowbase = b * SEQ + t0; }
    const int g_ = wave >> 1, ch_ = wave & 1, h4_ = lane >> 4, c_ = lane & 15;
    u32x2 gtp[NRB][4];
    {
#pragma unroll
      for (int rb = 0; rb < NRB; ++rb) { const int tr = 16 * rb + c_;
#pragma unroll
        for (int cb = 0; cb < 4; ++cb) gtp[rb][cb] = *(const u32x2*)(proj + (size_t)(rowbase + (tr < T ? tr : 0)) * NCOL + C_PGATE + 128 * g_ + 64 * ch_ + 16 * cb + 4 * h4_); } }
    __syncthreads();
    if (SAMPLE) {
        f32x4 sa[2], sb[2]; u32x4 pw;
#pragma unroll
        for (int i = 0; i < 2; ++i) { const int idx = tid + NTHREADS * i, row = idx < 960 ? (idx >> 6) : 0, c8 = idx & 63;
            const float* src = p.in[I_SPOOL] + (((size_t)layer * NSEQ + seq) * 15 + row) * 512 + 8 * c8; sa[i] = *(const f32x4*)src; sb[i] = *(const f32x4*)(src + 4); }
        { const int row = tid >> 6, c8 = tid & 63; pw = *(const u32x4*)(proj + (size_t)(rowbase + row) * NCOL + 8 * c8); }
#pragma unroll
        for (int i = 0; i < 2; ++i) { const int idx = tid + NTHREADS * i, row = idx >> 6, c8 = idx & 63;
            if (idx < 960) { u32x4 w; w.x = pk2(sa[i].x, sa[i].y); w.y = pk2(sa[i].z, sa[i].w); w.z = pk2(sb[i].x, sb[i].y); w.w = pk2(sb[i].z, sb[i].w);
                *(LAS u32x4*)(PE + row * 256 + 4 * c8) = w;
                if (row >= 8) { float* o = p.out + O_POOLS + (((size_t)layer * NSEQ + seq) * 15 + (row - 8)) * 512 + 8 * c8; *(f32x4*)o = sa[i]; *(f32x4*)(o + 4) = sb[i]; } } }
        { const int row = 15 + (tid >> 6), c8 = tid & 63; *(LAS u32x4*)(PE + row * 256 + 4 * c8) = pw;
            float* o = p.out + O_POOLS + (((size_t)layer * NSEQ + seq) * 15 + (row - 8)) * 512 + 8 * c8;
            *(f32x4*)o = (f32x4){bflo(pw.x), bfhi(pw.x), bflo(pw.y), bfhi(pw.y)}; *(f32x4*)(o + 4) = (f32x4){bflo(pw.z), bfhi(pw.z), bflo(pw.w), bfhi(pw.w)}; }
    } else {
        constexpr int NCH = R * 64, NIT = (NCH + NTHREADS - 1) / NTHREADS;
        u32x4 pw[NIT];
#pragma unroll
        for (int i = 0; i < NIT; ++i) { const int idx = tid + NTHREADS * i, row = idx >> 6, c8 = idx & 63; int grow = t0 - 15 + row; if (grow < 0 || idx >= NCH) grow = 0;
            pw[i] = *(const u32x4*)(proj + (size_t)(b * SEQ + grow) * NCOL + 8 * c8); }
#pragma unroll
        for (int i = 0; i < NIT; ++i) { const int idx = tid + NTHREADS * i, row = idx >> 6, c8 = idx & 63; const int grow = t0 - 15 + row;
            if (idx < NCH) { u32x4 w = pw[i]; if (grow < 0) w = (u32x4){0u, 0u, 0u, 0u};
                *(LAS u32x4*)(PE + row * 256 + 4 * c8) = w;
                if (grow >= SEQ - 15) { float* o = p.out + O_POOLP + (((size_t)layer * 8 + b) * 15 + (grow - (SEQ - 15))) * 512 + 8 * c8;
                    *(f32x4*)o = (f32x4){bflo(w.x), bfhi(w.x), bflo(w.y), bfhi(w.y)}; *(f32x4*)(o + 4) = (f32x4){bflo(w.z), bfhi(w.z), bflo(w.w), bfhi(w.w)}; } } }
    }
    __syncthreads();
    for (int idx = tid; idx < T * 256; idx += NTHREADS) {
        const int t = idx >> 8, cp = idx & 255, g = cp >> 6, win = 2 << g;
        float s0 = 0.f, s1 = 0.f;
        for (int j = 0; j < win; ++j) { const unsigned w = PE[(15 + t - j) * 256 + cp]; s0 += bflo(w); s1 += bfhi(w); }
        const unsigned cur = PE[(15 + t) * 256 + cp];
        float cnt = (float)win; if (!SAMPLE) { const int pp = t0 + t + 1; cnt = (float)(pp < win ? pp : win); }
        const float inv = 1.0f / cnt;
        MX[t * 260 + cp] = pk2(s0 * inv - bflo(cur), s1 * inv - bfhi(cur));
    }
    __syncthreads();
    {
        const int g = g_, ch = ch_, h4 = h4_, c = c_;
        const bf16_t* wt = (const bf16_t*)(ws + WS_WPOOL) + ((size_t)(layer * 4 + g) * 128 + 64 * ch) * 128;
        bf16x8 wf[4][4];
#pragma unroll
        for (int ks = 0; ks < 4; ++ks)
#pragma unroll
            for (int cb = 0; cb < 4; ++cb) wf[ks][cb] = *(const bf16x8*)(wt + (size_t)(16 * cb + c) * 128 + 32 * ks + 8 * h4);
        f32x4 acc[NRB][4];
#pragma unroll
        for (int rb = 0; rb < NRB; ++rb)
#pragma unroll
            for (int cb = 0; cb < 4; ++cb) acc[rb][cb] = (f32x4){0.f, 0.f, 0.f, 0.f};
#pragma unroll
        for (int ks = 0; ks < 4; ++ks) {
            bf16x8 bf[NRB];
#pragma unroll
            for (int rb = 0; rb < NRB; ++rb) bf[rb] = *(const LAS bf16x8*)((LAS unsigned char*)MX + (16 * rb + c) * 1040 + (128 * g + 32 * ks + 8 * h4) * 2);
#pragma unroll
            for (int cb = 0; cb < 4; ++cb)
#pragma unroll
                for (int rb = 0; rb < NRB; ++rb) acc[rb][cb] = __builtin_amdgcn_mfma_f32_16x16x32_bf16(wf[ks][cb], bf[rb], acc[rb][cb], 0, 0, 0);
        }
#pragma unroll
        for (int rb = 0; rb < NRB; ++rb) { const int tr = 16 * rb + c; if (tr < T) { const size_t row = (size_t)rowbase + tr;
#pragma unroll
                for (int cb = 0; cb < 4; ++cb) { const int col = 128 * g + 64 * ch + 16 * cb + 4 * h4;
                    const f32x4 sc = *(const f32x4*)(p.in[I_PSCALE] + layer * 512 + col); const u32x2 gt = gtp[rb][cb]; const f32x4 a = acc[rb][cb];
                    u32x2 w; w.x = pk2(a[0] * sc.x * siluf_(bflo(gt.x)), a[1] * sc.y * siluf_(bfhi(gt.x))); w.y = pk2(a[2] * sc.z * siluf_(bflo(gt.y)), a[3] * sc.w * siluf_(bfhi(gt.y)));
                    *(u32x2*)(br + row * BR_LD + col) = w; } } }
    }
}

template <int T, bool SAMPLE>
__device__ __forceinline__ void conv_task(const Params& p, int layer, LAS unsigned char* lds, int task, int tid, int wave, int lane) {
    constexpr int R = T + 30, TT = T / 2;
    unsigned char* ws = p.ws;
    const bf16_t* proj = (const bf16_t*)(ws + WS_PROJ); bf16_t* br = (bf16_t*)(ws + WS_BR);
    LAS unsigned* U = (LAS unsigned*)lds;
    LAS float* CO = (LAS float*)(lds + R * 1024);
    int b = 0, t0 = 0, seq = 0, rowbase;
    if (SAMPLE) { seq = task; rowbase = MP + seq * 8; } else { b = task >> 6; t0 = (task & 63) * T; rowbase = b * SEQ + t0; }
    const int cp = tid & 255, half = tid >> 8;
    constexpr int NTK = (T + 7) / 8;
    u32x4 gts[NTK];
#pragma unroll
    for (int i = 0; i < NTK; ++i) { const int t = wave + 8 * i; gts[i] = *(const u32x4*)(proj + (size_t)(rowbase + (t < T ? t : 0)) * NCOL + C_CGATE + 8 * lane); }
    __syncthreads();
#define GLU8(cv, cg_, ua, ub) do { \
        ua = (f32x4){bflo(cv.x) * sigmoidf_(bflo(cg_.x)), bfhi(cv.x) * sigmoidf_(bfhi(cg_.x)), bflo(cv.y) * sigmoidf_(bflo(cg_.y)), bfhi(cv.y) * sigmoidf_(bfhi(cg_.y))}; \
        ub = (f32x4){bflo(cv.z) * sigmoidf_(bflo(cg_.z)), bfhi(cv.z) * sigmoidf_(bfhi(cg_.z)), bflo(cv.w) * sigmoidf_(bflo(cg_.w)), bfhi(cv.w) * sigmoidf_(bfhi(cg_.w))}; } while (0)
    if (SAMPLE) {
        f32x4 sa[4], sb[4]; u32x4 cv, cg_;
#pragma unroll
        for (int i = 0; i < 4; ++i) { const int idx = tid + NTHREADS * i, row = idx < 1920 ? (idx >> 6) : 0, c8 = idx & 63;
            const float* src = p.in[I_SCONV] + (((size_t)layer * NSEQ + seq) * 30 + row) * 512 + 8 * c8; sa[i] = *(const f32x4*)src; sb[i] = *(const f32x4*)(src + 4); }
        { const int row = tid >> 6, c8 = tid & 63; const bf16_t* src = proj + (size_t)(rowbase + row) * NCOL + 8 * c8; cv = *(const u32x4*)(src + C_CVAL); cg_ = *(const u32x4*)(src + C_CGLU); }
#pragma unroll
        for (int i = 0; i < 4; ++i) { const int idx = tid + NTHREADS * i, row = idx >> 6, c8 = idx & 63;
            if (idx < 1920) { u32x4 w; w.x = pk2(sa[i].x, sa[i].y); w.y = pk2(sa[i].z, sa[i].w); w.z = pk2(sb[i].x, sb[i].y); w.w = pk2(sb[i].z, sb[i].w);
                *(LAS u32x4*)(U + row * 256 + 4 * c8) = w;
                if (row >= 8) { float* o = p.out + O_CONVS + (((size_t)layer * NSEQ + seq) * 30 + (row - 8)) * 512 + 8 * c8; *(f32x4*)o = sa[i]; *(f32x4*)(o + 4) = sb[i]; } } }
        { const int row = 30 + (tid >> 6), c8 = tid & 63; f32x4 ua, ub; GLU8(cv, cg_, ua, ub);
            u32x4 w; w.x = pk2(ua.x, ua.y); w.y = pk2(ua.z, ua.w); w.z = pk2(ub.x, ub.y); w.w = pk2(ub.z, ub.w);
            *(LAS u32x4*)(U + row * 256 + 4 * c8) = w;
            float* o = p.out + O_CONVS + (((size_t)layer * NSEQ + seq) * 30 + (row - 8)) * 512 + 8 * c8; *(f32x4*)o = ua; *(f32x4*)(o + 4) = ub; }
    } else {
        constexpr int NCH = R * 64, NIT = (NCH + NTHREADS - 1) / NTHREADS;
        u32x4 cv[NIT], cg_[NIT];
#pragma unroll
        for (int i = 0; i < NIT; ++i) { const int idx = tid + NTHREADS * i, row = idx >> 6, c8 = idx & 63; int gs = t0 - 30 + row; if (gs < 0 || idx >= NCH) gs = 0;
            const bf16_t* src = proj + (size_t)(b * SEQ + gs) * NCOL + 8 * c8; cv[i] = *(const u32x4*)(src + C_CVAL); cg_[i] = *(const u32x4*)(src + C_CGLU); }
#pragma unroll
        for (int i = 0; i < NIT; ++i) { const int idx = tid + NTHREADS * i, row = idx >> 6, c8 = idx & 63; const int gs = t0 - 30 + row;
            if (idx < NCH) { f32x4 ua, ub; GLU8(cv[i], cg_[i], ua, ub); if (gs < 0) { ua = (f32x4){0.f, 0.f, 0.f, 0.f}; ub = ua; }
                u32x4 w; w.x = pk2(ua.x, ua.y); w.y = pk2(ua.z, ua.w); w.z = pk2(ub.x, ub.y); w.w = pk2(ub.z, ub.w);
                *(LAS u32x4*)(U + row * 256 + 4 * c8) = w;
                if (gs >= SEQ - 30) { float* o = p.out + O_CONVP + (((size_t)layer * 8 + b) * 30 + (gs - (SEQ - 30))) * 512 + 8 * c8; *(f32x4*)o = ua; *(f32x4*)(o + 4) = ub; } } }
    }
#undef GLU8
    __syncthreads();
    {
        f32x2 wk[31];
        { const f32x2* cw = (const f32x2*)(p.in[I_CONVW] + (size_t)layer * 31 * 512) + cp;
#pragma unroll
          for (int k = 0; k < 31; ++k) wk[k] = cw[k * 256]; }
        const f32x2 bias = *((const f32x2*)(p.in[I_CONVB] + layer * 512) + cp);
        f32x2 acc[TT];
#pragma unroll
        for (int t = 0; t < TT; ++t) acc[t] = bias;
#pragma unroll
        for (int j = 0; j < TT + 30; ++j) {
            const unsigned uu = U[(half * TT + j) * 256 + cp]; const f32x2 uv = (f32x2){bflo(uu), bfhi(uu)};
#pragma unroll
            for (int t = 0; t < TT; ++t) { const int k = j - t; if (k >= 0 && k < 31) acc[t] += wk[k] * uv; }
        }
#pragma unroll
        for (int t = 0; t < TT; ++t) *(LAS f32x2*)(CO + (half * TT + t) * 512 + 2 * cp) = acc[t];
    }
    __syncthreads();
    {
        const float* lg = p.in[I_LNG] + layer * 512 + 8 * lane; const float* lb = p.in[I_LNB] + layer * 512 + 8 * lane;
        const f32x4 g0 = *(const f32x4*)lg, g1 = *(const f32x4*)(lg + 4), b0 = *(const f32x4*)lb, b1 = *(const f32x4*)(lb + 4);
#pragma unroll
        for (int ti = 0; ti < NTK; ++ti) { const int t = wave + 8 * ti; if (t >= T) break;
            const f32x4 x0 = *(const LAS f32x4*)(CO + t * 512 + 8 * lane), x1 = *(const LAS f32x4*)(CO + t * 512 + 8 * lane + 4);
            const float mean = wave_sum((x0.x + x0.y) + (x0.z + x0.w) + (x1.x + x1.y) + (x1.z + x1.w)) * (1.f / 512.f);
            const f32x4 d0 = x0 - mean, d1 = x1 - mean;
            const float var = wave_sum((d0.x * d0.x + d0.y * d0.y) + (d0.z * d0.z + d0.w * d0.w) + (d1.x * d1.x + d1.y * d1.y) + (d1.z * d1.z + d1.w * d1.w)) * (1.f / 512.f);
            const float rstd = 1.0f / sqrtf(var + EPS);
            const f32x4 y0 = d0 * rstd * g0 + b0, y1 = d1 * rstd * g1 + b1;
            const size_t row = (size_t)rowbase + t;
            const u32x4 gt = gts[ti];
            u32x4 w;
            w.x = pk2(siluf_(y0.x) * siluf_(bflo(gt.x)), siluf_(y0.y) * siluf_(bfhi(gt.x))); w.y = pk2(siluf_(y0.z) * siluf_(bflo(gt.y)), siluf_(y0.w) * siluf_(bfhi(gt.y)));
            w.z = pk2(siluf_(y1.x) * siluf_(bflo(gt.z)), siluf_(y1.y) * siluf_(bfhi(gt.z))); w.w = pk2(siluf_(y1.z) * siluf_(bflo(gt.w)), siluf_(y1.w) * siluf_(bfhi(gt.w)));
            *(u32x4*)(br + row * BR_LD + 512 + 8 * lane) = w;
        }
    }
}

constexpr int KS_STRIDE = 272, VT_STRIDE = 528, VT_OFF = 256 * KS_STRIDE;
template <bool SAMPLE>
__device__ __forceinline__ void attn_task(const Params& p, int layer, LAS unsigned char* lds, int task, int tid, int wave, int lane) {
    unsigned char* ws = p.ws;
    const bf16_t* proj = (const bf16_t*)(ws + WS_PROJ); bf16_t* br = (bf16_t*)(ws + WS_BR);
    int b = 0, head, qc = 0, seq = 0;
    if (SAMPLE) { seq = task >> 2; head = task & 3; } else { b = task >> 5; head = (task >> 3) & 3; qc = task & 7; }
    constexpr int NWT = SAMPLE ? 1 : 2;
    const int h4 = lane >> 4, c = lane & 15;
    const int nvalid = SAMPLE ? 8 : 16, cr = c < nvalid ? c : nvalid - 1;
    bf16x8 qfa[NWT][4]; u32x2 gta[NWT][8];
#pragma unroll
    for (int wi = 0; wi < NWT; ++wi) { const int qrow0 = SAMPLE ? (MP + seq * 8) : (b * SEQ + qc * 256 + (wave + 8 * wi) * 16);
        const bf16_t* qrow = proj + (size_t)(qrow0 + cr) * NCOL + C_Q + head * 128 + 8 * h4;
#pragma unroll
        for (int ks = 0; ks < 4; ++ks) qfa[wi][ks] = *(const bf16x8*)(qrow + 32 * ks);
#pragma unroll
        for (int nd = 0; nd < 8; ++nd) gta[wi][nd] = *(const u32x2*)(proj + (size_t)(qrow0 + cr) * NCOL + C_XGATE + head * 128 + 16 * nd + 4 * h4); }
    __syncthreads();
    if (SAMPLE) {
        const float* kb = p.in[I_CK] + (((size_t)layer * NSEQ + seq) * 256) * 512 + head * 128; const float* vb = p.in[I_CV] + (((size_t)layer * NSEQ + seq) * 256) * 512 + head * 128;
        f32x4 ka[8], kc[8], vv[2][8];
        const int d4 = 8 * (wave & 3) + (lane >> 3);
#pragma unroll
        for (int i = 0; i < 8; ++i) { const int c = tid + NTHREADS * i, key = c >> 4, dc = c & 15; const float* src = kb + (size_t)key * 512 + dc * 8; ka[i] = *(const f32x4*)src; kc[i] = *(const f32x4*)(src + 4); }
#pragma unroll
        for (int i = 0; i < 2; ++i) { const int ch = (lane & 7) + 8 * (wave >> 2) + 16 * i; const float* src = vb + (size_t)(8 * ch) * 512 + 4 * d4;
#pragma unroll
            for (int j = 0; j < 8; ++j) vv[i][j] = *(const f32x4*)(src + (size_t)j * 512); }
#pragma unroll
        for (int i = 0; i < 8; ++i) { const int c = tid + NTHREADS * i, key = c >> 4, dc = c & 15;
            u32x4 w; w.x = pk2(ka[i].x, ka[i].y); w.y = pk2(ka[i].z, ka[i].w); w.z = pk2(kc[i].x, kc[i].y); w.w = pk2(kc[i].z, kc[i].w);
            *(LAS u32x4*)(lds + key * KS_STRIDE + dc * 16) = w; }
#pragma unroll
        for (int i = 0; i < 2; ++i) { const int ch = (lane & 7) + 8 * (wave >> 2) + 16 * i;
#pragma unroll
            for (int q4 = 0; q4 < 4; ++q4) { u32x4 w; w.x = pk2(vv[i][0][q4], vv[i][1][q4]); w.y = pk2(vv[i][2][q4], vv[i][3][q4]); w.z = pk2(vv[i][4][q4], vv[i][5][q4]); w.w = pk2(vv[i][6][q4], vv[i][7][q4]);
                *(LAS u32x4*)(lds + VT_OFF + (4 * d4 + q4) * VT_STRIDE + ch * 16) = w; } }
    } else {
        const bf16_t* kb = (const bf16_t*)(ws + WS_KVB) + ((size_t)layer * 2048 + b * 256) * 512 + head * 128;
        const bf16_t* vt = (const bf16_t*)(ws + WS_KVB) + (size_t)2 * 2048 * 512 + ((size_t)layer * 512 + head * 128) * 2048 + b * 256;
        u32x4 kw[8], vw[8];
#pragma unroll
        for (int i = 0; i < 8; ++i) { const int c = tid + NTHREADS * i; kw[i] = *(const u32x4*)(kb + (size_t)(c >> 4) * 512 + (c & 15) * 8); vw[i] = *(const u32x4*)(vt + (size_t)(c >> 5) * 2048 + (c & 31) * 8); }
#pragma unroll
        for (int i = 0; i < 8; ++i) { const int c = tid + NTHREADS * i;
            *(LAS u32x4*)(lds + (c >> 4) * KS_STRIDE + (c & 15) * 16) = kw[i]; *(LAS u32x4*)(lds + VT_OFF + (c >> 5) * VT_STRIDE + (c & 31) * 16) = vw[i]; }
    }
    __syncthreads();
#pragma unroll
    for (int wi = 0; wi < NWT; ++wi) {
        if (SAMPLE && wave != 0) break;
        const int qrow0 = SAMPLE ? (MP + seq * 8) : (b * SEQ + qc * 256 + (wave + 8 * wi) * 16);
        bf16x8 qf[4]; u32x2 gt[8];
#pragma unroll
        for (int ks = 0; ks < 4; ++ks) qf[ks] = qfa[wi][ks];
#pragma unroll
        for (int nd = 0; nd < 8; ++nd) gt[nd] = gta[wi][nd];
        f32x4 s[16];
#pragma unroll
        for (int nb = 0; nb < 16; ++nb) {
            s[nb] = (f32x4){0.f, 0.f, 0.f, 0.f};
            const int keyrow = 32 * (nb >> 1) + 8 * (c >> 2) + 4 * (nb & 1) + (c & 3);
#pragma unroll
            for (int ks = 0; ks < 4; ++ks) { const bf16x8 kf = *(const LAS bf16x8*)(lds + keyrow * KS_STRIDE + (32 * ks + 8 * h4) * 2);
                s[nb] = __builtin_amdgcn_mfma_f32_16x16x32_bf16(kf, qf[ks], s[nb], 0, 0, 0); }
            if (nb & 1) asm volatile("" ::: "memory");
        }
        float mx = -3.0e38f;
#pragma unroll
        for (int nb = 0; nb < 16; ++nb) mx = fmaxf(fmaxf(fmaxf(s[nb][0], s[nb][1]), fmaxf(s[nb][2], s[nb][3])), mx);
        mx = fmaxf(mx, __shfl_xor(mx, 16)); mx = fmaxf(mx, __shfl_xor(mx, 32));
        const float sc = 0.08838834764831845f * 1.4426950408889634f;
        float sum = 0.f;
#pragma unroll
        for (int nb = 0; nb < 16; ++nb)
#pragma unroll
            for (int i = 0; i < 4; ++i) { const float e = __builtin_amdgcn_exp2f((s[nb][i] - mx) * sc); s[nb][i] = e; sum += e; }
        sum += __shfl_xor(sum, 16); sum += __shfl_xor(sum, 32);
        const float inv = 1.0f / sum;
        bf16x8 pf[8];
#pragma unroll
        for (int si = 0; si < 8; ++si) { u32x4 w; w.x = pk2(s[2 * si][0], s[2 * si][1]); w.y = pk2(s[2 * si][2], s[2 * si][3]); w.z = pk2(s[2 * si + 1][0], s[2 * si + 1][1]); w.w = pk2(s[2 * si + 1][2], s[2 * si + 1][3]);
            pf[si] = __builtin_bit_cast(bf16x8, w); }
#pragma unroll
        for (int nd = 0; nd < 8; ++nd) {
            f32x4 o = (f32x4){0.f, 0.f, 0.f, 0.f};
#pragma unroll
            for (int si = 0; si < 8; ++si) { const bf16x8 vf = *(const LAS bf16x8*)(lds + VT_OFF + (16 * nd + c) * VT_STRIDE + (32 * si + 8 * h4) * 2);
                o = __builtin_amdgcn_mfma_f32_16x16x32_bf16(vf, pf[si], o, 0, 0, 0); }
            if (c < nvalid) { const size_t row = (size_t)qrow0 + c; const int col = head * 128 + 16 * nd + 4 * h4;
                const u32x2 g2 = gt[nd];
                u32x2 w; w.x = pk2(o[0] * inv * siluf_(bflo(g2.x)), o[1] * inv * siluf_(bfhi(g2.x))); w.y = pk2(o[2] * inv * siluf_(bflo(g2.y)), o[3] * inv * siluf_(bfhi(g2.y)));
                *(u32x2*)(br + row * BR_LD + 1024 + col) = w; }
            asm volatile("" ::: "memory");
        }
    }
}


constexpr int SM_STRIDE = 1040, SM_BOFF = 64 * SM_STRIDE;
__device__ __forceinline__ void sm_issue(const bf16_t* A, int lda, const bf16_t* Bt, int ldb, int tid, u32x4 (&va)[8], u32x4 (&vb)[8]) {
#pragma unroll
    for (int i = 0; i < 8; ++i) { const int c = tid + NTHREADS * i, row = c >> 6, ch = c & 63;
        va[i] = *(const u32x4*)(A + (size_t)row * lda + ch * 8); vb[i] = *(const u32x4*)(Bt + (size_t)row * ldb + ch * 8); }
}
__device__ __forceinline__ void sm_write(LAS unsigned char* lds, int tid, const u32x4 (&va)[8], const u32x4 (&vb)[8]) {
#pragma unroll
    for (int i = 0; i < 8; ++i) { const int c = tid + NTHREADS * i, row = c >> 6, ch = c & 63;
        *(LAS u32x4*)(lds + row * SM_STRIDE + ch * 16) = va[i]; *(LAS u32x4*)(lds + SM_BOFF + row * SM_STRIDE + ch * 16) = vb[i]; }
}
__device__ __forceinline__ void sm_mma(LAS unsigned char* lds, int wr, int wc, int lane, f32x4 (&acc)[2]) {
    const int h4 = lane >> 4, r = lane & 15;
    LAS unsigned char* ap = lds + (16 * wr + r) * SM_STRIDE + 16 * h4; LAS unsigned char* bp = lds + SM_BOFF + (32 * wc + r) * SM_STRIDE + 16 * h4;
#pragma unroll
    for (int ks = 0; ks < 16; ++ks) { const bf16x8 af = *(const LAS bf16x8*)(ap + 64 * ks), w0 = *(const LAS bf16x8*)(bp + 64 * ks), w1 = *(const LAS bf16x8*)(bp + 16 * SM_STRIDE + 64 * ks);
        acc[0] = __builtin_amdgcn_mfma_f32_16x16x32_bf16(w0, af, acc[0], 0, 0, 0); acc[1] = __builtin_amdgcn_mfma_f32_16x16x32_bf16(w1, af, acc[1], 0, 0, 0);
        if ((ks & 3) == 3) asm volatile("" ::: "memory"); }
}
__device__ __forceinline__ void p3_small(const Params& p, int layer, LAS unsigned char* lds, int task, int tid, int wave, int lane) {
    unsigned char* ws = p.ws; const bf16_t* proj = (const bf16_t*)(ws + WS_PROJ);
    const int rt = task >> 4, ct = task & 15, wr = wave >> 1, wc = wave & 1, h4 = lane >> 4, c = lane & 15;
    const int row = MP + 64 * rt + 16 * wr + c, col0 = 64 * ct + 32 * wc + 4 * h4;
    const bf16_t* A0 = (const bf16_t*)(ws + WS_BR) + (size_t)(MP + 64 * rt) * BR_LD; const bf16_t* B0 = (const bf16_t*)(ws + WS_WBR) + ((size_t)(layer * 3) * D + 64 * ct) * 512;
    u32x4 va[8], vb[8];
    sm_issue(A0, BR_LD, B0, 512, tid, va, vb);
    f32x4 mg[2] = {(f32x4){0.f, 0.f, 0.f, 0.f}, (f32x4){0.f, 0.f, 0.f, 0.f}};
#pragma unroll 1
    for (int z = 0; z < 3; ++z) {
        __syncthreads();
        sm_write(lds, tid, va, vb);
        __syncthreads();
        if (z < 2) sm_issue(A0 + (z + 1) * 512, BR_LD, B0 + (size_t)(z + 1) * D * 512, 512, tid, va, vb);
        u32x2 lg[2];
#pragma unroll
        for (int n = 0; n < 2; ++n) lg[n] = *(const u32x2*)(proj + (size_t)row * NCOL + C_LOGIT + z * D + col0 + 16 * n);
        f32x4 acc[2] = {(f32x4){0.f, 0.f, 0.f, 0.f}, (f32x4){0.f, 0.f, 0.f, 0.f}};
        sm_mma(lds, wr, wc, lane, acc);
#pragma unroll
        for (int n = 0; n < 2; ++n) { mg[n][0] += acc[n][0] * sigmoidf_(bflo(lg[n].x)); mg[n][1] += acc[n][1] * sigmoidf_(bfhi(lg[n].x)); mg[n][2] += acc[n][2] * sigmoidf_(bflo(lg[n].y)); mg[n][3] += acc[n][3] * sigmoidf_(bfhi(lg[n].y)); }
    }
#pragma unroll
    for (int n = 0; n < 2; ++n) { u32x2 w; w.x = pk2(mg[n][0], mg[n][1]); w.y = pk2(mg[n][2], mg[n][3]); *(u32x2*)((bf16_t*)(ws + WS_MRG) + (size_t)row * D + col0 + 16 * n) = w; }
}
__device__ __forceinline__ void p4_small(const Params& p, int layer, LAS unsigned char* lds, int task, int tid, int wave, int lane) {
    unsigned char* ws = p.ws;
    const int rt = task >> 4, ct = task & 15, wr = wave >> 1, wc = wave & 1, h4 = lane >> 4, c = lane & 15;
    const int row = MP + 64 * rt + 16 * wr + c, col0 = 64 * ct + 32 * wc + 4 * h4;
    const bf16_t* A0 = (const bf16_t*)(ws + WS_MRG) + (size_t)(MP + 64 * rt) * D; const bf16_t* B0 = (const bf16_t*)(ws + WS_WOUT) + ((size_t)layer * D + 64 * ct) * D;
    u32x4 va[8], vb[8];
    sm_issue(A0, D, B0, D, tid, va, vb);
    f32x4 acc[2] = {(f32x4){0.f, 0.f, 0.f, 0.f}, (f32x4){0.f, 0.f, 0.f, 0.f}};
#pragma unroll 1
    for (int seg = 0; seg < 2; ++seg) {
        __syncthreads();
        sm_write(lds, tid, va, vb);
        __syncthreads();
        if (seg < 1) sm_issue(A0 + 512, D, B0 + 512, D, tid, va, vb);
        sm_mma(lds, wr, wc, lane, acc);
    }
    float s = 0.f;
#pragma unroll
    for (int n = 0; n < 2; ++n) { const f32x4 v = acc[n]; s += (v[0] * v[0] + v[1] * v[1]) + (v[2] * v[2] + v[3] * v[3]);
        u32x2 w; w.x = pk2(v[0], v[1]); w.y = pk2(v[2], v[3]); *(u32x2*)((bf16_t*)(ws + WS_Y) + (size_t)row * D + col0 + 16 * n) = w; }
    s += __shfl_xor(s, 16); s += __shfl_xor(s, 32);
    LAS float* red = (LAS float*)lds;
    __syncthreads();
    if (h4 == 0) red[(16 * wr + c) * 2 + wc] = s;
    __syncthreads();
    if (tid < 64) ((float*)(ws + WS_SSQ))[(size_t)(MP + 64 * rt + tid) * 16 + ct] = red[tid * 2] + red[tid * 2 + 1];
}

__device__ __forceinline__ void stagger_start(int bx, unsigned ticks) {
    const unsigned long long t0 = __builtin_amdgcn_s_memrealtime(); const unsigned long long w = (unsigned long long)(((unsigned)bx >> 3) & 3u) * ticks;
    while (__builtin_amdgcn_s_memrealtime() - t0 < w) __builtin_amdgcn_s_sleep(16);
}
constexpr unsigned STAG1 = 0, STAG3 = 0;

__global__ void __launch_bounds__(NTHREADS, 2) mk_fwd(Params p) {
    extern __shared__ __attribute__((aligned(16))) unsigned char lds_raw[];
    LAS unsigned char* lds = (LAS unsigned char*)lds_raw;
    cg::grid_group grid = cg::this_grid();
    const int G = gridDim.x;
    const int NGW = G * 8;
    const int wid0 = __builtin_amdgcn_readfirstlane(threadIdx.x >> 6);
    auto tidnow = [&]() -> int { unsigned z_ = 0u; asm volatile("" : "+v"(z_)); return wid0 * 64 + (int)__builtin_amdgcn_mbcnt_hi(~0u, __builtin_amdgcn_mbcnt_lo(~0u, z_)); };
#define TIDNOW() tidnow()
#define PQ() unsigned long long ka_ = (unsigned long long)__builtin_amdgcn_kernarg_segment_ptr(); asm volatile("" : "+s"(ka_)); \
    const __attribute__((address_space(4))) Params* kp_ = (const __attribute__((address_space(4))) Params*)ka_; Params q; \
    int bxq = blockIdx.x; asm volatile("" : "+s"(bxq)); \
    _Pragma("unroll") for (int i_ = 0; i_ < 20; ++i_) q.in[i_] = kp_->in[i_]; q.out = kp_->out; q.ws = kp_->ws; q.ph_lo = 0; q.ph_hi = 0; q.use_cg = 0; q.pad = 0
#define IDS() int tid = TIDNOW(); asm volatile("" : "+v"(tid)); const int bx = bxq, lane = tid & 63, wave = __builtin_amdgcn_readfirstlane(tid >> 6), gw = ((G % 8 == 0) ? (bx % 8) * (G / 8) + bx / 8 : bx) * 8 + wave; (void)gw; (void)lane; (void)bx
    unsigned char* ws = p.ws;
    const int lo = p.ph_lo, hi = p.ph_hi;
#define IN(k) (lo <= (k) && (k) < hi)
    { const int t0_ = TIDNOW(); if (t0_ < 4) ((LAS unsigned*)(lds + LDS_BAR_OFF))[t0_] = 0u; }
    __syncthreads();
    XcdBarrier xbar; xbar.bar = (unsigned*)(ws + WS_BAR); xbar.x = 0; xbar.st = (volatile LAS unsigned*)(lds + LDS_BAR_OFF);
    if (hi - lo > 1) xbar = xcd_barrier_post((unsigned*)(ws + WS_BAR), (volatile LAS unsigned*)(lds + LDS_BAR_OFF), TIDNOW() == 0);
#define SEAM(k) do { if (IN(k) && IN((k) + 1)) { if (p.use_cg) grid.sync(); else xcd_barrier(xbar, TIDNOW() == 0); } } while (0)

    if (IN(0)) for (int rep = 0; rep < REP0; ++rep) { PQ(); IDS(); p0_prologue(q, lds, gw, NGW, wave, lane); }
    SEAM(0);
#pragma unroll 1
    for (int layer = 0; layer < 2; ++layer) {
        const int pb = 1 + 5 * layer;
        if (IN(pb)) for (int rep = 0; rep < REP1; ++rep) {
            PQ(); unsigned char* const ws = q.ws;
            if (STAG1) stagger_start(bxq, STAG1);
            { pg8::Gemm g{(const bf16_t*)(ws + WS_H), (const bf16_t*)(ws + WS_WIN) + (size_t)layer * NCOL * D, D, D, D, 0, 0};
              pg8::Order S; S.init(MT, NCOL, 1, 0, G, bxq);
              pg8::EpiStoreBf16 E{(bf16_t*)(ws + WS_PROJ), NCOL};
              pg8::gemm_phase<pg8::EpiStoreBf16>(lds, g, S, E, TIDNOW()); }
            if (layer == 0) {
              { pg8::Gemm g{(const bf16_t*)(ws + WS_MEMN), (const bf16_t*)(ws + WS_WKV), D, D, D, 2048u * D * 2u, (unsigned)D * D * 2u};
                pg8::Order S; S.init(2048, 512, 2, 0, G, G - 1 - bxq);
                pg8::EpiK E{q.out + O_MK, (bf16_t*)(ws + WS_KVB)};
                pg8::gemm_phase<pg8::EpiK>(lds, g, S, E, TIDNOW()); }
              { pg8::Gemm g{(const bf16_t*)(ws + WS_WKV) + (size_t)512 * D, (const bf16_t*)(ws + WS_MEMN), D, D, D, (unsigned)D * D * 2u, 2048u * D * 2u};
                int cv = G - 33 - bxq; if (cv < 0) cv += G;
                pg8::Order S; S.init(512, 2048, 2, 0, G, cv);
                pg8::EpiVt E{q.out + O_MV, (bf16_t*)(ws + WS_KVB) + (size_t)2 * 2048 * 512};
                pg8::gemm_phase<pg8::EpiVt>(lds, g, S, E, TIDNOW()); }
            }
        }
        SEAM(pb);
        if (IN(pb + 1)) for (int rep = 0; rep < REP2; ++rep) {
            PQ(); IDS();
            const bool stream_first = ((bx >> 3) & 1) != 0;
            if (stream_first) { for (int t = bx; t < 512; t += G) attn_task<true>(q, layer, lds, t, tid, wave, lane); }
            for (int r2 = 0; r2 < R2A; ++r2) for (int t = bx; t < 512; t += G) pool_task<32, false>(q, layer, lds, t, tid, wave, lane);
            for (int r2 = 0; r2 < R2B; ++r2) for (int t = bx; t < 512; t += G) conv_task<32, false>(q, layer, lds, t, tid, wave, lane);
            for (int r2 = 0; r2 < R2C; ++r2) for (int t = bx; t < 256; t += G) { if (t < 128) pool_task<8, true>(q, layer, lds, t, tid, wave, lane); else conv_task<8, true>(q, layer, lds, t - 128, tid, wave, lane); }
            for (int r2 = 0; r2 < R2D; ++r2) for (int t = bx; t < 256; t += G) attn_task<false>(q, layer, lds, t, tid, wave, lane);
            if (!stream_first) { for (int r2 = 0; r2 < R2E; ++r2) for (int t = bx; t < 512; t += G) attn_task<true>(q, layer, lds, t, tid, wave, lane); }
        }
        SEAM(pb + 1);
        if (IN(pb + 2)) for (int rep = 0; rep < REP3; ++rep) {
            PQ(); unsigned char* const ws = q.ws;
            if (STAG3) stagger_start(bxq, STAG3);
            pg8::Gemm g{(const bf16_t*)(ws + WS_BR), (const bf16_t*)(ws + WS_WBR) + (size_t)layer * 3 * D * 512, 512, BR_LD, 512, 512u * 2u, (unsigned)D * 512u * 2u};
            pg8::Order S; S.init(MP, D, 3, 1, G, bxq);
            pg8::EpiMerge E{(const bf16_t*)(ws + WS_PROJ), (bf16_t*)(ws + WS_MRG)};
            const bool small_first = ((bxq >> 3) & 1) != 0;
            if (small_first) { IDS(); for (int r3 = 0; r3 < RSM; ++r3) for (int t = bx; t < 256; t += G) p3_small(q, layer, lds, t, tid, wave, lane); __syncthreads(); }
            pg8::gemm_phase<pg8::EpiMerge>(lds, g, S, E, TIDNOW());
            if (!small_first) { IDS(); for (int r3 = 0; r3 < RSM; ++r3) for (int t = bx; t < 256; t += G) p3_small(q, layer, lds, t, tid, wave, lane); }
        }
        SEAM(pb + 2);
        if (IN(pb + 3)) for (int rep = 0; rep < REP4; ++rep) {
            PQ(); unsigned char* const ws = q.ws;
            pg8::Gemm g{(const bf16_t*)(ws + WS_MRG), (const bf16_t*)(ws + WS_WOUT) + (size_t)layer * D * D, D, D, D, 0, 0};
            pg8::Order S; S.init(MP, D, 1, 0, G, bxq);
            pg8::EpiY E{(bf16_t*)(ws + WS_Y), (float*)(ws + WS_SSQ)};
            pg8::gemm_phase<pg8::EpiY>(lds, g, S, E, TIDNOW());
            { IDS(); for (int r3 = 0; r3 < RSM; ++r3) for (int t = bx; t < 256; t += G) p4_small(q, layer, lds, t, tid, wave, lane); }
        }
        SEAM(pb + 3);
        if (IN(pb + 4)) for (int rep = 0; rep < (layer == 0 ? REP5 : 1); ++rep) { PQ(); IDS(); p5_residual(q, layer, gw, NGW, lane); }
        if (layer == 0) SEAM(pb + 4);
    }
#undef IN
#undef SEAM
#undef IDS
#undef PQ
#undef TIDNOW
}

extern "C" void kernel_launch(void* const* d_in, const int* in_sizes, int n_in, void* d_out, int out_size, void* d_ws, size_t ws_size, hipStream_t stream) {
    static int grid = 0;
    if (grid == 0) {
        if (n_in != 20 || ws_size < WS_END) { fprintf(stderr, "kernel_launch: expected 20 inputs and >= %zu bytes of workspace (got %d, %zu)\n", (size_t)WS_END, n_in, ws_size); grid = -1; return; }
        int dev = 0, cus = 0, per_cu = 0;
        if (hipGetDevice(&dev) != hipSuccess || hipDeviceGetAttribute(&cus, hipDeviceAttributeMultiprocessorCount, dev) != hipSuccess) { grid = -1; return; }
        if (hipFuncSetAttribute((const void*)mk_fwd, hipFuncAttributeMaxDynamicSharedMemorySize, LDS_BYTES) != hipSuccess) { fprintf(stderr, "kernel_launch: hipFuncSetAttribute failed\n"); grid = -1; return; }
        if (hipOccupancyMaxActiveBlocksPerMultiprocessor(&per_cu, (const void*)mk_fwd, NTHREADS, LDS_BYTES) != hipSuccess || per_cu < 1) { fprintf(stderr, "kernel_launch: occupancy query says %d blocks per CU\n", per_cu); (void)hipGetLastError(); per_cu = 1; }
        grid = cus;
    }
    if (grid < 0) return;
    Params p{};
    for (int i = 0; i < 20; ++i) p.in[i] = (const float*)d_in[i];
    p.out = (float*)d_out; p.ws = (unsigned char*)d_ws;
#if MK_LAUNCHES == 1
    p.ph_lo = 0; p.ph_hi = NPHASES;
    if (hipMemsetAsync((char*)d_ws + WS_BAR, 0, XCD_BAR_WORDS * 4, stream) != hipSuccess) { fprintf(stderr, "kernel_launch: memset of the barrier words failed\n"); return; }
    void* args[] = {&p};
    hipError_t e = hipLaunchCooperativeKernel((const void*)mk_fwd, dim3(grid), dim3(NTHREADS), args, LDS_BYTES, stream);
    if (e != hipSuccess) fprintf(stderr, "cooperative launch failed: %s (grid %d)\n", hipGetErrorString(e), grid);
#else
    for (int k = 0; k < NPHASES; ++k) { p.ph_lo = k; p.ph_hi = k + 1; hipLaunchKernelGGL(mk_fwd, dim3(grid), dim3(NTHREADS), LDS_BYTES, stream, p); }
#endif
}
```

```cpp
#include <hip/hip_runtime.h>
#include <hip/hip_cooperative_groups.h>
#include <cstdio>
#include <cstdint>
namespace cg = cooperative_groups;

#define LAS __attribute__((address_space(3)))
typedef unsigned short bf16_t;
typedef short bf16x8 __attribute__((ext_vector_type(8)));
typedef float f32x4 __attribute__((ext_vector_type(4)));
typedef float f32x2 __attribute__((ext_vector_type(2)));
typedef unsigned u32x4 __attribute__((ext_vector_type(4)));
typedef unsigned u32x2 __attribute__((ext_vector_type(2)));

constexpr int D = 1024, NCOL = 6656, MP = 16384, MS = 1024, MT = MP + MS, SEQ = 2048, NSEQ = 128;
constexpr int C_PGATE = 512, C_CVAL = 1024, C_CGLU = 1536, C_CGATE = 2048, C_Q = 2560, C_XGATE = 3072, C_LOGIT = 3584;
constexpr int BR_LD = 1536;
constexpr float EPS = 1e-6f;
constexpr size_t O_POOLP = 17825792, O_CONVP = 17948672, O_MK = 18194432, O_MV = 20291584, O_POOLS = 22388736, O_CONVS = 24354816;
constexpr size_t WS_WIN = 0;
constexpr size_t WS_WKV = WS_WIN + (size_t)2 * NCOL * D * 2;
constexpr size_t WS_WBR = WS_WKV + (size_t)2 * D * D * 2;
constexpr size_t WS_WOUT = WS_WBR + (size_t)6 * D * 512 * 2;
constexpr size_t WS_WPOOL = WS_WOUT + (size_t)2 * D * D * 2;
constexpr size_t WS_H = WS_WPOOL + (size_t)8 * 128 * 128 * 2;
constexpr size_t WS_MEMN = WS_H + (size_t)MT * D * 2;
constexpr size_t WS_PROJ = WS_MEMN + (size_t)2 * 2048 * D * 2;
constexpr size_t WS_KVB = WS_PROJ + (size_t)MT * NCOL * 2;
constexpr size_t WS_BR = WS_KVB + (size_t)2 * 2048 * D * 2;
constexpr size_t WS_MRG = WS_BR + (size_t)MT * BR_LD * 2;
constexpr size_t WS_Y = WS_MRG + (size_t)MT * D * 2;
constexpr size_t WS_SSQ = WS_Y + (size_t)MT * D * 2;
constexpr size_t WS_X1 = WS_SSQ + (size_t)MT * 16 * 4;
constexpr size_t WS_BAR = WS_X1 + (size_t)MT * D * 2;
constexpr size_t WS_END = WS_BAR + 3456 * 4;
constexpr int LDS_BAR_OFF = 140 * 1024 - 16;
constexpr int LDS_BYTES = 140 * 1024;
constexpr int NTHREADS = 512;

#ifndef MK_LAUNCHES
#define MK_LAUNCHES 1
#endif
constexpr int NPHASES = 11;
constexpr int R2A = 1, R2B = 1, R2C = 1, R2D = 1, R2E = 1;
constexpr int RSM = 1;
constexpr int REP0 = 1, REP1 = 1, REP2 = 1, REP3 = 1, REP4 = 1, REP5 = 1;

__device__ __forceinline__ unsigned pk2(float lo, float hi) { unsigned r; asm("v_cvt_pk_bf16_f32 %0, %1, %2" : "=v"(r) : "v"(lo), "v"(hi)); return r; }
__device__ __forceinline__ float bflo(unsigned w) { return __uint_as_float(w << 16); }
__device__ __forceinline__ float bfhi(unsigned w) { return __uint_as_float(w & 0xffff0000u); }
__device__ __forceinline__ float bf1(bf16_t b) { return __uint_as_float(((unsigned)b) << 16); }
__device__ __forceinline__ float sigmoidf_(float x) { return __builtin_amdgcn_rcpf(1.0f + __builtin_amdgcn_exp2f(-1.4426950408889634f * x)); }
__device__ __forceinline__ float siluf_(float x) { return x * sigmoidf_(x); }
__device__ __forceinline__ float wave_sum(float v) {
#pragma unroll
    for (int o = 1; o < 64; o <<= 1) v += __shfl_xor(v, o);
    return v;
}
#define LDS_WAIT() asm volatile("s_waitcnt lgkmcnt(0)" ::: "memory")

namespace pg8 {
constexpr int BM = 256, BK = 64, HALF = 128, HTB = HALF * BK * 2, STAGE_BYTES = 8 * HTB, NXCD = 8, WGM = 8;
__host__ __device__ __forceinline__ int lds_byte(int r, int c) { const int st = (r >> 4) * 2 + (c >> 5), rr = r & 15, cc = c & 31, ob = rr * 64 + cc * 2; return st * 1024 + (ob ^ (((ob >> 9) & 1) << 5)); }
__host__ __device__ __forceinline__ void stage_rc(int b, int& R, int& C) { const int st = b / 1024, sb = b % 1024, swz = sb ^ (((sb >> 9) & 1) << 5); R = (st >> 1) * 16 + swz / 64; C = (st & 1) * 32 + (swz % 64) / 2; }
__host__ __device__ __forceinline__ int perm32(int rho) { const int n = rho >> 4, i = rho & 15; return 8 * (i >> 2) + 4 * n + (i & 3); }

struct Unit { int pm, pn, z; };
struct Gemm { const bf16_t* A; const bf16_t* Bt; int K, lda, ldb; unsigned zA, zB; };

struct Order {
    int nM, nN, ntile, nz, zinner, G, c;
    __device__ void init(int M, int N, int nz_, int zinner_, int G_, int c_) { nM = M / BM; nN = N / BM; ntile = nM * nN; nz = nz_; zinner = zinner_; G = G_; c = c_; }
    __device__ bool next(int i, Unit& u) const {
        int tix, z;
        if (zinner) { tix = (i / nz) * G + c; z = i % nz; if (tix >= ntile) return false; }
        else { const long L = (long)i * G + c; if (L >= (long)ntile * nz) return false; z = (int)(L / ntile); tix = (int)(L % ntile); }
        int wgid = tix; { const int q = ntile / NXCD, r = ntile % NXCD, xcd = wgid % NXCD, off = wgid / NXCD; wgid = (xcd < r ? xcd * (q + 1) : r * (q + 1) + (xcd - r) * q) + off; }
        const int nig = WGM * nN, gid = wgid / nig, fm = gid * WGM, gsz = (nM - fm) < WGM ? (nM - fm) : WGM;
        u.pm = fm + ((wgid % nig) % gsz); u.pn = (wgid % nig) / gsz; u.z = z; return true;
    }
};

struct EpiStoreBf16 {
    static constexpr bool PERM = true;
    bf16_t* O; int ldc;
    __device__ __forceinline__ void operator()(const f32x4 (&acc)[2][2][4][2], const Unit& u, int wr, int wc, int fr, int fq) const {
        const int row0 = u.pm * BM + wr * 64 + fr, col0 = u.pn * BM + wc * 32 + 8 * fq;
#pragma unroll
        for (int ai = 0; ai < 2; ++ai)
#pragma unroll
            for (int m = 0; m < 4; ++m) { bf16_t* rowp = O + (size_t)(row0 + ai * HALF + m * 16) * ldc + col0;
#pragma unroll
                for (int bj = 0; bj < 2; ++bj) { const f32x4 v0 = acc[ai][bj][m][0], v1 = acc[ai][bj][m][1];
                    u32x4 w; w.x = pk2(v0[0], v0[1]); w.y = pk2(v0[2], v0[3]); w.z = pk2(v1[0], v1[1]); w.w = pk2(v1[2], v1[3]);
                    *(u32x4*)(rowp + bj * HALF) = w; } }
    }
};
struct EpiK {
    static constexpr bool PERM = false;
    float* outK; bf16_t* kb;
    __device__ __forceinline__ void operator()(const f32x4 (&acc)[2][2][4][2], const Unit& u, int wr, int wc, int fr, int fq) const {
        const int row0 = u.pm * BM + wr * 64 + fr, col0 = u.pn * BM + wc * 32 + 4 * fq;
        float* of = outK + (size_t)u.z * 2048 * 512; bf16_t* ob = kb + (size_t)u.z * 2048 * 512;
#pragma unroll
        for (int ai = 0; ai < 2; ++ai)
#pragma unroll
            for (int m = 0; m < 4; ++m) { const int r = row0 + ai * HALF + m * 16;
#pragma unroll
                for (int bj = 0; bj < 2; ++bj)
#pragma unroll
                    for (int n = 0; n < 2; ++n) { const f32x4 v = acc[ai][bj][m][n]; const int c = col0 + bj * HALF + n * 16;
                        *(f32x4*)(of + (size_t)r * 512 + c) = v;
                        u32x2 w; w.x = pk2(v[0], v[1]); w.y = pk2(v[2], v[3]);
                        *(u32x2*)(ob + (size_t)r * 512 + c) = w; } }
    }
};
struct EpiVt {
    static constexpr bool PERM = true;
    float* outV; bf16_t* vt;
    __device__ __forceinline__ void operator()(const f32x4 (&acc)[2][2][4][2], const Unit& u, int wr, int wc, int fr, int fq) const {
        const int row0 = u.pm * BM + wr * 64 + fr, col0 = u.pn * BM + wc * 32 + 8 * fq;
        float* of = outV + (size_t)u.z * 2048 * 512; bf16_t* ob = vt + (size_t)u.z * 512 * 2048;
#pragma unroll
        for (int ai = 0; ai < 2; ++ai)
#pragma unroll
            for (int m = 0; m < 4; ++m) { const int r = row0 + ai * HALF + m * 16;
#pragma unroll
                for (int bj = 0; bj < 2; ++bj) { const f32x4 v0 = acc[ai][bj][m][0], v1 = acc[ai][bj][m][1]; const int c = col0 + bj * HALF;
                    u32x4 w; w.x = pk2(v0[0], v0[1]); w.y = pk2(v0[2], v0[3]); w.z = pk2(v1[0], v1[1]); w.w = pk2(v1[2], v1[3]);
                    *(u32x4*)(ob + (size_t)r * 2048 + c) = w;
#pragma unroll
                    for (int j = 0; j < 4; ++j) { of[(size_t)(c + j) * 512 + r] = v0[j]; of[(size_t)(c + 4 + j) * 512 + r] = v1[j]; } } }
    }
};
struct EpiMerge {
    static constexpr bool PERM = true;
    const bf16_t* proj; bf16_t* mrg;
    __device__ __forceinline__ void operator()(const f32x4 (&acc)[2][2][4][2], const Unit& u, int wr, int wc, int fr, int fq) const {
        const int row0 = u.pm * BM + wr * 64 + fr, col0 = u.pn * BM + wc * 32 + 8 * fq;
#pragma unroll
        for (int ai = 0; ai < 2; ++ai)
#pragma unroll
            for (int m = 0; m < 4; ++m) { const int r = row0 + ai * HALF + m * 16;
                const bf16_t* lg = proj + (size_t)r * NCOL + C_LOGIT + u.z * D + col0; bf16_t* mp = mrg + (size_t)r * D + col0;
#pragma unroll
                for (int bj = 0; bj < 2; ++bj) { const f32x4 v0 = acc[ai][bj][m][0], v1 = acc[ai][bj][m][1];
                    const u32x4 g = *(const u32x4*)(lg + bj * HALF);
                    float o[8];
                    o[0] = v0[0] * sigmoidf_(bflo(g.x)); o[1] = v0[1] * sigmoidf_(bfhi(g.x)); o[2] = v0[2] * sigmoidf_(bflo(g.y)); o[3] = v0[3] * sigmoidf_(bfhi(g.y));
                    o[4] = v1[0] * sigmoidf_(bflo(g.z)); o[5] = v1[1] * sigmoidf_(bfhi(g.z)); o[6] = v1[2] * sigmoidf_(bflo(g.w)); o[7] = v1[3] * sigmoidf_(bfhi(g.w));
                    if (u.z != 0) { const u32x4 p = *(const u32x4*)(mp + bj * HALF);
                        o[0] += bflo(p.x); o[1] += bfhi(p.x); o[2] += bflo(p.y); o[3] += bfhi(p.y); o[4] += bflo(p.z); o[5] += bfhi(p.z); o[6] += bflo(p.w); o[7] += bfhi(p.w); }
                    u32x4 w; w.x = pk2(o[0], o[1]); w.y = pk2(o[2], o[3]); w.z = pk2(o[4], o[5]); w.w = pk2(o[6], o[7]);
                    *(u32x4*)(mp + bj * HALF) = w; }
                if (m == 3) asm volatile("" ::: "memory"); }
    }
};
struct EpiY {
    static constexpr bool PERM = true;
    bf16_t* Y; float* ssq;
    __device__ __forceinline__ void operator()(const f32x4 (&acc)[2][2][4][2], const Unit& u, int wr, int wc, int fr, int fq) const {
        const int row0 = u.pm * BM + wr * 64 + fr, col0 = u.pn * BM + wc * 32 + 8 * fq;
#pragma unroll
        for (int ai = 0; ai < 2; ++ai)
#pragma unroll
            for (int m = 0; m < 4; ++m) { const int r = row0 + ai * HALF + m * 16; bf16_t* rowp = Y + (size_t)r * D + col0; float s = 0.f;
#pragma unroll
                for (int bj = 0; bj < 2; ++bj) { const f32x4 v0 = acc[ai][bj][m][0], v1 = acc[ai][bj][m][1];
                    s += (v0[0] * v0[0] + v0[1] * v0[1]) + (v0[2] * v0[2] + v0[3] * v0[3]) + (v1[0] * v1[0] + v1[1] * v1[1]) + (v1[2] * v1[2] + v1[3] * v1[3]);
                    u32x4 w; w.x = pk2(v0[0], v0[1]); w.y = pk2(v0[2], v0[3]); w.z = pk2(v1[0], v1[1]); w.w = pk2(v1[2], v1[3]);
                    *(u32x4*)(rowp + bj * HALF) = w; }
                s += __shfl_xor(s, 16); s += __shfl_xor(s, 32);
                if (fq == 0) ssq[(size_t)r * 16 + u.pn * 4 + wc] = s; }
    }
};

template <class Epi>
__device__ __forceinline__ void gemm_phase(LAS unsigned char* lds, const Gemm g, const Order& S, const Epi& E, int tid_in) {
    int tid = tid_in; asm volatile("" : "+v"(tid));
    const int wid = __builtin_amdgcn_readfirstlane(tid >> 6), lane = tid & 63, wr = wid >> 2, wc = wid & 3, fr = lane & 15, fq = lane >> 4;
    const int K = g.K, nt = K / BK;
    unsigned voffA[2], voffB[2];
#pragma unroll
    for (int i = 0; i < 2; ++i) { int R, C; stage_rc(tid * 16 + i * 8192, R, C); const int Rb = Epi::PERM ? ((R & ~31) + perm32(R & 31)) : R;
        voffA[i] = (unsigned)(R * g.lda + C) * 2u; voffB[i] = (unsigned)(Rb * g.ldb + C) * 2u; }
    constexpr unsigned kstep = BK * 2;
    const unsigned hstepA = (unsigned)HALF * g.lda * 2, hstepB = (unsigned)HALF * g.ldb * 2;
    const unsigned tstepA = 2 * hstepA, tstepB = 2 * hstepB;
    const unsigned ldsw = (unsigned)wid * 1024u;
    const int aoff = lds_byte(wr * 64 + fr, fq * 8), boff = lds_byte(wc * 32 + fr, fq * 8);
#define PG8_SA(b, h) (((b) * 2 + (h)) * HTB)
#define PG8_SB(b, h) ((4 + (b) * 2 + (h)) * HTB)
#define PG8_STAGE(bufoff, gbase, voff) do { _Pragma("unroll") for (int _i = 0; _i < 2; ++_i) \
        __builtin_amdgcn_global_load_lds((const unsigned*)((const char*)(gbase) + (voff)[_i]), (LAS unsigned*)(lds + (bufoff) + ldsw + _i * 8192), 16, 0, 0); } while (0)
#define PG8_LDA(dst, b, h) do { _Pragma("unroll") for (int m = 0; m < 4; ++m) _Pragma("unroll") for (int k = 0; k < 2; ++k) dst[m][k] = *(const LAS bf16x8*)(lds + PG8_SA(b, h) + aoff + m * 2048 + k * 1024); } while (0)
#define PG8_LDB(dst, b, h) do { _Pragma("unroll") for (int n = 0; n < 2; ++n) _Pragma("unroll") for (int k = 0; k < 2; ++k) dst[n][k] = *(const LAS bf16x8*)(lds + PG8_SB(b, h) + boff + n * 2048 + k * 1024); } while (0)
#define PG8_MMA(ai, bj, At, Bt) do { __builtin_amdgcn_s_setprio(1); _Pragma("unroll") for (int m = 0; m < 4; ++m) _Pragma("unroll") for (int n = 0; n < 2; ++n) _Pragma("unroll") for (int k = 0; k < 2; ++k) \
        acc[ai][bj][m][n] = __builtin_amdgcn_mfma_f32_16x16x32_bf16(Bt[n][k], At[m][k], acc[ai][bj][m][n], 0, 0, 0); __builtin_amdgcn_s_setprio(0); } while (0)
#define PG8_WAIT_V(n) asm volatile("s_waitcnt vmcnt(" #n ")" ::: "memory")
#define PG8_WAIT_L(n) asm volatile("s_waitcnt lgkmcnt(" #n ")" ::: "memory")
#define PG8_BAR __builtin_amdgcn_s_barrier()
#define PG8_SCHED __builtin_amdgcn_sched_barrier(0)
    Unit cur, nxt; int ui = 0;
    if (!S.next(0, cur)) return;
    f32x4 acc[2][2][4][2];
#pragma unroll
    for (int a = 0; a < 2; ++a)
#pragma unroll
        for (int b = 0; b < 2; ++b)
#pragma unroll
            for (int m = 0; m < 4; ++m)
#pragma unroll
                for (int n = 0; n < 2; ++n) acc[a][b][m][n] = (f32x4){0.f, 0.f, 0.f, 0.f};
    bf16x8 At[4][2], B0[2][2], B1[2][2];
    const char* cA = (const char*)g.A + (size_t)((unsigned)cur.pm * tstepA + (unsigned)cur.z * g.zA); const char* cB = (const char*)g.Bt + (size_t)((unsigned)cur.pn * tstepB + (unsigned)cur.z * g.zB);
    PG8_STAGE(PG8_SB(0, 0), cB, voffB); PG8_STAGE(PG8_SB(0, 1), cB + hstepB, voffB); PG8_STAGE(PG8_SA(0, 0), cA, voffA); PG8_STAGE(PG8_SA(0, 1), cA + hstepA, voffA);
    if (wr == 1) PG8_BAR;
    PG8_WAIT_V(2); PG8_BAR;
    PG8_STAGE(PG8_SB(1, 0), cB + kstep, voffB); PG8_STAGE(PG8_SA(1, 0), cA + kstep, voffA); PG8_STAGE(PG8_SB(1, 1), cB + hstepB + kstep, voffB);
    PG8_WAIT_V(6); PG8_BAR;
    for (;;) {
        const bool has_next = S.next(ui + 1, nxt);
        const char* nA = has_next ? (const char*)g.A + (size_t)((unsigned)nxt.pm * tstepA + (unsigned)nxt.z * g.zA) : cA;
        const char* nB = has_next ? (const char*)g.Bt + (size_t)((unsigned)nxt.pn * tstepB + (unsigned)nxt.z * g.zB) : cB;
        for (int t = 0; t < nt; t += 2) {
            const bool last = (t == nt - 2);
            const char* a1 = cA + (unsigned)(t + 1) * kstep;
            const char* a2 = last ? nA : cA + (unsigned)(t + 2) * kstep; const char* b2 = last ? nB : cB + (unsigned)(t + 2) * kstep;
            const char* a3 = a2 + kstep; const char* b3 = b2 + kstep;
            PG8_LDB(B0, 0, 0); PG8_LDB(B1, 0, 1); PG8_SCHED; PG8_LDA(At, 0, 0); PG8_STAGE(PG8_SA(1, 1), a1 + hstepA, voffA);
            PG8_WAIT_V(8); PG8_WAIT_L(0); PG8_BAR; PG8_MMA(0, 0, At, B0); PG8_MMA(0, 1, At, B1); PG8_BAR; PG8_SCHED;
            PG8_LDA(At, 0, 1); PG8_STAGE(PG8_SB(0, 0), b2, voffB); PG8_STAGE(PG8_SB(0, 1), b2 + hstepB, voffB); PG8_STAGE(PG8_SA(0, 0), a2, voffA);
            PG8_WAIT_V(8); PG8_WAIT_L(0); PG8_BAR; PG8_MMA(1, 0, At, B0); PG8_MMA(1, 1, At, B1); PG8_BAR; PG8_SCHED;
            PG8_LDB(B0, 1, 0); PG8_LDB(B1, 1, 1); PG8_SCHED; PG8_LDA(At, 1, 0); PG8_STAGE(PG8_SA(0, 1), a2 + hstepA, voffA);
            PG8_WAIT_V(8); PG8_WAIT_L(0); PG8_BAR; PG8_MMA(0, 0, At, B0); PG8_MMA(0, 1, At, B1); PG8_BAR; PG8_SCHED;
            PG8_LDA(At, 1, 1); PG8_STAGE(PG8_SB(1, 0), b3, voffB); PG8_STAGE(PG8_SB(1, 1), b3 + hstepB, voffB); PG8_STAGE(PG8_SA(1, 0), a3, voffA);
            PG8_WAIT_V(8); PG8_WAIT_L(0); PG8_BAR; PG8_MMA(1, 0, At, B0); PG8_MMA(1, 1, At, B1); PG8_BAR; PG8_SCHED;
        }
        if (wr == 0) PG8_BAR;
        E(acc, cur, wr, wc, fr, fq);
        if (!has_next) break;
#pragma unroll
        for (int a = 0; a < 2; ++a)
#pragma unroll
            for (int b = 0; b < 2; ++b)
#pragma unroll
                for (int m = 0; m < 4; ++m)
#pragma unroll
                    for (int n = 0; n < 2; ++n) acc[a][b][m][n] = (f32x4){0.f, 0.f, 0.f, 0.f};
        cur = nxt; cA = nA; cB = nB; ++ui;
        if (wr == 1) PG8_BAR;
    }
    PG8_WAIT_V(0);
    PG8_BAR;
#undef PG8_SA
#undef PG8_SB
#undef PG8_STAGE
#undef PG8_LDA
#undef PG8_LDB
#undef PG8_MMA
#undef PG8_WAIT_V
#undef PG8_WAIT_L
#undef PG8_BAR
#undef PG8_SCHED
}
}


#define XB_TMO      128
#define XB_XCNT(j)  (256  + 64 * (j))
#define XB_XSUB(j)  (1280 + 64 * (j))
#define XB_XGEN(j)  (2304 + 64 * (j))
#define XB_TOP      3328
#define XB_TOPGEN   3392
#define XCD_BAR_WORDS 3456
#define XB_SPIN_CAP (1u << 22)
__device__ __forceinline__ unsigned xb_ld(unsigned* p)              { return __hip_atomic_load(p, __ATOMIC_RELAXED, __HIP_MEMORY_SCOPE_AGENT); }
__device__ __forceinline__ unsigned xb_add(unsigned* p, unsigned v) { return __hip_atomic_fetch_add(p, v, __ATOMIC_RELAXED, __HIP_MEMORY_SCOPE_AGENT); }
__device__ __forceinline__ unsigned xb_xcc_id() { return (unsigned)__builtin_amdgcn_s_getreg((3 << 11) | 20) & 0xFu; }
#define XB_SPIN(cond, bar) do { unsigned _sp = 0; while (cond) { __builtin_amdgcn_s_sleep(1); \
    if ((++_sp & 255u) == 0u) { if (xb_ld(&(bar)[XB_TMO])) break; if (_sp > XB_SPIN_CAP) { atomicAdd(&(bar)[XB_TMO], 1u); break; } } } } while (0)
struct XcdBarrier { unsigned* bar; unsigned x; volatile LAS unsigned* st; };
__device__ __forceinline__ XcdBarrier xcd_barrier_post(unsigned* bar, volatile LAS unsigned* st, bool leader) {
    XcdBarrier b; b.bar = bar; b.x = xb_xcc_id(); b.st = st;
    if (leader) (void)xb_add(&bar[XB_XCNT(b.x)], 1u);
    return b;
}
__device__ __forceinline__ void xcd_barrier_complete(unsigned* bar, unsigned x, unsigned& nloc, unsigned& nx) {
    const unsigned G = gridDim.x * gridDim.y * gridDim.z;
    unsigned sum, cnt, mine, sp = 0u;
    for (;;) {
        sum = 0u; cnt = 0u; mine = 0u;
#pragma unroll 1
        for (unsigned j = 0; j < 16; ++j) { const unsigned c = xb_ld(&bar[XB_XCNT(j)]); sum += c; cnt += (c > 0u) ? 1u : 0u; mine = (j == x) ? c : mine; }
        if (sum == G) break;
        __builtin_amdgcn_s_sleep(1);
        if ((++sp & 255u) == 0u) { if (xb_ld(&bar[XB_TMO])) break; if (sp > XB_SPIN_CAP) { atomicAdd(&bar[XB_TMO], 1u); break; } }
    }
    nloc = mine > 0u ? mine : 1u; nx = cnt > 0u ? cnt : 1u;
}
__device__ __forceinline__ void xcd_barrier(const XcdBarrier& b, bool leader) {
    asm volatile("s_waitcnt vmcnt(0)" ::: "memory");
    __syncthreads();
    if (leader) {
        unsigned* bar = b.bar; asm volatile("" : "+s"(bar));
        __builtin_amdgcn_s_waitcnt(0);
        unsigned nloc = b.st[0], nx = b.st[1];
        if (nloc == 0u) { xcd_barrier_complete(bar, b.x, nloc, nx); b.st[0] = nloc; b.st[1] = nx; }
        const unsigned old = xb_add(&bar[XB_XSUB(b.x)], 1u);
        const unsigned gen = old / nloc;
        if (old + 1u == (gen + 1u) * nloc) {
            __builtin_amdgcn_fence(__ATOMIC_RELEASE, "agent");
            asm volatile("s_waitcnt vmcnt(0)" ::: "memory");
            const unsigned og = xb_add(&bar[XB_TOP], 1u);
            const unsigned tg = og / nx;
            if (og + 1u == (tg + 1u) * nx) xb_add(&bar[XB_TOPGEN], 1u);
            else XB_SPIN(xb_ld(&bar[XB_TOPGEN]) == tg, bar);
            __builtin_amdgcn_fence(__ATOMIC_ACQUIRE, "agent");
            xb_add(&bar[XB_XGEN(b.x)], 1u);
            asm volatile("s_waitcnt vmcnt(0)" ::: "memory");
        } else {
            XB_SPIN(xb_ld(&bar[XB_XGEN(b.x)]) == gen, bar);
            __builtin_amdgcn_fence(__ATOMIC_ACQUIRE, "agent");
            asm volatile("s_waitcnt vmcnt(0)" ::: "memory");
        }
    }
    __syncthreads();
}

struct Params { const float* in[20]; float* out; unsigned char* ws; int ph_lo, ph_hi, use_cg, pad; };
enum { I_XP = 0, I_XS, I_SPOOL, I_SCONV, I_CK, I_CV, I_MEM, I_NPRE, I_NPOST, I_MNORM, I_WKV, I_WIN, I_POOLW, I_PSCALE, I_CONVW, I_CONVB, I_LNG, I_LNB, I_WBR, I_WOUT };

__device__ __forceinline__ void transpose_item(const float* W, int K, int N, bf16_t* WT, LAS float* scr, int item, int lane) {
    const int nblk = N / 32, kb = item / nblk, nb = item % nblk, k0 = 64 * kb, n0 = 32 * nb;
    const int kk = lane >> 3, n4 = (lane & 7) * 4;
    f32x4 v[8];
#pragma unroll
    for (int i = 0; i < 8; ++i) v[i] = *(const f32x4*)(W + (size_t)(k0 + kk + 8 * i) * N + n0 + n4);
#pragma unroll
    for (int i = 0; i < 8; ++i) { LAS float* d = scr + (kk + 8 * i) * 33 + n4; d[0] = v[i].x; d[1] = v[i].y; d[2] = v[i].z; d[3] = v[i].w; }
    LDS_WAIT();
    const int c = lane & 7;
#pragma unroll
    for (int j = 0; j < 4; ++j) { const int n = (lane >> 3) + 8 * j; const LAS float* s = scr + (8 * c) * 33 + n;
        u32x4 o; o.x = pk2(s[0 * 33], s[1 * 33]); o.y = pk2(s[2 * 33], s[3 * 33]); o.z = pk2(s[4 * 33], s[5 * 33]); o.w = pk2(s[6 * 33], s[7 * 33]);
        *(u32x4*)(WT + (size_t)(n0 + n) * K + k0 + 8 * c) = o; }
    LDS_WAIT();
}

__device__ __forceinline__ void p0_prologue(const Params& p, LAS unsigned char* lds, int gw, int NGW, int wave, int lane) {
    LAS float* scr = (LAS float*)(lds + wave * 8704);
    unsigned char* ws = p.ws;
    constexpr int I_IN = (D / 64) * (NCOL / 32), I_SQ = (D / 64) * (D / 32), I_BR = (512 / 64) * (D / 32), I_PL = 2 * 4;
    constexpr int NITEMS = 2 * I_IN + 2 * I_SQ + 6 * I_BR + 2 * I_SQ + 8 * I_PL;
    for (int it = gw; it < NITEMS; it += NGW) {
        int r = it;
        if (r < 2 * I_IN) { const int l = r / I_IN; transpose_item(p.in[I_WIN] + (size_t)l * D * NCOL, D, NCOL, (bf16_t*)(ws + WS_WIN) + (size_t)l * NCOL * D, scr, r % I_IN, lane); continue; } r -= 2 * I_IN;
        if (r < 2 * I_SQ) { const int l = r / I_SQ; transpose_item(p.in[I_WKV] + (size_t)l * D * D, D, D, (bf16_t*)(ws + WS_WKV) + (size_t)l * D * D, scr, r % I_SQ, lane); continue; } r -= 2 * I_SQ;
        if (r < 6 * I_BR) { const int l = r / I_BR; transpose_item(p.in[I_WBR] + (size_t)l * 512 * D, 512, D, (bf16_t*)(ws + WS_WBR) + (size_t)l * D * 512, scr, r % I_BR, lane); continue; } r -= 6 * I_BR;
        if (r < 2 * I_SQ) { const int l = r / I_SQ; transpose_item(p.in[I_WOUT] + (size_t)l * D * D, D, D, (bf16_t*)(ws + WS_WOUT) + (size_t)l * D * D, scr, r % I_SQ, lane); continue; } r -= 2 * I_SQ;
        { const int l = r / I_PL; transpose_item(p.in[I_POOLW] + (size_t)l * 128 * 128, 128, 128, (bf16_t*)(ws + WS_WPOOL) + (size_t)l * 128 * 128, scr, r % I_PL, lane); }
    }
    const float* g0 = p.in[I_NPRE];
    for (int m0 = gw; m0 < MT; m0 += 2 * NGW) {
        f32x4 v[2][4]; float s[2];
#pragma unroll
        for (int r = 0; r < 2; ++r) { const int mm = m0 + r * NGW, m = mm < MT ? mm : MT - 1;
            const float* xrow = (m < MP) ? p.in[I_XP] + (size_t)m * D : p.in[I_XS] + (size_t)(m - MP) * D; const f32x4* xr = (const f32x4*)xrow + lane;
#pragma unroll
            for (int j = 0; j < 4; ++j) v[r][j] = xr[64 * j]; }
#pragma unroll
        for (int r = 0; r < 2; ++r) { float t = 0.f;
#pragma unroll
            for (int j = 0; j < 4; ++j) t += (v[r][j].x * v[r][j].x + v[r][j].y * v[r][j].y) + (v[r][j].z * v[r][j].z + v[r][j].w * v[r][j].w);
            s[r] = 1.0f / sqrtf(wave_sum(t) * (1.f / D) + EPS); }
#pragma unroll
        for (int r = 0; r < 2; ++r) { const int mm = m0 + r * NGW; if (mm < MT) { u32x2* o = (u32x2*)((bf16_t*)(ws + WS_H) + (size_t)mm * D) + lane; const float rs = s[r];
#pragma unroll
            for (int j = 0; j < 4; ++j) { const f32x4 g = ((const f32x4*)g0)[lane + 64 * j]; u32x2 w; w.x = pk2(v[r][j].x * rs * g.x, v[r][j].y * rs * g.y); w.y = pk2(v[r][j].z * rs * g.z, v[r][j].w * rs * g.w); o[64 * j] = w; } } }
    }
    for (int m = gw; m < 2048; m += NGW) {
        const f32x4* xr = (const f32x4*)(p.in[I_MEM] + (size_t)m * D) + lane; f32x4 v[4]; float s = 0.f;
#pragma unroll
        for (int j = 0; j < 4; ++j) { v[j] = xr[64 * j]; s += (v[j].x * v[j].x + v[j].y * v[j].y) + (v[j].z * v[j].z + v[j].w * v[j].w); }
        const float rs = 1.0f / sqrtf(wave_sum(s) * (1.f / D) + EPS);
#pragma unroll
        for (int l = 0; l < 2; ++l) { u32x2* o = (u32x2*)((bf16_t*)(ws + WS_MEMN) + ((size_t)l * 2048 + m) * D) + lane;
#pragma unroll
            for (int j = 0; j < 4; ++j) { const f32x4 g = ((const f32x4*)(p.in[I_MNORM] + l * D))[lane + 64 * j]; u32x2 w; w.x = pk2(v[j].x * rs * g.x, v[j].y * rs * g.y); w.y = pk2(v[j].z * rs * g.z, v[j].w * rs * g.w); o[64 * j] = w; } }
    }
}

__device__ __forceinline__ void p5_residual(const Params& p, int layer, int gw, int NGW, int lane) {
    unsigned char* ws = p.ws;
    const bf16_t* Y = (const bf16_t*)(ws + WS_Y); const float* ssq = (const float*)(ws + WS_SSQ);
    const f32x4* gp = (const f32x4*)(p.in[I_NPOST] + layer * D); const f32x4* gn = (const f32x4*)(p.in[I_NPRE] + D);
    for (int m0 = gw; m0 < MT; m0 += 2 * NGW) {
        f32x4 x[2][4]; u32x2 y[2][4]; float sp[2];
#pragma unroll
        for (int r = 0; r < 2; ++r) { const int mm = m0 + r * NGW, m = mm < MT ? mm : MT - 1;
            sp[r] = (lane < 16) ? ssq[(size_t)m * 16 + lane] : 0.f;
            const u32x2* yr = (const u32x2*)(Y + (size_t)m * D) + lane;
            if (layer == 0) { const float* xrow = (m < MP) ? p.in[I_XP] + (size_t)m * D : p.in[I_XS] + (size_t)(m - MP) * D; const f32x4* xr = (const f32x4*)xrow + lane;
#pragma unroll
                for (int j = 0; j < 4; ++j) { x[r][j] = xr[64 * j]; y[r][j] = yr[64 * j]; } }
            else { const u32x2* xr = (const u32x2*)((const bf16_t*)(ws + WS_X1) + (size_t)m * D) + lane;
#pragma unroll
                for (int j = 0; j < 4; ++j) { const u32x2 xx = xr[64 * j]; x[r][j] = (f32x4){bflo(xx.x), bfhi(xx.x), bflo(xx.y), bfhi(xx.y)}; y[r][j] = yr[64 * j]; } } }
#pragma unroll
        for (int r = 0; r < 2; ++r) { const int mm = m0 + r * NGW;
            const float rs = 1.0f / sqrtf(wave_sum(sp[r]) * (1.f / D) + EPS); float s = 0.f;
#pragma unroll
            for (int j = 0; j < 4; ++j) { const f32x4 g = gp[lane + 64 * j]; f32x4& v = x[r][j]; const u32x2 yy = y[r][j];
                v.x += bflo(yy.x) * rs * g.x; v.y += bfhi(yy.x) * rs * g.y; v.z += bflo(yy.y) * rs * g.z; v.w += bfhi(yy.y) * rs * g.w;
                s += (v.x * v.x + v.y * v.y) + (v.z * v.z + v.w * v.w); }
            if (layer == 0) {
                const float r2 = 1.0f / sqrtf(wave_sum(s) * (1.f / D) + EPS);
                if (mm < MT) { u32x2* o = (u32x2*)((bf16_t*)(ws + WS_H) + (size_t)mm * D) + lane; u32x2* o1 = (u32x2*)((bf16_t*)(ws + WS_X1) + (size_t)mm * D) + lane;
#pragma unroll
                    for (int j = 0; j < 4; ++j) { const f32x4 g = gn[lane + 64 * j]; const f32x4 v = x[r][j]; u32x2 w; w.x = pk2(v.x * r2 * g.x, v.y * r2 * g.y); w.y = pk2(v.z * r2 * g.z, v.w * r2 * g.w); o[64 * j] = w;
                        u32x2 w1; w1.x = pk2(v.x, v.y); w1.y = pk2(v.z, v.w); o1[64 * j] = w1; } }
            } else if (mm < MT) {
                f32x4* orow = (f32x4*)(p.out + (size_t)mm * D) + lane;
#pragma unroll
                for (int j = 0; j < 4; ++j) orow[64 * j] = x[r][j];
            }
        }
    }
}

template <int T, bool SAMPLE>
__device__ __forceinline__ void pool_task(const Params& p, int layer, LAS unsigned char* lds, int task, int tid, int wave, int lane) {
    constexpr int R = T + 15, NRB = (T + 15) / 16;
    unsigned char* ws = p.ws;
    const bf16_t* proj = (const bf16_t*)(ws + WS_PROJ); bf16_t* br = (bf16_t*)(ws + WS_BR);
    LAS unsigned* PE = (LAS unsigned*)lds;
    LAS unsigned* MX = (LAS unsigned*)(lds + R * 1024);
    int b = 0, t0 = 0, seq = 0, rowbase;
    if (SAMPLE) { seq = task; rowbase = MP + seq * 8; } else { b = task >> 6; t0 = (task & 63) * T; rowbase = b * SEQ + t0; }
    const int g_ = wave >> 1, ch_ = wave & 1, h4_ = lane >> 4, c_ = lane & 15;
    u32x2 gtp[NRB][4];
    {
#pragma unroll
      for (int rb = 0; rb < NRB; ++rb) { const int tr = 16 * rb + c_;
#pragma unroll
        for (int cb = 0; cb < 4; ++cb) gtp[rb][cb] = *(const u32x2*)(proj + (size_t)(rowbase + (tr < T ? tr : 0)) * NCOL + C_PGATE + 128 * g_ + 64 * ch_ + 16 * cb + 4 * h4_); } }
    __syncthreads();
    if (SAMPLE) {
        f32x4 sa[2], sb[2]; u32x4 pw;
#pragma unroll
        for (int i = 0; i < 2; ++i) { const int idx = tid + NTHREADS * i, row = idx < 960 ? (idx >> 6) : 0, c8 = idx & 63;
            const float* src = p.in[I_SPOOL] + (((size_t)layer * NSEQ + seq) * 15 + row) * 512 + 8 * c8; sa[i] = *(const f32x4*)src; sb[i] = *(const f32x4*)(src + 4); }
        { const int row = tid >> 6, c8 = tid & 63; pw = *(const u32x4*)(proj + (size_t)(rowbase + row) * NCOL + 8 * c8); }
#pragma unroll
        for (int i = 0; i < 2; ++i) { const int idx = tid + NTHREADS * i, row = idx >> 6, c8 = idx & 63;
            if (idx < 960) { u32x4 w; w.x = pk2(sa[i].x, sa[i].y); w.y = pk2(sa[i].z, sa[i].w); w.z = pk2(sb[i].x, sb[i].y); w.w = pk2(sb[i].z, sb[i].w);
                *(LAS u32x4*)(PE + row * 256 + 4 * c8) = w;
                if (row >= 8) { float* o = p.out + O_POOLS + (((size_t)layer * NSEQ + seq) * 15 + (row - 8)) * 512 + 8 * c8; *(f32x4*)o = sa[i]; *(f32x4*)(o + 4) = sb[i]; } } }
        { const int row = 15 + (tid >> 6), c8 = tid & 63; *(LAS u32x4*)(PE + row * 256 + 4 * c8) = pw;
            float* o = p.out + O_POOLS + (((size_t)layer * NSEQ + seq) * 15 + (row - 8)) * 512 + 8 * c8;
            *(f32x4*)o = (f32x4){bflo(pw.x), bfhi(pw.x), bflo(pw.y), bfhi(pw.y)}; *(f32x4*)(o + 4) = (f32x4){bflo(pw.z), bfhi(pw.z), bflo(pw.w), bfhi(pw.w)}; }
    } else {
        constexpr int NCH = R * 64, NIT = (NCH + NTHREADS - 1) / NTHREADS;
        u32x4 pw[NIT];
#pragma unroll
        for (int i = 0; i < NIT; ++i) { const int idx = tid + NTHREADS * i, row = idx >> 6, c8 = idx & 63; int grow = t0 - 15 + row; if (grow < 0 || idx >= NCH) grow = 0;
            pw[i] = *(const u32x4*)(proj + (size_t)(b * SEQ + grow) * NCOL + 8 * c8); }
#pragma unroll
        for (int i = 0; i < NIT; ++i) { const int idx = tid + NTHREADS * i, row = idx >> 6, c8 = idx & 63; const int grow = t0 - 15 + row;
            if (idx < NCH) { u32x4 w = pw[i]; if (grow < 0) w = (u32x4){0u, 0u, 0u, 0u};
                *(LAS u32x4*)(PE + row * 256 + 4 * c8) = w;
                if (grow >= SEQ - 15) { float* o = p.out + O_POOLP + (((size_t)layer * 8 + b) * 15 + (grow - (SEQ - 15))) * 512 + 8 * c8;
                    *(f32x4*)o = (f32x4){bflo(w.x), bfhi(w.x), bflo(w.y), bfhi(w.y)}; *(f32x4*)(o + 4) = (f32x4){bflo(w.z), bfhi(w.z), bflo(w.w), bfhi(w.w)}; } } }
    }
    __syncthreads();
    for (int idx = tid; idx < T * 256; idx += NTHREADS) {
        const int t = idx >> 8, cp = idx & 255, g = cp >> 6, win = 2 << g;
        float s0 = 0.f, s1 = 0.f;
        for (int j = 0; j < win; ++j) { const unsigned w = PE[(15 + t - j) * 256 + cp]; s0 += bflo(w); s1 += bfhi(w); }
        const unsigned cur = PE[(15 + t) * 256 + cp];
        float cnt = (float)win; if (!SAMPLE) { const int pp = t0 + t + 1; cnt = (float)(pp < win ? pp : win); }
        const float inv = 1.0f / cnt;
        MX[t * 260 + cp] = pk2(s0 * inv - bflo(cur), s1 * inv - bfhi(cur));
    }
    __syncthreads();
    {
        const int g = g_, ch = ch_, h4 = h4_, c = c_;
        const bf16_t* wt = (const bf16_t*)(ws + WS_WPOOL) + ((size_t)(layer * 4 + g) * 128 + 64 * ch) * 128;
        bf16x8 wf[4][4];
#pragma unroll
        for (int ks = 0; ks < 4; ++ks)
#pragma unroll
            for (int cb = 0; cb < 4; ++cb) wf[ks][cb] = *(const bf16x8*)(wt + (size_t)(16 * cb + c) * 128 + 32 * ks + 8 * h4);
        f32x4 acc[NRB][4];
#pragma unroll
        for (int rb = 0; rb < NRB; ++rb)
#pragma unroll
            for (int cb = 0; cb < 4; ++cb) acc[rb][cb] = (f32x4){0.f, 0.f, 0.f, 0.f};
#pragma unroll
        for (int ks = 0; ks < 4; ++ks) {
            bf16x8 bf[NRB];
#pragma unroll
            for (int rb = 0; rb < NRB; ++rb) bf[rb] = *(const LAS bf16x8*)((LAS unsigned char*)MX + (16 * rb + c) * 1040 + (128 * g + 32 * ks + 8 * h4) * 2);
#pragma unroll
            for (int cb = 0; cb < 4; ++cb)
#pragma unroll
                for (int rb = 0; rb < NRB; ++rb) acc[rb][cb] = __builtin_amdgcn_mfma_f32_16x16x32_bf16(wf[ks][cb], bf[rb], acc[rb][cb], 0, 0, 0);
        }
#pragma unroll
        for (int rb = 0; rb < NRB; ++rb) { const int tr = 16 * rb + c; if (tr < T) { const size_t row = (size_t)rowbase + tr;
#pragma unroll
                for (int cb = 0; cb < 4; ++cb) { const int col = 128 * g + 64 * ch + 16 * cb + 4 * h4;
                    const f32x4 sc = *(const f32x4*)(p.in[I_PSCALE] + layer * 512 + col); const u32x2 gt = gtp[rb][cb]; const f32x4 a = acc[rb][cb];
                    u32x2 w; w.x = pk2(a[0] * sc.x * siluf_(bflo(gt.x)), a[1] * sc.y * siluf_(bfhi(gt.x))); w.y = pk2(a[2] * sc.z * siluf_(bflo(gt.y)), a[3] * sc.w * siluf_(bfhi(gt.y)));
                    *(u32x2*)(br + row * BR_LD + col) = w; } } }
    }
}

template <int T, bool SAMPLE>
__device__ __forceinline__ void conv_task(const Params& p, int layer, LAS unsigned char* lds, int task, int tid, int wave, int lane) {
    constexpr int R = T + 30, TT = T / 2;
    unsigned char* ws = p.ws;
    const bf16_t* proj = (const bf16_t*)(ws + WS_PROJ); bf16_t* br = (bf16_t*)(ws + WS_BR);
    LAS unsigned* U = (LAS unsigned*)lds;
    LAS float* CO = (LAS float*)(lds + R * 1024);
    int b = 0, t0 = 0, seq = 0, rowbase;
    if (SAMPLE) { seq = task; rowbase = MP + seq * 8; } else { b = task >> 6; t0 = (task & 63) * T; rowbase = b * SEQ + t0; }
    const int cp = tid & 255, half = tid >> 8;
    constexpr int NTK = (T + 7) / 8;
    u32x4 gts[NTK];
#pragma unroll
    for (int i = 0; i < NTK; ++i) { const int t = wave + 8 * i; gts[i] = *(const u32x4*)(proj + (size_t)(rowbase + (t < T ? t : 0)) * NCOL + C_CGATE + 8 * lane); }
    __syncthreads();
#define GLU8(cv, cg_, ua, ub) do { \
        ua = (f32x4){bflo(cv.x) * sigmoidf_(bflo(cg_.x)), bfhi(cv.x) * sigmoidf_(bfhi(cg_.x)), bflo(cv.y) * sigmoidf_(bflo(cg_.y)), bfhi(cv.y) * sigmoidf_(bfhi(cg_.y))}; \
        ub = (f32x4){bflo(cv.z) * sigmoidf_(bflo(cg_.z)), bfhi(cv.z) * sigmoidf_(bfhi(cg_.z)), bflo(cv.w) * sigmoidf_(bflo(cg_.w)), bfhi(cv.w) * sigmoidf_(bfhi(cg_.w))}; } while (0)
    if (SAMPLE) {
        f32x4 sa[4], sb[4]; u32x4 cv, cg_;
#pragma unroll
        for (int i = 0; i < 4; ++i) { const int idx = tid + NTHREADS * i, row = idx < 1920 ? (idx >> 6) : 0, c8 = idx & 63;
            const float* src = p.in[I_SCONV] + (((size_t)layer * NSEQ + seq) * 30 + row) * 512 + 8 * c8; sa[i] = *(const f32x4*)src; sb[i] = *(const f32x4*)(src + 4); }
        { const int row = tid >> 6, c8 = tid & 63; const bf16_t* src = proj + (size_t)(rowbase + row) * NCOL + 8 * c8; cv = *(const u32x4*)(src + C_CVAL); cg_ = *(const u32x4*)(src + C_CGLU); }
#pragma unroll
        for (int i = 0; i < 4; ++i) { const int idx = tid + NTHREADS * i, row = idx >> 6, c8 = idx & 63;
            if (idx < 1920) { u32x4 w; w.x = pk2(sa[i].x, sa[i].y); w.y = pk2(sa[i].z, sa[i].w); w.z = pk2(sb[i].x, sb[i].y); w.w = pk2(sb[i].z, sb[i].w);
                *(LAS u32x4*)(U + row * 256 + 4 * c8) = w;
                if (row >= 8) { float* o = p.out + O_CONVS + (((size_t)layer * NSEQ + seq) * 30 + (row - 8)) * 512 + 8 * c8; *(f32x4*)o = sa[i]; *(f32x4*)(o + 4) = sb[i]; } } }
        { const int row = 30 + (tid >> 6), c8 = tid & 63; f32x4 ua, ub; GLU8(cv, cg_, ua, ub);
            u32x4 w; w.x = pk2(ua.x, ua.y); w.y = pk2(ua.z, ua.w); w.z = pk2(ub.x, ub.y); w.w = pk2(ub.z, ub.w);
            *(LAS u32x4*)(U + row * 256 + 4 * c8) = w;
            float* o = p.out + O_CONVS + (((size_t)layer * NSEQ + seq) * 30 + (row - 8)) * 512 + 8 * c8; *(f32x4*)o = ua; *(f32x4*)(o + 4) = ub; }
    } else {
        constexpr int NCH = R * 64, NIT = (NCH + NTHREADS - 1) / NTHREADS;
        u32x4 cv[NIT], cg_[NIT];
#pragma unroll
        for (int i = 0; i < NIT; ++i) { const int idx = tid + NTHREADS * i, row = idx >> 6, c8 = idx & 63; int gs = t0 - 30 + row; if (gs < 0 || idx >= NCH) gs = 0;
            const bf16_t* src = proj + (size_t)(b * SEQ + gs) * NCOL + 8 * c8; cv[i] = *(const u32x4*)(src + C_CVAL); cg_[i] = *(const u32x4*)(src + C_CGLU); }
#pragma unroll
        for (int i = 0; i < NIT; ++i) { const int idx = tid + NTHREADS * i, row = idx >> 6, c8 = idx & 63; const int gs = t0 - 30 + row;
            if (idx < NCH) { f32x4 ua, ub; GLU8(cv[i], cg_[i], ua, ub); if (gs < 0) { ua = (f32x4){0.f, 0.f, 0.f, 0.f}; ub = ua; }
                u32x4 w; w.x = pk2(ua.x, ua.y); w.y = pk2(ua.z, ua.w); w.z = pk2(ub.x, ub.y); w.w = pk2(ub.z, ub.w);
                *(LAS u32x4*)(U + row * 256 + 4 * c8) = w;
                if (gs >= SEQ - 30) { float* o = p.out + O_CONVP + (((size_t)layer * 8 + b) * 30 + (gs - (SEQ - 30))) * 512 + 8 * c8; *(f32x4*)o = ua; *(f32x4*)(o + 4) = ub; } } }
    }
#undef GLU8
    __syncthreads();
    {
        f32x2 wk[31];
        { const f32x2* cw = (const f32x2*)(p.in[I_CONVW] + (size_t)layer * 31 * 512) + cp;
#pragma unroll
          for (int k = 0; k < 31; ++k) wk[k] = cw[k * 256]; }
        const f32x2 bias = *((const f32x2*)(p.in[I_CONVB] + layer * 512) + cp);
        f32x2 acc[TT];
#pragma unroll
        for (int t = 0; t < TT; ++t) acc[t] = bias;
#pragma unroll
        for (int j = 0; j < TT + 30; ++j) {
            const unsigned uu = U[(half * TT + j) * 256 + cp]; const f32x2 uv = (f32x2){bflo(uu), bfhi(uu)};
#pragma unroll
            for (int t = 0; t < TT; ++t) { const int k = j - t; if (k >= 0 && k < 31) acc[t] += wk[k] * uv; }
        }
#pragma unroll
        for (int t = 0; t < TT; ++t) *(LAS f32x2*)(CO + (half * TT + t) * 512 + 2 * cp) = acc[t];
    }
    __syncthreads();
    {
        const float* lg = p.in[I_LNG] + layer * 512 + 8 * lane; const float* lb = p.in[I_LNB] + layer * 512 + 8 * lane;
        const f32x4 g0 = *(const f32x4*)lg, g1 = *(const f32x4*)(lg + 4), b0 = *(const f32x4*)lb, b1 = *(const f32x4*)(lb + 4);
#pragma unroll
        for (int ti = 0; ti < NTK; ++ti) { const int t = wave + 8 * ti; if (t >= T) break;
            const f32x4 x0 = *(const LAS f32x4*)(CO + t * 512 + 8 * lane), x1 = *(const LAS f32x4*)(CO + t * 512 + 8 * lane + 4);
            const float mean = wave_sum((x0.x + x0.y) + (x0.z + x0.w) + (x1.x + x1.y) + (x1.z + x1.w)) * (1.f / 512.f);
            const f32x4 d0 = x0 - mean, d1 = x1 - mean;
            const float var = wave_sum((d0.x * d0.x + d0.y * d0.y) + (d0.z * d0.z + d0.w * d0.w) + (d1.x * d1.x + d1.y * d1.y) + (d1.z * d1.z + d1.w * d1.w)) * (1.f / 512.f);
            const float rstd = 1.0f / sqrtf(var + EPS);
            const f32x4 y0 = d0 * rstd * g0 + b0, y1 = d1 * rstd * g1 + b1;
            const size_t row = (size_t)rowbase + t;
            const u32x4 gt = gts[ti];
            u32x4 w;
            w.x = pk2(siluf_(y0.x) * siluf_(bflo(gt.x)), siluf_(y0.y) * siluf_(bfhi(gt.x))); w.y = pk2(siluf_(y0.z) * siluf_(bflo(gt.y)), siluf_(y0.w) * siluf_(bfhi(gt.y)));
            w.z = pk2(siluf_(y1.x) * siluf_(bflo(gt.z)), siluf_(y1.y) * siluf_(bfhi(gt.z))); w.w = pk2(siluf_(y1.z) * siluf_(bflo(gt.w)), siluf_(y1.w) * siluf_(bfhi(gt.w)));
            *(u32x4*)(br + row * BR_LD + 512 + 8 * lane) = w;
        }
    }
}

constexpr int KS_STRIDE = 272, VT_STRIDE = 528, VT_OFF = 256 * KS_STRIDE;
template <bool SAMPLE>
__device__ __forceinline__ void attn_task(const Params& p, int layer, LAS unsigned char* lds, int task, int tid, int wave, int lane) {
    unsigned char* ws = p.ws;
    const bf16_t* proj = (const bf16_t*)(ws + WS_PROJ); bf16_t* br = (bf16_t*)(ws + WS_BR);
    int b = 0, head, qc = 0, seq = 0;
    if (SAMPLE) { seq = task >> 2; head = task & 3; } else { b = task >> 5; head = (task >> 3) & 3; qc = task & 7; }
    constexpr int NWT = SAMPLE ? 1 : 2;
    const int h4 = lane >> 4, c = lane & 15;
    const int nvalid = SAMPLE ? 8 : 16, cr = c < nvalid ? c : nvalid - 1;
    bf16x8 qfa[NWT][4]; u32x2 gta[NWT][8];
#pragma unroll
    for (int wi = 0; wi < NWT; ++wi) { const int qrow0 = SAMPLE ? (MP + seq * 8) : (b * SEQ + qc * 256 + (wave + 8 * wi) * 16);
        const bf16_t* qrow = proj + (size_t)(qrow0 + cr) * NCOL + C_Q + head * 128 + 8 * h4;
#pragma unroll
        for (int ks = 0; ks < 4; ++ks) qfa[wi][ks] = *(const bf16x8*)(qrow + 32 * ks);
#pragma unroll
        for (int nd = 0; nd < 8; ++nd) gta[wi][nd] = *(const u32x2*)(proj + (size_t)(qrow0 + cr) * NCOL + C_XGATE + head * 128 + 16 * nd + 4 * h4); }
    __syncthreads();
    if (SAMPLE) {
        const float* kb = p.in[I_CK] + (((size_t)layer * NSEQ + seq) * 256) * 512 + head * 128; const float* vb = p.in[I_CV] + (((size_t)layer * NSEQ + seq) * 256) * 512 + head * 128;
        f32x4 ka[8], kc[8], vv[2][8];
        const int d4 = 8 * (wave & 3) + (lane >> 3);
#pragma unroll
        for (int i = 0; i < 8; ++i) { const int c = tid + NTHREADS * i, key = c >> 4, dc = c & 15; const float* src = kb + (size_t)key * 512 + dc * 8; ka[i] = *(const f32x4*)src; kc[i] = *(const f32x4*)(src + 4); }
#pragma unroll
        for (int i = 0; i < 2; ++i) { const int ch = (lane & 7) + 8 * (wave >> 2) + 16 * i; const float* src = vb + (size_t)(8 * ch) * 512 + 4 * d4;
#pragma unroll
            for (int j = 0; j < 8; ++j) vv[i][j] = *(const f32x4*)(src + (size_t)j * 512); }
#pragma unroll
        for (int i = 0; i < 8; ++i) { const int c = tid + NTHREADS * i, key = c >> 4, dc = c & 15;
            u32x4 w; w.x = pk2(ka[i].x, ka[i].y); w.y = pk2(ka[i].z, ka[i].w); w.z = pk2(kc[i].x, kc[i].y); w.w = pk2(kc[i].z, kc[i].w);
            *(LAS u32x4*)(lds + key * KS_STRIDE + dc * 16) = w; }
#pragma unroll
        for (int i = 0; i < 2; ++i) { const int ch = (lane & 7) + 8 * (wave >> 2) + 16 * i;
#pragma unroll
            for (int q4 = 0; q4 < 4; ++q4) { u32x4 w; w.x = pk2(vv[i][0][q4], vv[i][1][q4]); w.y = pk2(vv[i][2][q4], vv[i][3][q4]); w.z = pk2(vv[i][4][q4], vv[i][5][q4]); w.w = pk2(vv[i][6][q4], vv[i][7][q4]);
                *(LAS u32x4*)(lds + VT_OFF + (4 * d4 + q4) * VT_STRIDE + ch * 16) = w; } }
    } else {
        const bf16_t* kb = (const bf16_t*)(ws + WS_KVB) + ((size_t)layer * 2048 + b * 256) * 512 + head * 128;
        const bf16_t* vt = (const bf16_t*)(ws + WS_KVB) + (size_t)2 * 2048 * 512 + ((size_t)layer * 512 + head * 128) * 2048 + b * 256;
        u32x4 kw[8], vw[8];
#pragma unroll
        for (int i = 0; i < 8; ++i) { const int c = tid + NTHREADS * i; kw[i] = *(const u32x4*)(kb + (size_t)(c >> 4) * 512 + (c & 15) * 8); vw[i] = *(const u32x4*)(vt + (size_t)(c >> 5) * 2048 + (c & 31) * 8); }
#pragma unroll
        for (int i = 0; i < 8; ++i) { const int c = tid + NTHREADS * i;
            *(LAS u32x4*)(lds + (c >> 4) * KS_STRIDE + (c & 15) * 16) = kw[i]; *(LAS u32x4*)(lds + VT_OFF + (c >> 5) * VT_STRIDE + (c & 31) * 16) = vw[i]; }
    }
    __syncthreads();
#pragma unroll
    for (int wi = 0; wi < NWT; ++wi) {
        if (SAMPLE && wave != 0) break;
        const int qrow0 = SAMPLE ? (MP + seq * 8) : (b * SEQ + qc * 256 + (wave + 8 * wi) * 16);
        bf16x8 qf[4]; u32x2 gt[8];
#pragma unroll
        for (int ks = 0; ks < 4; ++ks) qf[ks] = qfa[wi][ks];
#pragma unroll
        for (int nd = 0; nd < 8; ++nd) gt[nd] = gta[wi][nd];
        f32x4 s[16];
#pragma unroll
        for (int nb = 0; nb < 16; ++nb) {
            s[nb] = (f32x4){0.f, 0.f, 0.f, 0.f};
            const int keyrow = 32 * (nb >> 1) + 8 * (c >> 2) + 4 * (nb & 1) + (c & 3);
#pragma unroll
            for (int ks = 0; ks < 4; ++ks) { const bf16x8 kf = *(const LAS bf16x8*)(lds + keyrow * KS_STRIDE + (32 * ks + 8 * h4) * 2);
                s[nb] = __builtin_amdgcn_mfma_f32_16x16x32_bf16(kf, qf[ks], s[nb], 0, 0, 0); }
            if (nb & 1) asm volatile("" ::: "memory");
        }
        float mx = -3.0e38f;
#pragma unroll
        for (int nb = 0; nb < 16; ++nb) mx = fmaxf(fmaxf(fmaxf(s[nb][0], s[nb][1]), fmaxf(s[nb][2], s[nb][3])), mx);
        mx = fmaxf(mx, __shfl_xor(mx, 16)); mx = fmaxf(mx, __shfl_xor(mx, 32));
        const float sc = 0.08838834764831845f * 1.4426950408889634f;
        float sum = 0.f;
#pragma unroll
        for (int nb = 0; nb < 16; ++nb)
#pragma unroll
            for (int i = 0; i < 4; ++i) { const float e = __builtin_amdgcn_exp2f((s[nb][i] - mx) * sc); s[nb][i] = e; sum += e; }
        sum += __shfl_xor(sum, 16); sum += __shfl_xor(sum, 32);
        const float inv = 1.0f / sum;
        bf16x8 pf[8];
#pragma unroll
        for (int si = 0; si < 8; ++si) { u32x4 w; w.x = pk2(s[2 * si][0], s[2 * si][1]); w.y = pk2(s[2 * si][2], s[2 * si][3]); w.z = pk2(s[2 * si + 1][0], s[2 * si + 1][1]); w.w = pk2(s[2 * si + 1][2], s[2 * si + 1][3]);
            pf[si] = __builtin_bit_cast(bf16x8, w); }
#pragma unroll
        for (int nd = 0; nd < 8; ++nd) {
            f32x4 o = (f32x4){0.f, 0.f, 0.f, 0.f};
#pragma unroll
            for (int si = 0; si < 8; ++si) { const bf16x8 vf = *(const LAS bf16x8*)(lds + VT_OFF + (16 * nd + c) * VT_STRIDE + (32 * si + 8 * h4) * 2);
                o = __builtin_amdgcn_mfma_f32_16x16x32_bf16(vf, pf[si], o, 0, 0, 0); }
            if (c < nvalid) { const size_t row = (size_t)qrow0 + c; const int col = head * 128 + 16 * nd + 4 * h4;
                const u32x2 g2 = gt[nd];
                u32x2 w; w.x = pk2(o[0] * inv * siluf_(bflo(g2.x)), o[1] * inv * siluf_(bfhi(g2.x))); w.y = pk2(o[2] * inv * siluf_(bflo(g2.y)), o[3] * inv * siluf_(bfhi(g2.y)));
                *(u32x2*)(br + row * BR_LD + 1024 + col) = w; }
            asm volatile("" ::: "memory");
        }
    }
}


constexpr int SM_STRIDE = 1040, SM_BOFF = 64 * SM_STRIDE;
__device__ __forceinline__ void sm_issue(const bf16_t* A, int lda, const bf16_t* Bt, int ldb, int tid, u32x4 (&va)[8], u32x4 (&vb)[8]) {
#pragma unroll
    for (int i = 0; i < 8; ++i) { const int c = tid + NTHREADS * i, row = c >> 6, ch = c & 63;
        va[i] = *(const u32x4*)(A + (size_t)row * lda + ch * 8); vb[i] = *(const u32x4*)(Bt + (size_t)row * ldb + ch * 8); }
}
__device__ __forceinline__ void sm_write(LAS unsigned char* lds, int tid, const u32x4 (&va)[8], const u32x4 (&vb)[8]) {
#pragma unroll
    for (int i = 0; i < 8; ++i) { const int c = tid + NTHREADS * i, row = c >> 6, ch = c & 63;
        *(LAS u32x4*)(lds + row * SM_STRIDE + ch * 16) = va[i]; *(LAS u32x4*)(lds + SM_BOFF + row * SM_STRIDE + ch * 16) = vb[i]; }
}
__device__ __forceinline__ void sm_mma(LAS unsigned char* lds, int wr, int wc, int lane, f32x4 (&acc)[2]) {
    const int h4 = lane >> 4, r = lane & 15;
    LAS unsigned char* ap = lds + (16 * wr + r) * SM_STRIDE + 16 * h4; LAS unsigned char* bp = lds + SM_BOFF + (32 * wc + r) * SM_STRIDE + 16 * h4;
#pragma unroll
    for (int ks = 0; ks < 16; ++ks) { const bf16x8 af = *(const LAS bf16x8*)(ap + 64 * ks), w0 = *(const LAS bf16x8*)(bp + 64 * ks), w1 = *(const LAS bf16x8*)(bp + 16 * SM_STRIDE + 64 * ks);
        acc[0] = __builtin_amdgcn_mfma_f32_16x16x32_bf16(w0, af, acc[0], 0, 0, 0); acc[1] = __builtin_amdgcn_mfma_f32_16x16x32_bf16(w1, af, acc[1], 0, 0, 0);
        if ((ks & 3) == 3) asm volatile("" ::: "memory"); }
}
__device__ __forceinline__ void p3_small(const Params& p, int layer, LAS unsigned char* lds, int task, int tid, int wave, int lane) {
    unsigned char* ws = p.ws; const bf16_t* proj = (const bf16_t*)(ws + WS_PROJ);
    const int rt = task >> 4, ct = task & 15, wr = wave >> 1, wc = wave & 1, h4 = lane >> 4, c = lane & 15;
    const int row = MP + 64 * rt + 16 * wr + c, col0 = 64 * ct + 32 * wc + 4 * h4;
    const bf16_t* A0 = (const bf16_t*)(ws + WS_BR) + (size_t)(MP + 64 * rt) * BR_LD; const bf16_t* B0 = (const bf16_t*)(ws + WS_WBR) + ((size_t)(layer * 3) * D + 64 * ct) * 512;
    u32x4 va[8], vb[8];
    sm_issue(A0, BR_LD, B0, 512, tid, va, vb);
    f32x4 mg[2] = {(f32x4){0.f, 0.f, 0.f, 0.f}, (f32x4){0.f, 0.f, 0.f, 0.f}};
#pragma unroll 1
    for (int z = 0; z < 3; ++z) {
        __syncthreads();
        sm_write(lds, tid, va, vb);
        __syncthreads();
        if (z < 2) sm_issue(A0 + (z + 1) * 512, BR_LD, B0 + (size_t)(z + 1) * D * 512, 512, tid, va, vb);
        u32x2 lg[2];
#pragma unroll
        for (int n = 0; n < 2; ++n) lg[n] = *(const u32x2*)(proj + (size_t)row * NCOL + C_LOGIT + z * D + col0 + 16 * n);
        f32x4 acc[2] = {(f32x4){0.f, 0.f, 0.f, 0.f}, (f32x4){0.f, 0.f, 0.f, 0.f}};
        sm_mma(lds, wr, wc, lane, acc);
#pragma unroll
        for (int n = 0; n < 2; ++n) { mg[n][0] += acc[n][0] * sigmoidf_(bflo(lg[n].x)); mg[n][1] += acc[n][1] * sigmoidf_(bfhi(lg[n].x)); mg[n][2] += acc[n][2] * sigmoidf_(bflo(lg[n].y)); mg[n][3] += acc[n][3] * sigmoidf_(bfhi(lg[n].y)); }
    }
#pragma unroll
    for (int n = 0; n < 2; ++n) { u32x2 w; w.x = pk2(mg[n][0], mg[n][1]); w.y = pk2(mg[n][2], mg[n][3]); *(u32x2*)((bf16_t*)(ws + WS_MRG) + (size_t)row * D + col0 + 16 * n) = w; }
}
__device__ __forceinline__ void p4_small(const Params& p, int layer, LAS unsigned char* lds, int task, int tid, int wave, int lane) {
    unsigned char* ws = p.ws;
    const int rt = task >> 4, ct = task & 15, wr = wave >> 1, wc = wave & 1, h4 = lane >> 4, c = lane & 15;
    const int row = MP + 64 * rt + 16 * wr + c, col0 = 64 * ct + 32 * wc + 4 * h4;
    const bf16_t* A0 = (const bf16_t*)(ws + WS_MRG) + (size_t)(MP + 64 * rt) * D; const bf16_t* B0 = (const bf16_t*)(ws + WS_WOUT) + ((size_t)layer * D + 64 * ct) * D;
    u32x4 va[8], vb[8];
    sm_issue(A0, D, B0, D, tid, va, vb);
    f32x4 acc[2] = {(f32x4){0.f, 0.f, 0.f, 0.f}, (f32x4){0.f, 0.f, 0.f, 0.f}};
#pragma unroll 1
    for (int seg = 0; seg < 2; ++seg) {
        __syncthreads();
        sm_write(lds, tid, va, vb);
        __syncthreads();
        if (seg < 1) sm_issue(A0 + 512, D, B0 + 512, D, tid, va, vb);
        sm_mma(lds, wr, wc, lane, acc);
    }
    float s = 0.f;
#pragma unroll
    for (int n = 0; n < 2; ++n) { const f32x4 v = acc[n]; s += (v[0] * v[0] + v[1] * v[1]) + (v[2] * v[2] + v[3] * v[3]);
        u32x2 w; w.x = pk2(v[0], v[1]); w.y = pk2(v[2], v[3]); *(u32x2*)((bf16_t*)(ws + WS_Y) + (size_t)row * D + col0 + 16 * n) = w; }
    s += __shfl_xor(s, 16); s += __shfl_xor(s, 32);
    LAS float* red = (LAS float*)lds;
    __syncthreads();
    if (h4 == 0) red[(16 * wr + c) * 2 + wc] = s;
    __syncthreads();
    if (tid < 64) ((float*)(ws + WS_SSQ))[(size_t)(MP + 64 * rt + tid) * 16 + ct] = red[tid * 2] + red[tid * 2 + 1];
}

__device__ __forceinline__ void stagger_start(int bx, unsigned ticks) {
    const unsigned long long t0 = __builtin_amdgcn_s_memrealtime(); const unsigned long long w = (unsigned long long)(((unsigned)bx >> 3) & 3u) * ticks;
    while (__builtin_amdgcn_s_memrealtime() - t0 < w) __builtin_amdgcn_s_sleep(16);
}
constexpr unsigned STAG1 = 0, STAG3 = 0;

__global__ void __launch_bounds__(NTHREADS, 2) mk_fwd(Params p) {
    extern __shared__ __attribute__((aligned(16))) unsigned char lds_raw[];
    LAS unsigned char* lds = (LAS unsigned char*)lds_raw;
    cg::grid_group grid = cg::this_grid();
    const int G = gridDim.x;
    const int NGW = G * 8;
    const int wid0 = __builtin_amdgcn_readfirstlane(threadIdx.x >> 6);
    auto tidnow = [&]() -> int { unsigned z_ = 0u; asm volatile("" : "+v"(z_)); return wid0 * 64 + (int)__builtin_amdgcn_mbcnt_hi(~0u, __builtin_amdgcn_mbcnt_lo(~0u, z_)); };
#define TIDNOW() tidnow()
#define PQ() unsigned long long ka_ = (unsigned long long)__builtin_amdgcn_kernarg_segment_ptr(); asm volatile("" : "+s"(ka_)); \
    const __attribute__((address_space(4))) Params* kp_ = (const __attribute__((address_space(4))) Params*)ka_; Params q; \
    int bxq = blockIdx.x; asm volatile("" : "+s"(bxq)); \
    _Pragma("unroll") for (int i_ = 0; i_ < 20; ++i_) q.in[i_] = kp_->in[i_]; q.out = kp_->out; q.ws = kp_->ws; q.ph_lo = 0; q.ph_hi = 0; q.use_cg = 0; q.pad = 0
#define IDS() int tid = TIDNOW(); asm volatile("" : "+v"(tid)); const int bx = bxq, lane = tid & 63, wave = __builtin_amdgcn_readfirstlane(tid >> 6), gw = ((G % 8 == 0) ? (bx % 8) * (G / 8) + bx / 8 : bx) * 8 + wave; (void)gw; (void)lane; (void)bx
    unsigned char* ws = p.ws;
    const int lo = p.ph_lo, hi = p.ph_hi;
#define IN(k) (lo <= (k) && (k) < hi)
    { const int t0_ = TIDNOW(); if (t0_ < 4) ((LAS unsigned*)(lds + LDS_BAR_OFF))[t0_] = 0u; }
    __syncthreads();
    XcdBarrier xbar; xbar.bar = (unsigned*)(ws + WS_BAR); xbar.x = 0; xbar.st = (volatile LAS unsigned*)(lds + LDS_BAR_OFF);
    if (hi - lo > 1) xbar = xcd_barrier_post((unsigned*)(ws + WS_BAR), (volatile LAS unsigned*)(lds + LDS_BAR_OFF), TIDNOW() == 0);
#define SEAM(k) do { if (IN(k) && IN((k) + 1)) { if (p.use_cg) grid.sync(); else xcd_barrier(xbar, TIDNOW() == 0); } } while (0)

    if (IN(0)) for (int rep = 0; rep < REP0; ++rep) { PQ(); IDS(); p0_prologue(q, lds, gw, NGW, wave, lane); }
    SEAM(0);
#pragma unroll 1
    for (int layer = 0; layer < 2; ++layer) {
        const int pb = 1 + 5 * layer;
        if (IN(pb)) for (int rep = 0; rep < REP1; ++rep) {
            PQ(); unsigned char* const ws = q.ws;
            if (STAG1) stagger_start(bxq, STAG1);
            { pg8::Gemm g{(const bf16_t*)(ws + WS_H), (const bf16_t*)(ws + WS_WIN) + (size_t)layer * NCOL * D, D, D, D, 0, 0};
              pg8::Order S; S.init(MT, NCOL, 1, 0, G, bxq);
              pg8::EpiStoreBf16 E{(bf16_t*)(ws + WS_PROJ), NCOL};
              pg8::gemm_phase<pg8::EpiStoreBf16>(lds, g, S, E, TIDNOW()); }
            if (layer == 0) {
              { pg8::Gemm g{(const bf16_t*)(ws + WS_MEMN), (const bf16_t*)(ws + WS_WKV), D, D, D, 2048u * D * 2u, (unsigned)D * D * 2u};
                pg8::Order S; S.init(2048, 512, 2, 0, G, G - 1 - bxq);
                pg8::EpiK E{q.out + O_MK, (bf16_t*)(ws + WS_KVB)};
                pg8::gemm_phase<pg8::EpiK>(lds, g, S, E, TIDNOW()); }
              { pg8::Gemm g{(const bf16_t*)(ws + WS_WKV) + (size_t)512 * D, (const bf16_t*)(ws + WS_MEMN), D, D, D, (unsigned)D * D * 2u, 2048u * D * 2u};
                int cv = G - 33 - bxq; if (cv < 0) cv += G;
                pg8::Order S; S.init(512, 2048, 2, 0, G, cv);
                pg8::EpiVt E{q.out + O_MV, (bf16_t*)(ws + WS_KVB) + (size_t)2 * 2048 * 512};
                pg8::gemm_phase<pg8::EpiVt>(lds, g, S, E, TIDNOW()); }
            }
        }
        SEAM(pb);
        if (IN(pb + 1)) for (int rep = 0; rep < REP2; ++rep) {
            PQ(); IDS();
            const bool stream_first = ((bx >> 3) & 1) != 0;
            if (stream_first) { for (int t = bx; t < 512; t += G) attn_task<true>(q, layer, lds, t, tid, wave, lane); }
            for (int r2 = 0; r2 < R2A; ++r2) for (int t = bx; t < 512; t += G) pool_task<32, false>(q, layer, lds, t, tid, wave, lane);
            for (int r2 = 0; r2 < R2B; ++r2) for (int t = bx; t < 512; t += G) conv_task<32, false>(q, layer, lds, t, tid, wave, lane);
            for (int r2 = 0; r2 < R2C; ++r2) for (int t = bx; t < 256; t += G) { if (t < 128) pool_task<8, true>(q, layer, lds, t, tid, wave, lane); else conv_task<8, true>(q, layer, lds, t - 128, tid, wave, lane); }
            for (int r2 = 0; r2 < R2D; ++r2) for (int t = bx; t < 256; t += G) attn_task<false>(q, layer, lds, t, tid, wave, lane);
            if (!stream_first) { for (int r2 = 0; r2 < R2E; ++r2) for (int t = bx; t < 512; t += G) attn_task<true>(q, layer, lds, t, tid, wave, lane); }
        }
        SEAM(pb + 1);
        if (IN(pb + 2)) for (int rep = 0; rep < REP3; ++rep) {
            PQ(); unsigned char* const ws = q.ws;
            if (STAG3) stagger_start(bxq, STAG3);
            pg8::Gemm g{(const bf16_t*)(ws + WS_BR), (const bf16_t*)(ws + WS_WBR) + (size_t)layer * 3 * D * 512, 512, BR_LD, 512, 512u * 2u, (unsigned)D * 512u * 2u};
            pg8::Order S; S.init(MP, D, 3, 1, G, bxq);
            pg8::EpiMerge E{(const bf16_t*)(ws + WS_PROJ), (bf16_t*)(ws + WS_MRG)};
            const bool small_first = ((bxq >> 3) & 1) != 0;
            if (small_first) { IDS(); for (int r3 = 0; r3 < RSM; ++r3) for (int t = bx; t < 256; t += G) p3_small(q, layer, lds, t, tid, wave, lane); __syncthreads(); }
            pg8::gemm_phase<pg8::EpiMerge>(lds, g, S, E, TIDNOW());
            if (!small_first) { IDS(); for (int r3 = 0; r3 < RSM; ++r3) for (int t = bx; t < 256; t += G) p3_small(q, layer, lds, t, tid, wave, lane); }
        }
        SEAM(pb + 2);
        if (IN(pb + 3)) for (int rep = 0; rep < REP4; ++rep) {
            PQ(); unsigned char* const ws = q.ws;
            pg8::Gemm g{(const bf16_t*)(ws + WS_MRG), (const bf16_t*)(ws + WS_WOUT) + (size_t)layer * D * D, D, D, D, 0, 0};
            pg8::Order S; S.init(MP, D, 1, 0, G, bxq);
            pg8::EpiY E{(bf16_t*)(ws + WS_Y), (float*)(ws + WS_SSQ)};
            pg8::gemm_phase<pg8::EpiY>(lds, g, S, E, TIDNOW());
            { IDS(); for (int r3 = 0; r3 < RSM; ++r3) for (int t = bx; t < 256; t += G) p4_small(q, layer, lds, t, tid, wave, lane); }
        }
        SEAM(pb + 3);
        if (IN(pb + 4)) for (int rep = 0; rep < (layer == 0 ? REP5 : 1); ++rep) { PQ(); IDS(); p5_residual(q, layer, gw, NGW, lane); }
        if (layer == 0) SEAM(pb + 4);
    }
#undef IN
#undef SEAM
#undef IDS
#undef PQ
#undef TIDNOW
}

extern "C" void kernel_launch(void* const* d_in, const int* in_sizes, int n_in, void* d_out, int out_size, void* d_ws, size_t ws_size, hipStream_t stream) {
    static int grid = 0;
    if (grid == 0) {
        if (n_in != 20 || ws_size < WS_END) { fprintf(stderr, "kernel_launch: expected 20 inputs and >= %zu bytes of workspace (got %d, %zu)\n", (size_t)WS_END, n_in, ws_size); grid = -1; return; }
        int dev = 0, cus = 0, per_cu = 0;
        if (hipGetDevice(&dev) != hipSuccess || hipDeviceGetAttribute(&cus, hipDeviceAttributeMultiprocessorCount, dev) != hipSuccess) { grid = -1; return; }
        if (hipFuncSetAttribute((const void*)mk_fwd, hipFuncAttributeMaxDynamicSharedMemorySize, LDS_BYTES) != hipSuccess) { fprintf(stderr, "kernel_launch: hipFuncSetAttribute failed\n"); grid = -1; return; }
        if (hipOccupancyMaxActiveBlocksPerMultiprocessor(&per_cu, (const void*)mk_fwd, NTHREADS, LDS_BYTES) != hipSuccess || per_cu < 1) { fprintf(stderr, "kernel_launch: occupancy query says %d blocks per CU\n", per_cu); (void)hipGetLastError(); per_cu = 1; }
        grid = cus;
    }
    if (grid < 0) return;
    Params p{};
    for (int i = 0; i < 20; ++i) p.in[i] = (const float*)d_in[i];
    p.out = (float*)d_out; p.ws = (unsigned char*)d_ws;
#if MK_LAUNCHES == 1
    p.ph_lo = 0; p.ph_hi = NPHASES;
    if (hipMemsetAsync((char*)d_ws + WS_BAR, 0, XCD_BAR_WORDS * 4, stream) != hipSuccess) { fprintf(stderr, "kernel_launch: memset of the barrier words failed\n"); return; }
    void* args[] = {&p};
    hipError_t e = hipLaunchCooperativeKernel((const void*)mk_fwd, dim3(grid), dim3(NTHREADS), args, LDS_BYTES, stream);
    if (e != hipSuccess) fprintf(stderr, "cooperative launch failed: %s (grid %d)\n", hipGetErrorString(e), grid);
#else
    for (int k = 0; k < NPHASES; ++k) { p.ph_lo = k; p.ph_hi = k + 1; hipLaunchKernelGGL(mk_fwd, dim3(grid), dim3(NTHREADS), LDS_BYTES, stream, p); }
#endif
}
```
